# Optimizing an MI355X kernel written in HIP

```python
import math
import jax, jax.numpy as jnp
from jax import lax
import numpy as np

D_MODEL = 1024
BATCH = 16
SEQ = 2048
DEPTH = 1

HEAD_DIM = 64
BLOCK = 128
N_META = 16
META_PAD = BLOCK - N_META
WINDOW = 128
ROPE_THETA = 10000.0
RMS_EPS = 1e-6
NEG_INF = -1e30

SWA_Q_HEADS = 16
SWA_KV_HEADS = 4
SWA_GROUP = SWA_Q_HEADS // SWA_KV_HEADS
SWA_WIDTH = SWA_Q_HEADS * HEAD_DIM

DIFF_HEADS = 8
DIFF_V_DIM = 2 * HEAD_DIM
DIFF_WIDTH = DIFF_HEADS * DIFF_V_DIM

D_FF = ((8 * D_MODEL // 3 + 255) // 256) * 256

QA_COLS = SWA_Q_HEADS * HEAD_DIM
KA_COLS = SWA_KV_HEADS * HEAD_DIM
VA_COLS = SWA_KV_HEADS * HEAD_DIM
QB_COLS = DIFF_HEADS * 2 * HEAD_DIM
KB_COLS = DIFF_HEADS * 2 * HEAD_DIM
VB_COLS = DIFF_WIDTH
GATE_COLS = 2 * D_MODEL
IN_COLS = QA_COLS + KA_COLS + VA_COLS + QB_COLS + KB_COLS + VB_COLS + GATE_COLS
SPLITS = (
    QA_COLS,
    QA_COLS + KA_COLS,
    QA_COLS + KA_COLS + VA_COLS,
    QA_COLS + KA_COLS + VA_COLS + QB_COLS,
    QA_COLS + KA_COLS + VA_COLS + QB_COLS + KB_COLS,
    QA_COLS + KA_COLS + VA_COLS + QB_COLS + KB_COLS + VB_COLS,
)

kernel_name = "hybrid_swa_sink_diffattn_gated_encoder"


def rms_norm(x, g):
    xf = x.astype(jnp.float32)
    y = xf * lax.rsqrt(jnp.mean(xf * xf, axis=-1, keepdims=True) + RMS_EPS)
    return (y * g.astype(jnp.float32)).astype(x.dtype)


def rope(x, pos):
    d = x.shape[-1]
    half = d // 2
    inv_freq = ROPE_THETA ** (-jnp.arange(0, d, 2, dtype=jnp.float32) / d)
    ang = pos.astype(jnp.float32)[:, None] * inv_freq[None, :]
    shape = (1, x.shape[1]) + (1,) * (x.ndim - 3) + (half,)
    cos = jnp.cos(ang).reshape(shape)
    sin = jnp.sin(ang).reshape(shape)
    xf = x.astype(jnp.float32)
    x1, x2 = xf[..., :half], xf[..., half:]
    return jnp.concatenate([x1 * cos - x2 * sin, x2 * cos + x1 * sin], axis=-1).astype(x.dtype)


def windowed_gqa_sink_attention(q, k, v, sink, pos, is_real):
    B, Lp = q.shape[0], q.shape[1]
    nb = Lp // BLOCK
    scale = HEAD_DIM ** -0.5
    k_meta = k[:, META_PAD:BLOCK]
    v_meta = v[:, META_PAD:BLOCK]
    padw = ((0, 0), (BLOCK, BLOCK), (0, 0), (0, 0))
    k_p = jnp.pad(k, padw)
    v_p = jnp.pad(v, padw)
    pos_p = jnp.pad(pos, (BLOCK, BLOCK))
    real_p = jnp.pad(is_real, (BLOCK, BLOCK))
    qb = q.reshape(B, nb, BLOCK, SWA_KV_HEADS, SWA_GROUP, HEAD_DIM).transpose(1, 0, 2, 3, 4, 5)
    sink_g = sink.astype(jnp.float32).reshape(SWA_KV_HEADS, SWA_GROUP)

    def one_block(args):
        i, qi = args
        start = i * BLOCK
        kb = lax.dynamic_slice_in_dim(k_p, start, 3 * BLOCK, axis=1)
        vb = lax.dynamic_slice_in_dim(v_p, start, 3 * BLOCK, axis=1)
        kpos = lax.dynamic_slice_in_dim(pos_p, start, 3 * BLOCK)
        kreal = lax.dynamic_slice_in_dim(real_p, start, 3 * BLOCK)
        qpos = lax.dynamic_slice_in_dim(pos, start, BLOCK)
        mask = kreal[None, :] & (jnp.abs(qpos[:, None] - kpos[None, :]) <= WINDOW)
        s_band = jnp.einsum('bqhgd,bkhd->bhgqk', qi, kb).astype(jnp.float32) * scale
        s_band = jnp.where(mask, s_band, NEG_INF)
        s_meta = jnp.einsum('bqhgd,bmhd->bhgqm', qi, k_meta).astype(jnp.float32) * scale
        s_sink = jnp.broadcast_to(sink_g[None, :, :, None, None], s_meta.shape[:-1] + (1,))
        p = jax.nn.softmax(jnp.concatenate([s_band, s_meta, s_sink], axis=-1), axis=-1)
        p_band = p[..., :3 * BLOCK].astype(v.dtype)
        p_meta = p[..., 3 * BLOCK:3 * BLOCK + N_META].astype(v.dtype)
        return (jnp.einsum('bhgqk,bkhd->bqhgd', p_band, vb)
                + jnp.einsum('bhgqm,bmhd->bqhgd', p_meta, v_meta))

    o = lax.map(one_block, (jnp.arange(nb), qb))
    return o.transpose(1, 0, 2, 3, 4, 5).reshape(B, Lp, SWA_WIDTH)


def differential_attention(q, k, v, lam, lambda_init, subln_gain, is_key):
    B, Lp = q.shape[0], q.shape[1]
    nb = Lp // BLOCK
    scale = HEAD_DIM ** -0.5
    key_bias = jnp.where(is_key, 0.0, NEG_INF).astype(jnp.float32)
    qb = q.reshape(B, nb, BLOCK, DIFF_HEADS, 2, HEAD_DIM).transpose(1, 0, 2, 3, 4, 5)

    def one_block(qi):
        s = jnp.einsum('bqhcd,bkhcd->bhcqk', qi, k).astype(jnp.float32) * scale + key_bias
        p = jax.nn.softmax(s, axis=-1)
        a = (p[:, :, 0] - lam * p[:, :, 1]).astype(v.dtype)
        return jnp.einsum('bhqk,bkhe->bqhe', a, v)

    o = lax.map(one_block, qb)
    o = o.transpose(1, 0, 2, 3, 4).reshape(B, Lp, DIFF_HEADS, DIFF_V_DIM)
    o = rms_norm(o, subln_gain) * (1.0 - lambda_init)
    return o.reshape(B, Lp, DIFF_WIDTH).astype(v.dtype)


def setup_inputs(seed: int = 0) -> dict:
    key = jax.random.key(seed)
    ks = jax.random.split(key, 20)
    f32 = jnp.float32

    def nrm(k, shape, scale):
        return jax.random.normal(k, shape, f32) * scale

    def gain(k, shape):
        return 1.0 + 0.02 * jax.random.normal(k, shape, f32)

    return {
        "x": nrm(ks[0], (BATCH, SEQ, D_MODEL), 1.0),
        "meta_tokens": nrm(ks[1], (N_META, D_MODEL), 1.0),
        "pre_mix_gain": gain(ks[2], (DEPTH, D_MODEL)),
        "w_in": nrm(ks[3], (DEPTH, D_MODEL, IN_COLS), D_MODEL ** -0.5),
        "b_gate": nrm(ks[4], (DEPTH, GATE_COLS), 0.1),
        "attn_sink": nrm(ks[5], (DEPTH, SWA_Q_HEADS), 0.5),
        "lambda_q1": nrm(ks[6], (DEPTH, HEAD_DIM), 0.1),
        "lambda_k1": nrm(ks[7], (DEPTH, HEAD_DIM), 0.1),
        "lambda_q2": nrm(ks[8], (DEPTH, HEAD_DIM), 0.1),
        "lambda_k2": nrm(ks[9], (DEPTH, HEAD_DIM), 0.1),
        "diff_subln_gain": gain(ks[10], (DEPTH, DIFF_V_DIM)),
        "w_branch_swa": nrm(ks[11], (DEPTH, SWA_WIDTH, D_MODEL), SWA_WIDTH ** -0.5),
        "w_branch_diff": nrm(ks[12], (DEPTH, DIFF_WIDTH, D_MODEL), DIFF_WIDTH ** -0.5),
        "w_out": nrm(ks[13], (DEPTH, D_MODEL, D_MODEL), D_MODEL ** -0.5),
        "post_mix_gain": gain(ks[14], (DEPTH, D_MODEL)),
        "pre_ffn_gain": gain(ks[15], (DEPTH, D_MODEL)),
        "w_ffn_in": nrm(ks[16], (DEPTH, D_MODEL, 2 * D_FF), D_MODEL ** -0.5),
        "w_ffn_out": nrm(ks[17], (DEPTH, D_FF, D_MODEL), D_FF ** -0.5),
        "post_ffn_gain": gain(ks[18], (DEPTH, D_MODEL)),
    }


def reference(x, meta_tokens, pre_mix_gain, w_in, b_gate, attn_sink, lambda_q1, lambda_k1,
              lambda_q2, lambda_k2, diff_subln_gain, w_branch_swa, w_branch_diff, w_out,
              post_mix_gain, pre_ffn_gain, w_ffn_in, w_ffn_out, post_ffn_gain):
    B = x.shape[0]
    filler = jnp.zeros((B, META_PAD, D_MODEL), x.dtype)
    meta = jnp.broadcast_to(meta_tokens[None].astype(x.dtype), (B, N_META, D_MODEL))
    h = jnp.concatenate([filler, meta, x], axis=1)
    Lp = h.shape[1]
    pos = jnp.arange(Lp, dtype=jnp.int32) - META_PAD
    is_real = pos >= N_META
    is_key = pos >= 0

    for l in range(DEPTH):
        lambda_init = 0.8 - 0.6 * math.exp(-0.3 * l)
        u = rms_norm(h, pre_mix_gain[l])
        proj = u @ w_in[l]
        qa, ka, va, qb, kb, vb, g = jnp.split(proj, SPLITS, axis=-1)
        qa = rope(qa.reshape(B, Lp, SWA_Q_HEADS, HEAD_DIM), pos)
        ka = rope(ka.reshape(B, Lp, SWA_KV_HEADS, HEAD_DIM), pos)
        va = va.reshape(B, Lp, SWA_KV_HEADS, HEAD_DIM)
        qb = rope(qb.reshape(B, Lp, DIFF_HEADS, 2, HEAD_DIM), pos)
        kb = rope(kb.reshape(B, Lp, DIFF_HEADS, 2, HEAD_DIM), pos)
        vb = vb.reshape(B, Lp, DIFF_HEADS, DIFF_V_DIM)

        o_swa = windowed_gqa_sink_attention(qa, ka, va, attn_sink[l], pos, is_real)
        lam = (jnp.exp(jnp.sum(lambda_q1[l].astype(jnp.float32) * lambda_k1[l].astype(jnp.float32)))
               - jnp.exp(jnp.sum(lambda_q2[l].astype(jnp.float32) * lambda_k2[l].astype(jnp.float32)))
               + lambda_init)
        o_diff = differential_attention(qb, kb, vb, lam, lambda_init, diff_subln_gain[l], is_key)

        gates = jax.nn.sigmoid(g + b_gate[l])
        g_swa, g_diff = gates[..., :D_MODEL], gates[..., D_MODEL:]
        merged = g_swa * (o_swa @ w_branch_swa[l]) + g_diff * (o_diff @ w_branch_diff[l])
        h = h + rms_norm(merged @ w_out[l], post_mix_gain[l])

        u = rms_norm(h, pre_ffn_gain[l])
        gate_up = u @ w_ffn_in[l]
        f = (jax.nn.silu(gate_up[..., :D_FF]) * gate_up[..., D_FF:]) @ w_ffn_out[l]
        h = h + rms_norm(f, post_ffn_gain[l])

    return h[:, BLOCK:]
```

```cpp
#include <hip/hip_runtime.h>
#include <hip/hip_cooperative_groups.h>
#include <cstdio>
#include <cstdint>
namespace cg = cooperative_groups;

constexpr size_t MiB = 1u << 20;
constexpr size_t WS_SS1 = 0, WS_SS3 = 128 * 1024, WS_ROPE = 1 * MiB, WS_KAM = 2 * MiB, WS_VAM = WS_KAM + 32 * 1024, WS_KBM = WS_KAM + 64 * 1024, WS_VBM = WS_KAM + 192 * 1024;
constexpr size_t WS_WIN = 4 * MiB, WS_WCAT = 17 * MiB, WS_WOUT = 21 * MiB, WS_WFFI = 23 * MiB, WS_WFFO = 34 * MiB;
constexpr size_t WS_U = 48 * MiB, WS_QO = 112 * MiB, WS_KA = 240 * MiB, WS_VA = 256 * MiB, WS_KB = 272 * MiB, WS_VB = 336 * MiB, WS_MERGED = 400 * MiB;
constexpr size_t WS_Y = 272 * MiB, WS_F = 112 * MiB, WS_FO = 400 * MiB, WS_END = 464 * MiB;

namespace pg8 {
#define PG8_LAS __attribute__((address_space(3)))
typedef unsigned short bf16_t;
typedef short bf16x8 __attribute__((ext_vector_type(8)));
typedef float f32x4 __attribute__((ext_vector_type(4)));
typedef unsigned u32x4 __attribute__((ext_vector_type(4)));
constexpr int BM = 256, BK = 64, HALF = 128, HTB = HALF * BK * 2  , STAGE_BYTES = 8 * HTB, NXCD = 8, WGM = 8;

__host__ __device__ __forceinline__ int lds_byte(int r, int c) { const int st = (r >> 4) * 2 + (c >> 5), rr = r & 15, cc = c & 31, ob = rr * 64 + cc * 2; return st * 1024 + (ob ^ (((ob >> 9) & 1) << 5)); }
__host__ __device__ __forceinline__ void stage_rc(int b, int& R, int& C) { const int st = b / 1024, sb = b % 1024, swz = sb ^ (((sb >> 9) & 1) << 5); R = (st >> 1) * 16 + swz / 64; C = (st & 1) * 32 + (swz % 64) / 2; }
__host__ __device__ __forceinline__ int perm32(int rho) { const int n = rho >> 4, i = rho & 15; return 8 * (i >> 2) + 4 * n + (i & 3); }

struct Unit { int pm, pn; };
struct Gemm { const bf16_t* A; const bf16_t* Bt; int M, N, K; };

struct StaticOrder {
    int nM, nN, nwg, G, c;
    __host__ __device__ void init(int M, int N, int G_, int c_) { nM = M / BM; nN = N / BM; nwg = nM * nN; G = G_; c = c_; }
    __host__ __device__ bool next(int i, Unit& u) const {
        const long L = (long)i * G + c; if (L >= nwg) return false;
        int wgid = (int)L; { const int q = nwg / NXCD, r = nwg % NXCD, xcd = wgid % NXCD, off = wgid / NXCD; wgid = (xcd < r ? xcd * (q + 1) : r * (q + 1) + (xcd - r) * q) + off; }
        const int nig = WGM * nN, gid = wgid / nig, fm = gid * WGM, gsz = (nM - fm) < WGM ? (nM - fm) : WGM;
        u.pm = fm + ((wgid % nig) % gsz); u.pn = (wgid % nig) / gsz; return true;
    }
    __device__ __forceinline__ void a_ready(const Unit&) const {}
    __device__ __forceinline__ void done(const Unit&) const {}
};


typedef float f32x2_t __attribute__((ext_vector_type(2))); typedef __bf16 bf16x2_t __attribute__((ext_vector_type(2)));
__device__ __forceinline__ unsigned cvtpk(float lo, float hi) { f32x2_t v = {lo, hi}; bf16x2_t b = __builtin_convertvector(v, bf16x2_t); return __builtin_bit_cast(unsigned, b); }
__device__ __forceinline__ float bf_lo(unsigned w) { return __uint_as_float(w << 16); }
__device__ __forceinline__ float bf_hi(unsigned w) { return __uint_as_float(w & 0xffff0000u); }
constexpr float QK_C2 = 0.125f * 1.4426950408889634f;

struct EpiInProj {
    static constexpr bool PERM = true, AFTER_DRAIN = false, HAS_MID = false;
    unsigned char* ws; bf16_t* G; const float* bgate;
    __device__ __forceinline__ void mid(f32x4 (&)[2][2][4][2], const Unit&, int, int, int, int) const {}
    __device__ __forceinline__ void operator()(const f32x4 (&acc)[2][2][4][2], const Unit& u, int wr, int wc, int fr, int fq) const {
        const int pn = u.pn, row0 = u.pm * BM + wr * 64 + fr, cl = wc * 32 + 8 * fq;
        bf16_t* dst; int ldc, cb, mode; float sc = 1.f;
        const float* rope = (const float*)(ws + WS_ROPE);
        if (pn < 4)       { dst = (bf16_t*)(ws + WS_QO);        ldc = 2048; cb = pn * 256;        mode = 1; sc = QK_C2; }
        else if (pn == 4) { dst = (bf16_t*)(ws + WS_KA);        ldc = 256;  cb = 0;               mode = 1; }
        else if (pn == 5) { dst = (bf16_t*)(ws + WS_VA);        ldc = 256;  cb = 0;               mode = 0; }
        else if (pn < 10) { dst = (bf16_t*)(ws + WS_QO) + 1024; ldc = 2048; cb = (pn - 6) * 256;  mode = 1; sc = QK_C2; }
        else if (pn < 14) { dst = (bf16_t*)(ws + WS_KB);        ldc = 1024; cb = (pn - 10) * 256; mode = 1; }
        else if (pn < 18) { dst = (bf16_t*)(ws + WS_VB);        ldc = 1024; cb = (pn - 14) * 256; mode = 0; }
        else              { dst = G;                            ldc = 2048; cb = (pn - 18) * 256; mode = 2; }
        if (mode == 1) {
            const int i0 = 16 * (wc & 1) + 4 * fq;
#pragma unroll
            for (int ai = 0; ai < 2; ++ai)
#pragma unroll
                for (int m = 0; m < 4; ++m) {
                    const int row = row0 + ai * HALF + m * 16, pos = 16 + (row & 2047);
                    const f32x4 c0 = *(const f32x4*)(rope + (size_t)(pos * 32 + i0) * 2), c1 = *(const f32x4*)(rope + (size_t)(pos * 32 + i0 + 2) * 2);
#pragma unroll
                    for (int bj = 0; bj < 2; ++bj) {
                        const f32x4 v0 = acc[ai][bj][m][0], v1 = acc[ai][bj][m][1]; u32x4 w;
                        w.x = cvtpk((v0[0] * c0[0] - v0[1] * c0[1]) * sc, (v0[1] * c0[0] + v0[0] * c0[1]) * sc);
                        w.y = cvtpk((v0[2] * c0[2] - v0[3] * c0[3]) * sc, (v0[3] * c0[2] + v0[2] * c0[3]) * sc);
                        w.z = cvtpk((v1[0] * c1[0] - v1[1] * c1[1]) * sc, (v1[1] * c1[0] + v1[0] * c1[1]) * sc);
                        w.w = cvtpk((v1[2] * c1[2] - v1[3] * c1[3]) * sc, (v1[3] * c1[2] + v1[2] * c1[3]) * sc);
                        *(u32x4*)(dst + (size_t)row * ldc + cb + bj * HALF + cl) = w;
                    }
                }
        } else if (mode == 0) {
#pragma unroll
            for (int ai = 0; ai < 2; ++ai)
#pragma unroll
                for (int m = 0; m < 4; ++m) {
                    const int row = row0 + ai * HALF + m * 16;
#pragma unroll
                    for (int bj = 0; bj < 2; ++bj) {
                        const f32x4 v0 = acc[ai][bj][m][0], v1 = acc[ai][bj][m][1]; u32x4 w;
                        w.x = cvtpk(v0[0], v0[1]); w.y = cvtpk(v0[2], v0[3]); w.z = cvtpk(v1[0], v1[1]); w.w = cvtpk(v1[2], v1[3]);
                        *(u32x4*)(dst + (size_t)row * ldc + cb + bj * HALF + cl) = w;
                    }
                }
        } else {
            f32x4 bv[2][2];
#pragma unroll
            for (int bj = 0; bj < 2; ++bj)
#pragma unroll
                for (int n = 0; n < 2; ++n) bv[bj][n] = *(const f32x4*)(bgate + cb + bj * HALF + cl + 4 * n);
#pragma unroll
            for (int ai = 0; ai < 2; ++ai)
#pragma unroll
                for (int m = 0; m < 4; ++m) {
                    const int row = row0 + ai * HALF + m * 16;
#pragma unroll
                    for (int bj = 0; bj < 2; ++bj) {
                        const f32x4 v0 = acc[ai][bj][m][0] + bv[bj][0], v1 = acc[ai][bj][m][1] + bv[bj][1]; float s[8];
#pragma unroll
                        for (int e = 0; e < 4; ++e) { s[e] = __builtin_amdgcn_rcpf(1.f + __expf(-v0[e])); s[4 + e] = __builtin_amdgcn_rcpf(1.f + __expf(-v1[e])); }
                        u32x4 w; w.x = cvtpk(s[0], s[1]); w.y = cvtpk(s[2], s[3]); w.z = cvtpk(s[4], s[5]); w.w = cvtpk(s[6], s[7]);
                        *(u32x4*)(dst + (size_t)row * ldc + cb + bj * HALF + cl) = w;
                    }
                }
        }
    }
};

struct EpiMerge {
    static constexpr bool PERM = true, AFTER_DRAIN = false, HAS_MID = true;
    const bf16_t* G; bf16_t* out;
    __device__ __forceinline__ void mid(f32x4 (&acc)[2][2][4][2], const Unit& u, int wr, int wc, int fr, int fq) const {
        int row0 = u.pm * BM + wr * 64 + fr, col0 = u.pn * BM + wc * 32 + 8 * fq;
        asm volatile("" : "+v"(row0), "+v"(col0));
#pragma unroll
        for (int ai = 0; ai < 2; ++ai)
#pragma unroll
            for (int m = 0; m < 4; ++m) {
                const bf16_t* gp = G + (size_t)(row0 + ai * HALF + m * 16) * 2048 + col0;
#pragma unroll
                for (int bj = 0; bj < 2; ++bj) {
                    const u32x4 a = *(const u32x4*)(gp + bj * HALF), d = *(const u32x4*)(gp + 1024 + bj * HALF);
                    f32x4 r0, r1;
                    r0[0] = bf_lo(a.x) * __builtin_amdgcn_rcpf(fmaxf(bf_lo(d.x), 1e-20f)); r0[1] = bf_hi(a.x) * __builtin_amdgcn_rcpf(fmaxf(bf_hi(d.x), 1e-20f));
                    r0[2] = bf_lo(a.y) * __builtin_amdgcn_rcpf(fmaxf(bf_lo(d.y), 1e-20f)); r0[3] = bf_hi(a.y) * __builtin_amdgcn_rcpf(fmaxf(bf_hi(d.y), 1e-20f));
                    r1[0] = bf_lo(a.z) * __builtin_amdgcn_rcpf(fmaxf(bf_lo(d.z), 1e-20f)); r1[1] = bf_hi(a.z) * __builtin_amdgcn_rcpf(fmaxf(bf_hi(d.z), 1e-20f));
                    r1[2] = bf_lo(a.w) * __builtin_amdgcn_rcpf(fmaxf(bf_lo(d.w), 1e-20f)); r1[3] = bf_hi(a.w) * __builtin_amdgcn_rcpf(fmaxf(bf_hi(d.w), 1e-20f));
                    acc[ai][bj][m][0] *= r0; acc[ai][bj][m][1] *= r1;
                }
                asm volatile("" ::: "memory");
            }
    }
    __device__ __forceinline__ void operator()(const f32x4 (&acc)[2][2][4][2], const Unit& u, int wr, int wc, int fr, int fq) const {
        const int row0 = u.pm * BM + wr * 64 + fr, col0 = u.pn * BM + wc * 32 + 8 * fq;
#pragma unroll
        for (int ai = 0; ai < 2; ++ai)
#pragma unroll
            for (int m = 0; m < 4; ++m) {
                const int row = row0 + ai * HALF + m * 16; const bf16_t* gp = G + (size_t)row * 2048 + 1024 + col0;
#pragma unroll
                for (int bj = 0; bj < 2; ++bj) {
                    const u32x4 d = *(const u32x4*)(gp + bj * HALF); const f32x4 v0 = acc[ai][bj][m][0], v1 = acc[ai][bj][m][1]; u32x4 w;
                    w.x = cvtpk(v0[0] * fmaxf(bf_lo(d.x), 1e-20f), v0[1] * fmaxf(bf_hi(d.x), 1e-20f)); w.y = cvtpk(v0[2] * fmaxf(bf_lo(d.y), 1e-20f), v0[3] * fmaxf(bf_hi(d.y), 1e-20f));
                    w.z = cvtpk(v1[0] * fmaxf(bf_lo(d.z), 1e-20f), v1[1] * fmaxf(bf_hi(d.z), 1e-20f)); w.w = cvtpk(v1[2] * fmaxf(bf_lo(d.w), 1e-20f), v1[3] * fmaxf(bf_hi(d.w), 1e-20f));
                    *(u32x4*)(out + (size_t)row * 1024 + col0 + bj * HALF) = w;
                }
                asm volatile("" ::: "memory");
            }
    }
};

struct EpiYSS {
    static constexpr bool PERM = true, AFTER_DRAIN = false, HAS_MID = false;
    bf16_t* Y; float* ss;
    __device__ __forceinline__ void mid(f32x4 (&)[2][2][4][2], const Unit&, int, int, int, int) const {}
    __device__ __forceinline__ void operator()(const f32x4 (&acc)[2][2][4][2], const Unit& u, int wr, int wc, int fr, int fq) const {
        const int row0 = u.pm * BM + wr * 64 + fr, col0 = u.pn * BM + wc * 32 + 8 * fq;
#pragma unroll
        for (int ai = 0; ai < 2; ++ai)
#pragma unroll
            for (int m = 0; m < 4; ++m) {
                const int row = row0 + ai * HALF + m * 16; float s = 0.f;
#pragma unroll
                for (int bj = 0; bj < 2; ++bj) {
                    const f32x4 v0 = acc[ai][bj][m][0], v1 = acc[ai][bj][m][1]; u32x4 w;
                    s += (v0[0] * v0[0] + v0[1] * v0[1]) + (v0[2] * v0[2] + v0[3] * v0[3]) + (v1[0] * v1[0] + v1[1] * v1[1]) + (v1[2] * v1[2] + v1[3] * v1[3]);
                    w.x = cvtpk(v0[0], v0[1]); w.y = cvtpk(v0[2], v0[3]); w.z = cvtpk(v1[0], v1[1]); w.w = cvtpk(v1[2], v1[3]);
                    *(u32x4*)(Y + (size_t)row * 1024 + col0 + bj * HALF) = w;
                }
                s += __shfl_xor(s, 16); s += __shfl_xor(s, 32);
                if (fq == 0) atomicAdd(ss + row, s);
            }
    }
};

struct EpiSwiGLU {
    static constexpr bool PERM = true, AFTER_DRAIN = false, HAS_MID = false;
    bf16_t* F;
    __device__ __forceinline__ void mid(f32x4 (&)[2][2][4][2], const Unit&, int, int, int, int) const {}
    __device__ __forceinline__ void operator()(const f32x4 (&acc)[2][2][4][2], const Unit& u, int wr, int wc, int fr, int fq) const {
        const int row0 = u.pm * BM + wr * 64 + fr, col0 = u.pn * 128 + wc * 16 + 4 * fq;
#pragma unroll
        for (int ai = 0; ai < 2; ++ai)
#pragma unroll
            for (int m = 0; m < 4; ++m) {
                const int row = row0 + ai * HALF + m * 16;
#pragma unroll
                for (int bj = 0; bj < 2; ++bj) {
                    const f32x4 g = acc[ai][bj][m][0], up = acc[ai][bj][m][1]; float o[4];
#pragma unroll
                    for (int e = 0; e < 4; ++e) o[e] = g[e] * __builtin_amdgcn_rcpf(1.f + __expf(-g[e])) * up[e];
                    unsigned long long w = (unsigned long long)cvtpk(o[0], o[1]) | ((unsigned long long)cvtpk(o[2], o[3]) << 32);
                    *(unsigned long long*)(F + (size_t)row * 2816 + col0 + bj * 64) = w;
                }
            }
    }
};

template <class Epi, class Sched, bool ALIGN_EPI = false, bool SP2 = false>
__device__ __forceinline__ void gemm_phase(PG8_LAS unsigned char* lds, const Gemm g, const Sched& S, const Epi& E) {
    int tid_ = threadIdx.x; asm volatile("" : "+v"(tid_));
    const int tid = tid_, wid = __builtin_amdgcn_readfirstlane(tid >> 6), lane = tid & 63, wr = wid >> 2, wc = wid & 3, fr = lane & 15, fq = lane >> 4;
    const int K = g.K, nt = K / BK;
    unsigned voffA[2], voffB[2];
#pragma unroll
    for (int i = 0; i < 2; ++i) { int R, C; stage_rc(tid * 16 + i * 8192, R, C); const int Rb = Epi::PERM ? ((R & ~31) + perm32(R & 31)) : R;
        voffA[i] = (unsigned)(R * K + C) * 2u; voffB[i] = (unsigned)(Rb * K + C) * 2u; }
    const size_t kstep = (size_t)(BK * 2);
    const size_t hstep = (size_t)HALF * K * 2;
    const size_t tstep = 2 * hstep;
    const unsigned ldsw = (unsigned)wid * 1024u;
    const int aoff = lds_byte(wr * 64 + fr, fq * 8), boff = lds_byte(wc * 32 + fr, fq * 8);
#define PG8_SA(b, h) (((b) * 2 + (h)) * HTB)
#define PG8_SB(b, h) ((4 + (b) * 2 + (h)) * HTB)
#define PG8_STAGE(bufoff, gbase, voff) do { _Pragma("unroll") for (int _i = 0; _i < 2; ++_i) \
        __builtin_amdgcn_global_load_lds((const unsigned*)((const char*)(gbase) + (voff)[_i]), (PG8_LAS unsigned*)(lds + (bufoff) + ldsw + _i * 8192), 16, 0, 0); } while (0)
#define PG8_LDA(dst, b, h) do { _Pragma("unroll") for (int m = 0; m < 4; ++m) _Pragma("unroll") for (int k = 0; k < 2; ++k) dst[m][k] = *(const PG8_LAS bf16x8*)(lds + PG8_SA(b, h) + aoff + m * 2048 + k * 1024); } while (0)
#define PG8_LDB(dst, b, h) do { _Pragma("unroll") for (int n = 0; n < 2; ++n) _Pragma("unroll") for (int k = 0; k < 2; ++k) dst[n][k] = *(const PG8_LAS bf16x8*)(lds + PG8_SB(b, h) + boff + n * 2048 + k * 1024); } while (0)
#define PG8_MMA(ai, bj, At, Bt) do { __builtin_amdgcn_s_setprio(1); _Pragma("unroll") for (int m = 0; m < 4; ++m) _Pragma("unroll") for (int n = 0; n < 2; ++n) _Pragma("unroll") for (int k = 0; k < 2; ++k) \
        acc[ai][bj][m][n] = __builtin_amdgcn_mfma_f32_16x16x32_bf16(Bt[n][k], At[m][k], acc[ai][bj][m][n], 0, 0, 0); __builtin_amdgcn_s_setprio(0); } while (0)
#define PG8_WAIT_V(n) asm volatile("s_waitcnt vmcnt(" #n ")" ::: "memory")
#define PG8_WAIT_L(n) asm volatile("s_waitcnt lgkmcnt(" #n ")" ::: "memory")
#define PG8_BAR __builtin_amdgcn_s_barrier()
#define PG8_SCHED __builtin_amdgcn_sched_barrier(0)
    Unit cur, nxt; int ui = 0;
    if (!S.next(0, cur)) return;
    f32x4 acc[2][2][4][2];
#pragma unroll
    for (int a = 0; a < 2; ++a)
#pragma unroll
        for (int b = 0; b < 2; ++b)
#pragma unroll
            for (int m = 0; m < 4; ++m)
#pragma unroll
                for (int n = 0; n < 2; ++n) acc[a][b][m][n] = (f32x4){0.f, 0.f, 0.f, 0.f};
    bf16x8 At[4][2], B0[2][2], B1[2][2];
    const char* cA = (const char*)g.A + (size_t)cur.pm * tstep; const char* cB = (const char*)g.Bt + (size_t)cur.pn * tstep;
    S.a_ready(cur);
    if constexpr (SP2) {
        PG8_STAGE(PG8_SB(0, 0), cB, voffB); PG8_STAGE(PG8_SB(0, 1), cB + hstep, voffB); PG8_STAGE(PG8_SA(0, 0), cA, voffA); PG8_STAGE(PG8_SA(0, 1), cA + hstep, voffA);
        if (wr == 1) PG8_BAR;
        PG8_WAIT_V(2); PG8_BAR;
        PG8_STAGE(PG8_SB(1, 0), cB + kstep, voffB); PG8_STAGE(PG8_SA(1, 0), cA + kstep, voffA); PG8_STAGE(PG8_SB(1, 1), cB + hstep + kstep, voffB);
        PG8_WAIT_V(6); PG8_BAR;
    } else {
        PG8_STAGE(PG8_SB(0, 0), cB, voffB); PG8_STAGE(PG8_SA(0, 0), cA, voffA); PG8_STAGE(PG8_SB(0, 1), cB + hstep, voffB); PG8_STAGE(PG8_SA(0, 1), cA + hstep, voffA);
        if (wr == 1) PG8_BAR;
        PG8_WAIT_V(4); PG8_BAR;
        PG8_STAGE(PG8_SB(1, 0), cB + kstep, voffB); PG8_STAGE(PG8_SA(1, 0), cA + kstep, voffA); PG8_STAGE(PG8_SB(1, 1), cB + hstep + kstep, voffB);
        PG8_WAIT_V(6); PG8_BAR;
    }
    for (;;) {
        const bool has_next = S.next(ui + 1, nxt);
        const char* nA = has_next ? (const char*)g.A + (size_t)nxt.pm * tstep : cA; const char* nB = has_next ? (const char*)g.Bt + (size_t)nxt.pn * tstep : cB;
        for (int t = 0; t < nt; t += 2) {
            if constexpr (Epi::HAS_MID) { if (t == (nt >> 1)) E.mid(acc, cur, wr, wc, fr, fq); }
            const bool last = (t == nt - 2);
            const char* a1 = cA + (size_t)(t + 1) * kstep;
            const char* a2 = last ? nA : cA + (size_t)(t + 2) * kstep; const char* b2 = last ? nB : cB + (size_t)(t + 2) * kstep;
            const char* a3 = a2 + kstep; const char* b3 = b2 + kstep;
            if (last && has_next) S.a_ready(nxt);
            if constexpr (SP2) {
            PG8_LDB(B0, 0, 0); PG8_LDB(B1, 0, 1); PG8_SCHED; PG8_LDA(At, 0, 0); PG8_STAGE(PG8_SA(1, 1), a1 + hstep, voffA);
            PG8_WAIT_V(8); PG8_WAIT_L(0); PG8_BAR; PG8_MMA(0, 0, At, B0); PG8_MMA(0, 1, At, B1); PG8_BAR; PG8_SCHED;
            PG8_LDA(At, 0, 1); PG8_STAGE(PG8_SB(0, 0), b2, voffB); PG8_STAGE(PG8_SB(0, 1), b2 + hstep, voffB); PG8_STAGE(PG8_SA(0, 0), a2, voffA);
            PG8_WAIT_V(8); PG8_WAIT_L(0); PG8_BAR; PG8_MMA(1, 0, At, B0); PG8_MMA(1, 1, At, B1); PG8_BAR; PG8_SCHED;
            PG8_LDB(B0, 1, 0); PG8_LDB(B1, 1, 1); PG8_SCHED; PG8_LDA(At, 1, 0); PG8_STAGE(PG8_SA(0, 1), a2 + hstep, voffA);
            PG8_WAIT_V(8); PG8_WAIT_L(0); PG8_BAR; PG8_MMA(0, 0, At, B0); PG8_MMA(0, 1, At, B1); PG8_BAR; PG8_SCHED;
            PG8_LDA(At, 1, 1); PG8_STAGE(PG8_SB(1, 0), b3, voffB); PG8_STAGE(PG8_SB(1, 1), b3 + hstep, voffB); PG8_STAGE(PG8_SA(1, 0), a3, voffA);
            PG8_WAIT_V(8); PG8_WAIT_L(0); PG8_BAR; PG8_MMA(1, 0, At, B0); PG8_MMA(1, 1, At, B1); PG8_BAR; PG8_SCHED;
            } else {
            PG8_LDB(B0, 0, 0); PG8_SCHED; PG8_LDA(At, 0, 0); PG8_STAGE(PG8_SA(1, 1), a1 + hstep, voffA);
            PG8_WAIT_L(8); PG8_BAR; PG8_WAIT_L(0); PG8_MMA(0, 0, At, B0); PG8_BAR; PG8_SCHED;
            PG8_LDB(B1, 0, 1); PG8_STAGE(PG8_SB(0, 0), b2, voffB);
            PG8_BAR; PG8_WAIT_L(0); PG8_MMA(0, 1, At, B1); PG8_BAR;
            PG8_LDA(At, 0, 1); PG8_STAGE(PG8_SA(0, 0), a2, voffA);
            PG8_BAR; PG8_WAIT_L(0); PG8_MMA(1, 0, At, B0); PG8_BAR; PG8_SCHED;
            PG8_STAGE(PG8_SB(0, 1), b2 + hstep, voffB);
            PG8_WAIT_V(6); PG8_BAR; PG8_MMA(1, 1, At, B1); PG8_BAR;
            PG8_LDB(B0, 1, 0); PG8_SCHED; PG8_LDA(At, 1, 0); PG8_STAGE(PG8_SA(0, 1), a2 + hstep, voffA);
            PG8_WAIT_L(8); PG8_BAR; PG8_WAIT_L(0); PG8_MMA(0, 0, At, B0); PG8_BAR; PG8_SCHED;
            PG8_LDB(B1, 1, 1); PG8_STAGE(PG8_SB(1, 0), b3, voffB);
            PG8_BAR; PG8_WAIT_L(0); PG8_MMA(0, 1, At, B1); PG8_BAR;
            PG8_LDA(At, 1, 1); PG8_STAGE(PG8_SA(1, 0), a3, voffA);
            PG8_BAR; PG8_WAIT_L(0); PG8_MMA(1, 0, At, B0); PG8_BAR; PG8_SCHED;
            PG8_STAGE(PG8_SB(1, 1), b3 + hstep, voffB);
            PG8_WAIT_V(6); PG8_BAR; PG8_MMA(1, 1, At, B1); PG8_BAR;
            }
        }
        if constexpr (ALIGN_EPI) { if (wr == 0) PG8_BAR; }
        if constexpr (!Epi::AFTER_DRAIN) { E(acc, cur, wr, wc, fr, fq); S.done(cur); }
        if (!has_next) break;
#pragma unroll
        for (int a = 0; a < 2; ++a)
#pragma unroll
            for (int b = 0; b < 2; ++b)
#pragma unroll
                for (int m = 0; m < 4; ++m)
#pragma unroll
                    for (int n = 0; n < 2; ++n) acc[a][b][m][n] = (f32x4){0.f, 0.f, 0.f, 0.f};
        cur = nxt; cA = nA; cB = nB; ++ui;
        if constexpr (ALIGN_EPI) { if (wr == 1) PG8_BAR; }
    }
    PG8_WAIT_V(0);
    if constexpr (!ALIGN_EPI) { if (wr == 0) PG8_BAR; }
    PG8_BAR;
    if constexpr (Epi::AFTER_DRAIN) { E.fused(acc, cur, wr, wc, fr, fq, lds, wid, lane); S.done(cur); }
#undef PG8_SA
#undef PG8_SB
#undef PG8_STAGE
#undef PG8_LDA
#undef PG8_LDB
#undef PG8_MMA
#undef PG8_WAIT_V
#undef PG8_WAIT_L
#undef PG8_BAR
#undef PG8_SCHED
}
}

namespace att {
#define LAS __attribute__((address_space(3)))
typedef unsigned short bf16_t;
typedef short bf16x8 __attribute__((ext_vector_type(8)));
typedef short s16x4 __attribute__((ext_vector_type(4)));
typedef short v4i16_t __attribute__((ext_vector_type(4)));
typedef float f32x16 __attribute__((ext_vector_type(16)));
typedef float f32x4 __attribute__((ext_vector_type(4)));
typedef unsigned u32x4 __attribute__((ext_vector_type(4)));
typedef unsigned u32x2 __attribute__((ext_vector_type(2)));
using pg8::cvtpk;
__device__ __forceinline__ s16x4 vtr(const LAS unsigned char* p) { return __builtin_bit_cast(s16x4, __builtin_amdgcn_ds_read_tr16_b64_v4i16((LAS v4i16_t*)p)); }
__device__ __forceinline__ int crow(int i, int h) { return (i & 3) + 8 * (i >> 2) + 4 * h; }
#define MFMA32(a, b, c) __builtin_amdgcn_mfma_f32_32x32x16_bf16((a), (b), (c), 0, 0, 0)
constexpr float NEGV = -1e30f;
constexpr int ATT_LDS_MAX = 2 * (64 * 272 + 64 * 320);

template <int KW, int DV, bool SWA>
__device__ __forceinline__ void attn_unit(LAS unsigned char* lds, const int tid, const int wid, const int lane,
                                          bf16_t* Qw, const bf16_t* Kreal, const bf16_t* Kmeta, const int kpitch, const bf16_t* Vreal, const bf16_t* Vmeta, const int vpitch,
                                          const int t0, const int t1, const int qrel0, const float sink_l2, const float lam, const float* gain, bf16_t* Od) {
    constexpr int KP = KW * 2 + 16, VP = (DV == 64) ? 192 : 320, KBUF = 64 * KP, VBUF = 64 * VP;
    constexpr int NKC = KW / 64, NVC = DV / 64, KCPR = KW / 8, VCPR = DV / 8, NDB = DV / 32;
    const int r = lane & 31, h = lane >> 5;
    bf16x8 qf[4];
#pragma unroll
    for (int st = 0; st < 4; ++st) qf[st] = *(const bf16x8*)(Qw + (size_t)r * 2048 + 16 * st + 8 * h);
    u32x4 kreg[NKC], vreg[NVC];
#define ATT_LOAD(Ks, Vs) do { \
        _Pragma("unroll") for (int i_ = 0; i_ < NKC; ++i_) { const int c_ = tid + 512 * i_; kreg[i_] = *(const u32x4*)((Ks) + (size_t)(c_ / KCPR) * kpitch + (c_ % KCPR) * 8); } \
        _Pragma("unroll") for (int i_ = 0; i_ < NVC; ++i_) { const int c_ = tid + 512 * i_; vreg[i_] = *(const u32x4*)((Vs) + (size_t)(c_ / VCPR) * vpitch + (c_ % VCPR) * 8); } } while (0)
#define ATT_STORE(buf) do { \
        _Pragma("unroll") for (int i_ = 0; i_ < NKC; ++i_) { const int c_ = tid + 512 * i_; *(LAS u32x4*)(lds + (buf) * KBUF + (c_ / KCPR) * KP + (c_ % KCPR) * 16) = kreg[i_]; } \
        _Pragma("unroll") for (int i_ = 0; i_ < NVC; ++i_) { const int c_ = tid + 512 * i_; *(LAS u32x4*)(lds + 2 * KBUF + (buf) * VBUF + (c_ / VCPR) * VP + (c_ % VCPR) * 16) = vreg[i_]; } } while (0)
    ATT_LOAD(Kmeta, Vmeta);
    ATT_STORE(0);
    __syncthreads();
    f32x16 o[NDB];
#pragma unroll
    for (int db = 0; db < NDB; ++db)
#pragma unroll
        for (int i = 0; i < 16; ++i) o[db][i] = 0.f;
    float m = NEGV, l = 0.f;
    const int nt = 1 + (t1 - t0);
    const int kcolw = SWA ? 0 : 64 * (wid >> 2);
    const int koff = r * KP + (kcolw + 8 * h) * 2;
    const int voff = (4 * h + ((lane & 15) >> 2)) * VP + (16 * ((lane >> 4) & 1) + 4 * (lane & 3)) * 2;
    for (int it = 0; it < nt; ++it) {
        const int cur = it & 1;
        if (it + 1 < nt) { const int tt = t0 + it; ATT_LOAD(Kreal + (size_t)tt * 64 * kpitch, Vreal + (size_t)tt * 64 * vpitch); }
        const LAS unsigned char* kb = lds + cur * KBUF + koff;
        const LAS unsigned char* vb = lds + 2 * KBUF + cur * VBUF + voff;
        f32x16 s0, s1;
#pragma unroll
        for (int i = 0; i < 16; ++i) { s0[i] = 0.f; s1[i] = 0.f; }
#pragma unroll
        for (int st = 0; st < 4; ++st) {
            const bf16x8 a0 = *(const LAS bf16x8*)(kb + st * 32);
            const bf16x8 a1 = *(const LAS bf16x8*)(kb + 32 * KP + st * 32);
            s0 = MFMA32(a0, qf[st], s0); s1 = MFMA32(a1, qf[st], s1);
        }
        if (it == 0) {
#pragma unroll
            for (int i = 0; i < 16; ++i) { if (i >= 8) s0[i] = NEGV; s1[i] = NEGV; }
        } else if (SWA) {
            const int d0 = (t0 + it - 1) * 64 - (qrel0 + r);
#pragma unroll
            for (int i = 0; i < 16; ++i) { const int d = d0 + crow(i, h); if (d < -128 || d > 128) s0[i] = NEGV; if (d + 32 < -128 || d + 32 > 128) s1[i] = NEGV; }
        }
        float mx = fmaxf(s0[0], s1[0]);
#pragma unroll
        for (int i = 1; i < 16; ++i) mx = fmaxf(mx, fmaxf(s0[i], s1[i]));
        mx = fmaxf(mx, __shfl_xor(mx, 32));
        const float mn = fmaxf(m, mx), alpha = __builtin_amdgcn_exp2f(m - mn);
        m = mn;
        float rs = 0.f;
#pragma unroll
        for (int i = 0; i < 16; ++i) { s0[i] = __builtin_amdgcn_exp2f(s0[i] - mn); s1[i] = __builtin_amdgcn_exp2f(s1[i] - mn); rs += s0[i] + s1[i]; }
        l = l * alpha + rs;
#pragma unroll
        for (int db = 0; db < NDB; ++db)
#pragma unroll
            for (int i = 0; i < 16; ++i) o[db][i] *= alpha;
        bf16x8 pf[4];
        { u32x4 w;
          w.x = cvtpk(s0[0], s0[1]); w.y = cvtpk(s0[2], s0[3]); w.z = cvtpk(s0[4], s0[5]); w.w = cvtpk(s0[6], s0[7]); pf[0] = __builtin_bit_cast(bf16x8, w);
          w.x = cvtpk(s0[8], s0[9]); w.y = cvtpk(s0[10], s0[11]); w.z = cvtpk(s0[12], s0[13]); w.w = cvtpk(s0[14], s0[15]); pf[1] = __builtin_bit_cast(bf16x8, w);
          w.x = cvtpk(s1[0], s1[1]); w.y = cvtpk(s1[2], s1[3]); w.z = cvtpk(s1[4], s1[5]); w.w = cvtpk(s1[6], s1[7]); pf[2] = __builtin_bit_cast(bf16x8, w);
          w.x = cvtpk(s1[8], s1[9]); w.y = cvtpk(s1[10], s1[11]); w.z = cvtpk(s1[12], s1[13]); w.w = cvtpk(s1[14], s1[15]); pf[3] = __builtin_bit_cast(bf16x8, w); }
#pragma unroll
        for (int ks = 0; ks < 4; ++ks)
#pragma unroll
            for (int db = 0; db < NDB; ++db) {
                const s16x4 lo = vtr(vb + (16 * ks) * VP + db * 64), hi = vtr(vb + (16 * ks + 8) * VP + db * 64);
                const bf16x8 va = __builtin_shufflevector(lo, hi, 0, 1, 2, 3, 4, 5, 6, 7);
                o[db] = MFMA32(va, pf[ks], o[db]);
            }
        if (it + 1 < nt) ATT_STORE(cur ^ 1);
        __syncthreads();
    }
#undef ATT_LOAD
#undef ATT_STORE
    l += __shfl_xor(l, 32);
    if constexpr (SWA) {
        l += __builtin_amdgcn_exp2f(sink_l2 - m);
        const float inv = 1.f / l;
#pragma unroll
        for (int db = 0; db < NDB; ++db)
#pragma unroll
            for (int g4 = 0; g4 < 4; ++g4) {
                u32x2 w; w.x = cvtpk(o[db][4 * g4] * inv, o[db][4 * g4 + 1] * inv); w.y = cvtpk(o[db][4 * g4 + 2] * inv, o[db][4 * g4 + 3] * inv);
                *(u32x2*)(Qw + (size_t)r * 2048 + 32 * db + 8 * g4 + 4 * h) = w;
            }
    } else {
        const float inv = 1.f / l;
        LAS float* xb = (LAS float*)lds;
        if (wid >= 4) {
            const float sc = lam * inv;
#pragma unroll
            for (int db = 0; db < NDB; ++db)
#pragma unroll
                for (int i = 0; i < 16; ++i) xb[((wid - 4) * 128 + 32 * db + crow(i, h)) * 32 + r] = o[db][i] * sc;
        }
        __syncthreads();
        if (wid < 4) {
            float ss = 0.f;
#pragma unroll
            for (int db = 0; db < NDB; ++db)
#pragma unroll
                for (int i = 0; i < 16; ++i) { const float v = o[db][i] * inv - xb[(wid * 128 + 32 * db + crow(i, h)) * 32 + r]; o[db][i] = v; ss += v * v; }
            ss += __shfl_xor(ss, 32);
            const float rstd = 0.8f / sqrtf(ss * (1.f / 128.f) + 1e-6f);
#pragma unroll
            for (int db = 0; db < NDB; ++db)
#pragma unroll
                for (int g4 = 0; g4 < 4; ++g4) {
                    const int d = 32 * db + 8 * g4 + 4 * h; const f32x4 gg = *(const f32x4*)(gain + d);
                    u32x2 w; w.x = cvtpk(o[db][4 * g4] * rstd * gg[0], o[db][4 * g4 + 1] * rstd * gg[1]); w.y = cvtpk(o[db][4 * g4 + 2] * rstd * gg[2], o[db][4 * g4 + 3] * rstd * gg[3]);
                    *(u32x2*)(Od + (size_t)r * 2048 + d) = w;
                }
        }
        __syncthreads();
    }
}
}

typedef unsigned short bf16;
typedef float f32x4 __attribute__((ext_vector_type(4)));
typedef unsigned u32x4 __attribute__((ext_vector_type(4)));
typedef unsigned u32x2 __attribute__((ext_vector_type(2)));
using pg8::cvtpk; using pg8::bf_lo; using pg8::bf_hi;
constexpr int NTOK = 32768, DM = 1024, NIN = 6656, DFF = 2816, SEQL = 2048;
constexpr float RMS_EPS = 1e-6f;
constexpr int LDS_BYTES = 131072;
static_assert(att::ATT_LDS_MAX <= LDS_BYTES && pg8::STAGE_BYTES <= LDS_BYTES, "LDS map");

__device__ __forceinline__ float wave_sum(float v) {
#pragma unroll
    for (int o = 1; o < 64; o <<= 1) v += __shfl_xor(v, o);
    return v;
}
template <int MODE> __device__ __forceinline__ int rowmap(int n) {
    if (MODE == 1) {
        const bool perm = (n < 1280) || (n >= 1536 && n < 3584);
        if (!perm) return n;
        const int d = n & 63; return (n & ~63) + ((d < 32) ? 2 * d : 2 * (d - 32) + 1);
    } else if (MODE == 2) {
        if (n < DFF) return 8 * (n >> 2) + (n & 3);
        const int j = n - DFF; return 8 * (j >> 2) + 4 + (j & 3);
    }
    return n;
}
template <int MODE> __device__ __forceinline__ void p0_transpose_item(const float* W, int N, bf16* WT, int ldk, int koff, LAS float* scr, int item, int lane) {
    const int nblk = N / 32, kb = item / nblk, nb = item % nblk, k0 = 64 * kb, n0 = 32 * nb;
#pragma unroll 8
    for (int i = 0; i < 32; ++i) { const int kk = 2 * i + (lane >> 5); scr[kk * 33 + (lane & 31)] = W[(size_t)(k0 + kk) * N + n0 + (lane & 31)]; }
    asm volatile("s_waitcnt lgkmcnt(0)" ::: "memory");
    const int c = lane & 7;
#pragma unroll
    for (int j = 0; j < 4; ++j) { const int n = (lane >> 3) + 8 * j; const LAS float* s = scr + (8 * c) * 33 + n;
        u32x4 o; o.x = cvtpk(s[0 * 33], s[1 * 33]); o.y = cvtpk(s[2 * 33], s[3 * 33]); o.z = cvtpk(s[4 * 33], s[5 * 33]); o.w = cvtpk(s[6 * 33], s[7 * 33]);
        *(u32x4*)(WT + (size_t)rowmap<MODE>(n0 + n) * ldk + koff + k0 + 8 * c) = o; }
    asm volatile("s_waitcnt lgkmcnt(0)" ::: "memory");
}

#ifndef PH_MASK
#define PH_MASK 0x1ff
#endif
#define PH_ON(k) ((PH_MASK >> (k)) & 1)
struct Args { const float* in[19]; float* out; unsigned char* ws; };

__global__ void __launch_bounds__(512, 2) fwd_megakernel(Args a) {
    extern __shared__ __attribute__((aligned(16))) unsigned char lds_raw[];
    cg::grid_group grid = cg::this_grid();
    LAS unsigned char* lds = (LAS unsigned char*)lds_raw;
    const int tid = threadIdx.x, lane = tid & 63, wid = __builtin_amdgcn_readfirstlane(tid >> 6);
    const int G = gridDim.x, bx = blockIdx.x;
    const int vcu = (G % 8 == 0) ? (bx % 8) * (G / 8) + bx / 8 : bx;
    const int gw = bx * 8 + wid, NGW = G * 8;
    unsigned char* ws = a.ws;
#define p_x (a.in[0])
#define p_meta_tokens (a.in[1])
#define p_pre_mix_gain (a.in[2])
#define p_w_in (a.in[3])
#define p_b_gate (a.in[4])
#define p_attn_sink (a.in[5])
#define p_lq1 (a.in[6])
#define p_lk1 (a.in[7])
#define p_lq2 (a.in[8])
#define p_lk2 (a.in[9])
#define p_subln_gain (a.in[10])
#define p_w_bswa (a.in[11])
#define p_w_bdiff (a.in[12])
#define p_w_out (a.in[13])
#define p_post_mix_gain (a.in[14])
#define p_pre_ffn_gain (a.in[15])
#define p_w_ffn_in (a.in[16])
#define p_w_ffn_out (a.in[17])
#define p_post_ffn_gain (a.in[18])
#define p_ss1 ((float*)(ws + WS_SS1))
#define p_ss3 ((float*)(ws + WS_SS3))
#define p_rope ((float*)(ws + WS_ROPE))
#define p_KAm ((bf16*)(ws + WS_KAM))
#define p_VAm ((bf16*)(ws + WS_VAM))
#define p_KBm ((bf16*)(ws + WS_KBM))
#define p_VBm ((bf16*)(ws + WS_VBM))
#define p_Win_t ((bf16*)(ws + WS_WIN))
#define p_Wcat_t ((bf16*)(ws + WS_WCAT))
#define p_Wout_t ((bf16*)(ws + WS_WOUT))
#define p_Wffi_t ((bf16*)(ws + WS_WFFI))
#define p_Wffo_t ((bf16*)(ws + WS_WFFO))
#define p_U ((bf16*)(ws + WS_U))
#define p_QO ((bf16*)(ws + WS_QO))
#define p_KA ((bf16*)(ws + WS_KA))
#define p_VA ((bf16*)(ws + WS_VA))
#define p_KB ((bf16*)(ws + WS_KB))
#define p_VB ((bf16*)(ws + WS_VB))
#define p_MERGED ((bf16*)(ws + WS_MERGED))
#define p_Y ((bf16*)(ws + WS_Y))
#define p_F ((bf16*)(ws + WS_F))
#define p_FO ((bf16*)(ws + WS_FO))
#define p_GATES ((bf16*)a.out)
#define p_out (a.out)

#if PH_ON(0)
    {
        for (int e = bx * 512 + tid; e < 65536; e += G * 512) p_ss1[e] = 0.f;
        for (int e = bx * 512 + tid; e < 2064 * 32; e += G * 512) {
            const int pos = e >> 5, i = e & 31; const float inv = powf(10000.f, -(float)i * (1.f / 32.f)); const float ang = (float)pos * inv;
            p_rope[2 * e] = cosf(ang); p_rope[2 * e + 1] = sinf(ang);
        }
        if (bx < 40) {
            const int item = bx;
            LAS float* um = (LAS float*)lds; LAS float* red = (LAS float*)(lds + 65536);
#pragma unroll
            for (int rr = 0; rr < 2; ++rr) {
                const int row = 2 * wid + rr; const float* xr = p_meta_tokens + row * DM; float v[16]; float s = 0.f;
#pragma unroll
                for (int j = 0; j < 16; ++j) { v[j] = xr[lane + 64 * j]; s += v[j] * v[j]; }
                s = wave_sum(s); const float rstd = 1.f / sqrtf(s * (1.f / DM) + RMS_EPS);
#pragma unroll
                for (int j = 0; j < 16; ++j) um[row * DM + lane + 64 * j] = v[j] * rstd * p_pre_mix_gain[lane + 64 * j];
            }
            __syncthreads();
            int c0, ldd, dcol; bf16* dst; bool dorope;
            if (item < 4)       { c0 = 1024 + 64 * item;        dst = p_KAm; ldd = 256;  dcol = 64 * item;        dorope = true; }
            else if (item < 8)  { c0 = 1280 + 64 * (item - 4);  dst = p_VAm; ldd = 256;  dcol = 64 * (item - 4);  dorope = false; }
            else if (item < 24) { c0 = 2560 + 64 * (item - 8);  dst = p_KBm; ldd = 1024; dcol = 64 * (item - 8);  dorope = true; }
            else                { c0 = 3584 + 64 * (item - 24); dst = p_VBm; ldd = 1024; dcol = 64 * (item - 24); dorope = false; }
            float acc[16];
#pragma unroll
            for (int rI = 0; rI < 16; ++rI) acc[rI] = 0.f;
            const float* wp = p_w_in + (size_t)(128 * wid) * NIN + c0 + lane;
            for (int k4 = 0; k4 < 32; ++k4) {
                const float w0 = wp[(size_t)(4 * k4) * NIN], w1 = wp[(size_t)(4 * k4 + 1) * NIN], w2 = wp[(size_t)(4 * k4 + 2) * NIN], w3 = wp[(size_t)(4 * k4 + 3) * NIN];
#pragma unroll
                for (int rI = 0; rI < 16; ++rI) { const f32x4 uu = *(const LAS f32x4*)(um + rI * DM + 128 * wid + 4 * k4); acc[rI] += (uu[0] * w0 + uu[1] * w1) + (uu[2] * w2 + uu[3] * w3); }
            }
#pragma unroll
            for (int rI = 0; rI < 16; ++rI) red[(wid * 16 + rI) * 64 + lane] = acc[rI];
            __syncthreads();
            {
                const int rI = tid >> 5, i = tid & 31; float x1 = 0.f, x2 = 0.f;
#pragma unroll
                for (int w = 0; w < 8; ++w) { x1 += red[(w * 16 + rI) * 64 + i]; x2 += red[(w * 16 + rI) * 64 + i + 32]; }
                if (dorope) {
                    const float inv = powf(10000.f, -(float)i * (1.f / 32.f)); const float ang = (float)rI * inv; const float c = cosf(ang), s = sinf(ang);
                    *(unsigned*)(dst + rI * ldd + dcol + 2 * i) = cvtpk(x1 * c - x2 * s, x2 * c + x1 * s);
                } else {
                    dst[rI * ldd + dcol + i] = (bf16)(cvtpk(x1, 0.f) & 0xffffu); dst[rI * ldd + dcol + i + 32] = (bf16)(cvtpk(x2, 0.f) & 0xffffu);
                }
                for (int e = tid; e < 1536; e += 512) { const int rr = 16 + e / 32, cc = (e % 32) * 2; *(unsigned*)(dst + rr * ldd + dcol + cc) = 0u; }
            }
            __syncthreads();
        }
        {
            LAS float* scr = (LAS float*)(lds + wid * 16384);
            constexpr int I_IN = 16 * (NIN / 32), I_SQ = 16 * 32, I_FI = 16 * (2 * DFF / 32), I_FO = (DFF / 64) * 32;
            constexpr int NITEMS = I_IN + 3 * I_SQ + I_FI + I_FO;
            for (int it = gw; it < NITEMS; it += NGW) {
                int q = it;
                if (q < I_IN) { p0_transpose_item<1>(p_w_in, NIN, p_Win_t, DM, 0, scr, q, lane); continue; } q -= I_IN;
                if (q < I_SQ) { p0_transpose_item<0>(p_w_bswa, DM, p_Wcat_t, 2048, 0, scr, q, lane); continue; } q -= I_SQ;
                if (q < I_SQ) { p0_transpose_item<0>(p_w_bdiff, DM, p_Wcat_t, 2048, 1024, scr, q, lane); continue; } q -= I_SQ;
                if (q < I_SQ) { p0_transpose_item<0>(p_w_out, DM, p_Wout_t, DM, 0, scr, q, lane); continue; } q -= I_SQ;
                if (q < I_FI) { p0_transpose_item<2>(p_w_ffn_in, 2 * DFF, p_Wffi_t, DM, 0, scr, q, lane); continue; } q -= I_FI;
                p0_transpose_item<0>(p_w_ffn_out, DM, p_Wffo_t, DFF, 0, scr, q, lane);
            }
        }
        for (int mrow = gw; mrow < NTOK; mrow += NGW) {
            const f32x4* xr = (const f32x4*)(p_x + (size_t)mrow * DM) + lane; f32x4 v[4]; float s = 0.f;
#pragma unroll
            for (int j = 0; j < 4; ++j) { v[j] = xr[64 * j]; s += (v[j][0] * v[j][0] + v[j][1] * v[j][1]) + (v[j][2] * v[j][2] + v[j][3] * v[j][3]); }
            const float rstd = 1.f / sqrtf(wave_sum(s) * (1.f / DM) + RMS_EPS);
            u32x2* o8 = (u32x2*)(p_U + (size_t)mrow * DM) + lane;
#pragma unroll
            for (int j = 0; j < 4; ++j) { const f32x4 g = *((const f32x4*)p_pre_mix_gain + lane + 64 * j); u32x2 w; w.x = cvtpk(v[j][0] * rstd * g[0], v[j][1] * rstd * g[1]); w.y = cvtpk(v[j][2] * rstd * g[2], v[j][3] * rstd * g[3]); o8[64 * j] = w; }
        }
    }
    grid.sync();

#endif
#if PH_ON(1)
    {
        pg8::Gemm g{p_U, p_Win_t, NTOK, NIN, DM}; pg8::StaticOrder S; S.init(NTOK, NIN, G, bx);
        pg8::EpiInProj E{ws, p_GATES, p_b_gate};
        pg8::gemm_phase<pg8::EpiInProj, pg8::StaticOrder, true, true>(lds, g, S, E);
    }
    grid.sync();

#endif
#if PH_ON(2)
    {
        int tid_o = threadIdx.x; asm volatile("" : "+v"(tid_o));
        const int tid = tid_o, lane = tid & 63, wid = __builtin_amdgcn_readfirstlane(tid >> 6);
        float lam;
        { float p1 = p_lq1[lane] * p_lk1[lane], p2 = p_lq2[lane] * p_lk2[lane]; p1 = wave_sum(p1); p2 = wave_sum(p2); lam = expf(p1) - expf(p2) + 0.2f; }
        for (int uidx = vcu; uidx < 2048; uidx += G) {
            const int i = uidx & 15, hh = (uidx >> 4) & 7, b = uidx >> 7;
            const size_t qrow = (size_t)b * SEQL + i * 128 + 32 * (wid & 3);
            att::attn_unit<128, 128, false>(lds, tid, wid, lane, p_QO + qrow * 2048 + 1024 + hh * 128 + 64 * (wid >> 2),
                                            p_KB + (size_t)b * SEQL * 1024 + hh * 128, p_KBm + hh * 128, 1024, p_VB + (size_t)b * SEQL * 1024 + hh * 128, p_VBm + hh * 128, 1024,
                                            0, 32, 0, 0.f, lam, p_subln_gain, p_QO + qrow * 2048 + 1024 + hh * 128);
        }
        for (int uidx = vcu; uidx < 2048; uidx += G) {
            const int hp = uidx & 1, i = (uidx >> 1) & 15, gk = (uidx >> 5) & 3, b = uidx >> 7;
            const int qhead = gk * 4 + hp * 2 + (wid >> 2);
            const size_t qrow = (size_t)b * SEQL + i * 128 + 32 * (wid & 3);
            const int t0 = (i >= 1) ? 2 * (i - 1) : 0, t1 = (2 * (i + 2) < 32) ? 2 * (i + 2) : 32;
            att::attn_unit<64, 64, true>(lds, tid, wid, lane, p_QO + qrow * 2048 + qhead * 64,
                                         p_KA + (size_t)b * SEQL * 256 + gk * 64, p_KAm + gk * 64, 256, p_VA + (size_t)b * SEQL * 256 + gk * 64, p_VAm + gk * 64, 256,
                                         t0, t1, i * 128 + 32 * (wid & 3), p_attn_sink[qhead] * 1.4426950408889634f, 0.f, nullptr, nullptr);
        }
    }
    grid.sync();

#endif
#if PH_ON(3)
    {
        pg8::Gemm g{p_QO, p_Wcat_t, NTOK, DM, 2048}; pg8::StaticOrder S; S.init(NTOK, DM, G, bx);
        pg8::EpiMerge E{p_GATES, p_MERGED};
        pg8::gemm_phase<pg8::EpiMerge, pg8::StaticOrder, true, true>(lds, g, S, E);
    }
    grid.sync();

#endif
#if PH_ON(4)
    {
        pg8::Gemm g{p_MERGED, p_Wout_t, NTOK, DM, DM}; pg8::StaticOrder S; S.init(NTOK, DM, G, bx);
        pg8::EpiYSS E{p_Y, p_ss1};
        pg8::gemm_phase<pg8::EpiYSS, pg8::StaticOrder, true, true>(lds, g, S, E);
    }
    grid.sync();

#endif
#if PH_ON(5)
    for (int mrow = gw; mrow < NTOK; mrow += NGW) {
        const f32x4* xr = (const f32x4*)(p_x + (size_t)mrow * DM) + lane; const u32x2* yr = (const u32x2*)(p_Y + (size_t)mrow * DM) + lane;
        const float rstd1 = 1.f / sqrtf(p_ss1[mrow] * (1.f / DM) + RMS_EPS);
        f32x4 hv[4]; float s2 = 0.f;
#pragma unroll
        for (int j = 0; j < 4; ++j) {
            const f32x4 xv = xr[64 * j]; const u32x2 yw = yr[64 * j]; const f32x4 g = *((const f32x4*)p_post_mix_gain + lane + 64 * j);
            f32x4 hvv; hvv[0] = xv[0] + bf_lo(yw.x) * rstd1 * g[0]; hvv[1] = xv[1] + bf_hi(yw.x) * rstd1 * g[1]; hvv[2] = xv[2] + bf_lo(yw.y) * rstd1 * g[2]; hvv[3] = xv[3] + bf_hi(yw.y) * rstd1 * g[3];
            hv[j] = hvv; s2 += (hvv[0] * hvv[0] + hvv[1] * hvv[1]) + (hvv[2] * hvv[2] + hvv[3] * hvv[3]);
        }
        const float rstd2 = 1.f / sqrtf(wave_sum(s2) * (1.f / DM) + RMS_EPS);
        f32x4* orow = (f32x4*)(p_out + (size_t)mrow * DM) + lane; u32x2* urow = (u32x2*)(p_U + (size_t)mrow * DM) + lane;
#pragma unroll
        for (int j = 0; j < 4; ++j) {
            const f32x4 g = *((const f32x4*)p_pre_ffn_gain + lane + 64 * j); orow[64 * j] = hv[j];
            u32x2 w; w.x = cvtpk(hv[j][0] * rstd2 * g[0], hv[j][1] * rstd2 * g[1]); w.y = cvtpk(hv[j][2] * rstd2 * g[2], hv[j][3] * rstd2 * g[3]); urow[64 * j] = w;
        }
    }
    grid.sync();

#endif
#if PH_ON(6)
    {
        pg8::Gemm g{p_U, p_Wffi_t, NTOK, 2 * DFF, DM}; pg8::StaticOrder S; S.init(NTOK, 2 * DFF, G, bx);
        pg8::EpiSwiGLU E{p_F};
        pg8::gemm_phase<pg8::EpiSwiGLU, pg8::StaticOrder, true, true>(lds, g, S, E);
    }
    grid.sync();

#endif
#if PH_ON(7)
    {
        pg8::Gemm g{p_F, p_Wffo_t, NTOK, DM, DFF}; pg8::StaticOrder S; S.init(NTOK, DM, G, bx);
        pg8::EpiYSS E{p_FO, p_ss3};
        pg8::gemm_phase<pg8::EpiYSS, pg8::StaticOrder, true, true>(lds, g, S, E);
    }
    grid.sync();

#endif
#if PH_ON(8)
    for (int mrow = gw; mrow < NTOK; mrow += NGW) {
        f32x4* orow = (f32x4*)(p_out + (size_t)mrow * DM) + lane; const u32x2* fr_ = (const u32x2*)(p_FO + (size_t)mrow * DM) + lane;
        const float rstd3 = 1.f / sqrtf(p_ss3[mrow] * (1.f / DM) + RMS_EPS);
#pragma unroll
        for (int j = 0; j < 4; ++j) {
            const f32x4 hvv = orow[64 * j]; const u32x2 fw = fr_[64 * j]; const f32x4 g = *((const f32x4*)p_post_ffn_gain + lane + 64 * j);
            f32x4 o; o[0] = hvv[0] + bf_lo(fw.x) * rstd3 * g[0]; o[1] = hvv[1] + bf_hi(fw.x) * rstd3 * g[1]; o[2] = hvv[2] + bf_lo(fw.y) * rstd3 * g[2]; o[3] = hvv[3] + bf_hi(fw.y) * rstd3 * g[3];
            orow[64 * j] = o;
        }
    }
#endif
}


extern "C" void kernel_launch(void* const* d_in, const int* in_sizes, int n_in, void* d_out, int out_size, void* d_ws, size_t ws_size, hipStream_t stream) {
    static int grid_blocks = 0;
    if (grid_blocks == 0) {
        if (n_in != 19 || out_size != NTOK * DM || ws_size < WS_END) { fprintf(stderr, "kernel_launch: unexpected shapes (n_in %d, out %d, ws %zu)\n", n_in, out_size, ws_size); grid_blocks = -1; return; }
        int dev = 0, cus = 0, per_cu = 0;
        hipGetDevice(&dev);
        hipDeviceGetAttribute(&cus, hipDeviceAttributeMultiprocessorCount, dev);
        hipFuncSetAttribute((const void*)fwd_megakernel, hipFuncAttributeMaxDynamicSharedMemorySize, LDS_BYTES);
        hipOccupancyMaxActiveBlocksPerMultiprocessor(&per_cu, (const void*)fwd_megakernel, 512, LDS_BYTES);
        if (per_cu < 1) { fprintf(stderr, "kernel_launch: occupancy query says %d blocks per CU\n", per_cu); per_cu = 1; }
        if (per_cu > 1) per_cu = 1;
        grid_blocks = cus * per_cu;
    }
    if (grid_blocks < 0) return;
    Args a{};
    for (int i = 0; i < 19; ++i) a.in[i] = (const float*)d_in[i];
    a.out = (float*)d_out; a.ws = (unsigned char*)d_ws;
    void* args[] = {&a};
    hipError_t e = hipLaunchCooperativeKernel((const void*)fwd_megakernel, dim3(grid_blocks), dim3(512), args, LDS_BYTES, stream);
    if (e != hipSuccess) fprintf(stderr, "cooperative launch failed: %s (grid %d)\n", hipGetErrorString(e), grid_blocks);
}
```

```cpp
#include <hip/hip_runtime.h>
#include <hip/hip_cooperative_groups.h>
#include <cstdio>
#include <cstdint>
namespace cg = cooperative_groups;

constexpr size_t MiB = 1u << 20;
constexpr size_t WS_RSX = 256 * 1024, WS_RS2 = 384 * 1024;
constexpr size_t WS_SS1 = 0, WS_SS3 = 128 * 1024, WS_ROPE = 1 * MiB, WS_KAM = 2 * MiB, WS_VAM = WS_KAM + 32 * 1024, WS_KBM = WS_KAM + 64 * 1024, WS_VBM = WS_KAM + 192 * 1024;
constexpr size_t WS_WIN = 4 * MiB, WS_WCAT = 17 * MiB, WS_WOUT = 21 * MiB, WS_WFFI = 23 * MiB, WS_WFFO = 34 * MiB;
constexpr size_t WS_U = 48 * MiB, WS_QO = 112 * MiB, WS_KA = 240 * MiB, WS_VA = 256 * MiB, WS_KB = 272 * MiB, WS_VB = 336 * MiB, WS_MERGED = 400 * MiB;
constexpr size_t WS_Y = 272 * MiB, WS_F = 112 * MiB, WS_FO = 48 * MiB  , WS_H1 = 400 * MiB  , WS_END = 464 * MiB;

namespace pg8 {
#define PG8_LAS __attribute__((address_space(3)))
typedef unsigned short bf16_t;
typedef short bf16x8 __attribute__((ext_vector_type(8)));
typedef float f32x4 __attribute__((ext_vector_type(4)));
typedef unsigned u32x4 __attribute__((ext_vector_type(4)));
constexpr int BM = 256, BK = 64, HALF = 128, HTB = HALF * BK * 2  , STAGE_BYTES = 8 * HTB, NXCD = 8, WGM = 8;

__host__ __device__ __forceinline__ int lds_byte(int r, int c) { const int st = (r >> 4) * 2 + (c >> 5), rr = r & 15, cc = c & 31, ob = rr * 64 + cc * 2; return st * 1024 + (ob ^ (((ob >> 9) & 1) << 5)); }
__host__ __device__ __forceinline__ void stage_rc(int b, int& R, int& C) { const int st = b / 1024, sb = b % 1024, swz = sb ^ (((sb >> 9) & 1) << 5); R = (st >> 1) * 16 + swz / 64; C = (st & 1) * 32 + (swz % 64) / 2; }
__host__ __device__ __forceinline__ int perm32(int rho) { const int n = rho >> 4, i = rho & 15; return 8 * (i >> 2) + 4 * n + (i & 3); }

struct Unit { int pm, pn; };
struct Gemm { const bf16_t* A; const bf16_t* Bt; int M, N, K; };

struct StaticOrder {
    int nM, nN, nwg, G, c;
    __host__ __device__ void init(int M, int N, int G_, int c_) { nM = M / BM; nN = N / BM; nwg = nM * nN; G = G_; c = c_; }
    __host__ __device__ bool next(int i, Unit& u) const {
        const long L = (long)i * G + c; if (L >= nwg) return false;
        int wgid = (int)L; { const int q = nwg / NXCD, r = nwg % NXCD, xcd = wgid % NXCD, off = wgid / NXCD; wgid = (xcd < r ? xcd * (q + 1) : r * (q + 1) + (xcd - r) * q) + off; }
        const int nig = WGM * nN, gid = wgid / nig, fm = gid * WGM, gsz = (nM - fm) < WGM ? (nM - fm) : WGM;
        u.pm = fm + ((wgid % nig) % gsz); u.pn = (wgid % nig) / gsz; return true;
    }
    __device__ __forceinline__ void a_ready(const Unit&) const {}
    __device__ __forceinline__ void done(const Unit&) const {}
};


typedef float f32x2_t __attribute__((ext_vector_type(2))); typedef __bf16 bf16x2_t __attribute__((ext_vector_type(2)));
__device__ __forceinline__ unsigned cvtpk(float lo, float hi) { f32x2_t v = {lo, hi}; bf16x2_t b = __builtin_convertvector(v, bf16x2_t); return __builtin_bit_cast(unsigned, b); }
__device__ __forceinline__ float bf_lo(unsigned w) { return __uint_as_float(w << 16); }
__device__ __forceinline__ float bf_hi(unsigned w) { return __uint_as_float(w & 0xffff0000u); }
constexpr float QK_C2 = 0.125f * 1.4426950408889634f;

struct EpiInProj {
    static constexpr bool PERM = true, AFTER_DRAIN = false, HAS_MID = false;
    unsigned char* ws; bf16_t* G; const float* bgate;
    __device__ __forceinline__ void mid(f32x4 (&)[2][2][4][2], const Unit&, int, int, int, int) const {}
    __device__ __forceinline__ void operator()(const f32x4 (&acc)[2][2][4][2], const Unit& u, int wr, int wc, int fr, int fq) const {
        const int pn = u.pn, row0 = u.pm * BM + wr * 64 + fr, cl = wc * 32 + 8 * fq;
        bf16_t* dst; int ldc, cb, mode; float sc0 = 1.f;
        const float* rope = (const float*)(ws + WS_ROPE);
        if (pn < 4)       { dst = (bf16_t*)(ws + WS_QO);        ldc = 2048; cb = pn * 256;        mode = 1; sc0 = QK_C2; }
        else if (pn == 4) { dst = (bf16_t*)(ws + WS_KA);        ldc = 256;  cb = 0;               mode = 1; }
        else if (pn == 5) { dst = (bf16_t*)(ws + WS_VA);        ldc = 256;  cb = 0;               mode = 0; }
        else if (pn < 10) { dst = (bf16_t*)(ws + WS_QO) + 1024; ldc = 2048; cb = (pn - 6) * 256;  mode = 1; sc0 = QK_C2; }
        else if (pn < 14) { dst = (bf16_t*)(ws + WS_KB);        ldc = 1024; cb = (pn - 10) * 256; mode = 1; }
        else if (pn < 18) { dst = (bf16_t*)(ws + WS_VB);        ldc = 1024; cb = (pn - 14) * 256; mode = 0; }
        else              { dst = G;                            ldc = 2048; cb = (pn - 18) * 256; mode = 2; }
        if (mode == 1) {
            const int i0 = 16 * (wc & 1) + 4 * fq;
#pragma unroll
            for (int ai = 0; ai < 2; ++ai)
#pragma unroll
                for (int m = 0; m < 4; ++m) {
                    const int row = row0 + ai * HALF + m * 16, pos = 16 + (row & 2047);
                    const f32x4 c0 = *(const f32x4*)(rope + (size_t)(pos * 32 + i0) * 2), c1 = *(const f32x4*)(rope + (size_t)(pos * 32 + i0 + 2) * 2);
                    const float sc = sc0;
#pragma unroll
                    for (int bj = 0; bj < 2; ++bj) {
                        const f32x4 v0 = acc[ai][bj][m][0], v1 = acc[ai][bj][m][1]; u32x4 w;
                        w.x = cvtpk((v0[0] * c0[0] - v0[1] * c0[1]) * sc, (v0[1] * c0[0] + v0[0] * c0[1]) * sc);
                        w.y = cvtpk((v0[2] * c0[2] - v0[3] * c0[3]) * sc, (v0[3] * c0[2] + v0[2] * c0[3]) * sc);
                        w.z = cvtpk((v1[0] * c1[0] - v1[1] * c1[1]) * sc, (v1[1] * c1[0] + v1[0] * c1[1]) * sc);
                        w.w = cvtpk((v1[2] * c1[2] - v1[3] * c1[3]) * sc, (v1[3] * c1[2] + v1[2] * c1[3]) * sc);
                        *(u32x4*)(dst + (size_t)row * ldc + cb + bj * HALF + cl) = w;
                    }
                }
        } else if (mode == 0) {
#pragma unroll
            for (int ai = 0; ai < 2; ++ai)
#pragma unroll
                for (int m = 0; m < 4; ++m) {
                    const int row = row0 + ai * HALF + m * 16;
#pragma unroll
                    for (int bj = 0; bj < 2; ++bj) {
                        const f32x4 v0 = acc[ai][bj][m][0], v1 = acc[ai][bj][m][1]; u32x4 w;
                        w.x = cvtpk(v0[0], v0[1]); w.y = cvtpk(v0[2], v0[3]); w.z = cvtpk(v1[0], v1[1]); w.w = cvtpk(v1[2], v1[3]);
                        *(u32x4*)(dst + (size_t)row * ldc + cb + bj * HALF + cl) = w;
                    }
                }
        } else {
            f32x4 bv[2][2];
#pragma unroll
            for (int bj = 0; bj < 2; ++bj)
#pragma unroll
                for (int n = 0; n < 2; ++n) bv[bj][n] = *(const f32x4*)(bgate + cb + bj * HALF + cl + 4 * n);
#pragma unroll
            for (int ai = 0; ai < 2; ++ai)
#pragma unroll
                for (int m = 0; m < 4; ++m) {
                    const int row = row0 + ai * HALF + m * 16;
#pragma unroll
                    for (int bj = 0; bj < 2; ++bj) {
                        const f32x4 v0 = acc[ai][bj][m][0] + bv[bj][0], v1 = acc[ai][bj][m][1] + bv[bj][1]; float s[8];
#pragma unroll
                        for (int e = 0; e < 4; ++e) { s[e] = __builtin_amdgcn_rcpf(1.f + __expf(-v0[e])); s[4 + e] = __builtin_amdgcn_rcpf(1.f + __expf(-v1[e])); }
                        u32x4 w; w.x = cvtpk(s[0], s[1]); w.y = cvtpk(s[2], s[3]); w.z = cvtpk(s[4], s[5]); w.w = cvtpk(s[6], s[7]);
                        *(u32x4*)(dst + (size_t)row * ldc + cb + bj * HALF + cl) = w;
                    }
                }
        }
    }
};

struct EpiMerge {
    static constexpr bool PERM = true, AFTER_DRAIN = false, HAS_MID = true;
    const bf16_t* G; bf16_t* out;
    __device__ __forceinline__ void mid(f32x4 (&acc)[2][2][4][2], const Unit& u, int wr, int wc, int fr, int fq) const {
        int row0 = u.pm * BM + wr * 64 + fr, col0 = u.pn * BM + wc * 32 + 8 * fq;
        asm volatile("" : "+v"(row0), "+v"(col0));
#pragma unroll
        for (int ai = 0; ai < 2; ++ai)
#pragma unroll
            for (int m = 0; m < 4; ++m) {
                const bf16_t* gp = G + (size_t)(row0 + ai * HALF + m * 16) * 2048 + col0;
#pragma unroll
                for (int bj = 0; bj < 2; ++bj) {
                    const u32x4 a = *(const u32x4*)(gp + bj * HALF), d = *(const u32x4*)(gp + 1024 + bj * HALF);
                    f32x4 r0, r1;
                    r0[0] = bf_lo(a.x) * __builtin_amdgcn_rcpf(fmaxf(bf_lo(d.x), 1e-20f)); r0[1] = bf_hi(a.x) * __builtin_amdgcn_rcpf(fmaxf(bf_hi(d.x), 1e-20f));
                    r0[2] = bf_lo(a.y) * __builtin_amdgcn_rcpf(fmaxf(bf_lo(d.y), 1e-20f)); r0[3] = bf_hi(a.y) * __builtin_amdgcn_rcpf(fmaxf(bf_hi(d.y), 1e-20f));
                    r1[0] = bf_lo(a.z) * __builtin_amdgcn_rcpf(fmaxf(bf_lo(d.z), 1e-20f)); r1[1] = bf_hi(a.z) * __builtin_amdgcn_rcpf(fmaxf(bf_hi(d.z), 1e-20f));
                    r1[2] = bf_lo(a.w) * __builtin_amdgcn_rcpf(fmaxf(bf_lo(d.w), 1e-20f)); r1[3] = bf_hi(a.w) * __builtin_amdgcn_rcpf(fmaxf(bf_hi(d.w), 1e-20f));
                    acc[ai][bj][m][0] *= r0; acc[ai][bj][m][1] *= r1;
                }
                asm volatile("" ::: "memory");
            }
    }
    __device__ __forceinline__ void operator()(const f32x4 (&acc)[2][2][4][2], const Unit& u, int wr, int wc, int fr, int fq) const {
        const int row0 = u.pm * BM + wr * 64 + fr, col0 = u.pn * BM + wc * 32 + 8 * fq;
#pragma unroll
        for (int ai = 0; ai < 2; ++ai)
#pragma unroll
            for (int m = 0; m < 4; ++m) {
                const int row = row0 + ai * HALF + m * 16; const bf16_t* gp = G + (size_t)row * 2048 + 1024 + col0;
#pragma unroll
                for (int bj = 0; bj < 2; ++bj) {
                    const u32x4 d = *(const u32x4*)(gp + bj * HALF); const f32x4 v0 = acc[ai][bj][m][0], v1 = acc[ai][bj][m][1]; u32x4 w;
                    w.x = cvtpk(v0[0] * fmaxf(bf_lo(d.x), 1e-20f), v0[1] * fmaxf(bf_hi(d.x), 1e-20f)); w.y = cvtpk(v0[2] * fmaxf(bf_lo(d.y), 1e-20f), v0[3] * fmaxf(bf_hi(d.y), 1e-20f));
                    w.z = cvtpk(v1[0] * fmaxf(bf_lo(d.z), 1e-20f), v1[1] * fmaxf(bf_hi(d.z), 1e-20f)); w.w = cvtpk(v1[2] * fmaxf(bf_lo(d.w), 1e-20f), v1[3] * fmaxf(bf_hi(d.w), 1e-20f));
                    *(u32x4*)(out + (size_t)row * 1024 + col0 + bj * HALF) = w;
                }
                asm volatile("" ::: "memory");
            }
    }
};

struct EpiYSS {
    static constexpr bool PERM = true, AFTER_DRAIN = false, HAS_MID = false;
    bf16_t* Y; float* ss;
    __device__ __forceinline__ void mid(f32x4 (&)[2][2][4][2], const Unit&, int, int, int, int) const {}
    __device__ __forceinline__ void operator()(const f32x4 (&acc)[2][2][4][2], const Unit& u, int wr, int wc, int fr, int fq) const {
        const int row0 = u.pm * BM + wr * 64 + fr, col0 = u.pn * BM + wc * 32 + 8 * fq;
#pragma unroll
        for (int ai = 0; ai < 2; ++ai)
#pragma unroll
            for (int m = 0; m < 4; ++m) {
                const int row = row0 + ai * HALF + m * 16; float s = 0.f;
#pragma unroll
                for (int bj = 0; bj < 2; ++bj) {
                    const f32x4 v0 = acc[ai][bj][m][0], v1 = acc[ai][bj][m][1]; u32x4 w;
                    s += (v0[0] * v0[0] + v0[1] * v0[1]) + (v0[2] * v0[2] + v0[3] * v0[3]) + (v1[0] * v1[0] + v1[1] * v1[1]) + (v1[2] * v1[2] + v1[3] * v1[3]);
                    w.x = cvtpk(v0[0], v0[1]); w.y = cvtpk(v0[2], v0[3]); w.z = cvtpk(v1[0], v1[1]); w.w = cvtpk(v1[2], v1[3]);
                    *(u32x4*)(Y + (size_t)row * 1024 + col0 + bj * HALF) = w;
                }
                s += __shfl_xor(s, 16); s += __shfl_xor(s, 32);
                if (fq == 0) atomicAdd(ss + row, s);
            }
    }
};

struct EpiSwiGLU {
    static constexpr bool PERM = true, AFTER_DRAIN = false, HAS_MID = false;
    bf16_t* F;
    __device__ __forceinline__ void mid(f32x4 (&)[2][2][4][2], const Unit&, int, int, int, int) const {}
    __device__ __forceinline__ void operator()(const f32x4 (&acc)[2][2][4][2], const Unit& u, int wr, int wc, int fr, int fq) const {
        const int row0 = u.pm * BM + wr * 64 + fr, col0 = u.pn * 128 + wc * 16 + 4 * fq;
#pragma unroll
        for (int ai = 0; ai < 2; ++ai)
#pragma unroll
            for (int m = 0; m < 4; ++m) {
                const int row = row0 + ai * HALF + m * 16;
#pragma unroll
                for (int bj = 0; bj < 2; ++bj) {
                    const f32x4 g = acc[ai][bj][m][0], up = acc[ai][bj][m][1]; float o[4];
#pragma unroll
                    for (int e = 0; e < 4; ++e) o[e] = g[e] * __builtin_amdgcn_rcpf(1.f + __expf(-g[e])) * up[e];
                    unsigned long long w = (unsigned long long)cvtpk(o[0], o[1]) | ((unsigned long long)cvtpk(o[2], o[3]) << 32);
                    *(unsigned long long*)(F + (size_t)row * 2816 + col0 + bj * 64) = w;
                }
            }
    }
};

template <class Epi, class Sched, bool ALIGN_EPI = false, bool SP2 = false>
__device__ __forceinline__ void gemm_phase(PG8_LAS unsigned char* lds, const Gemm g, const Sched& S, Epi& E) {
    int tid_ = threadIdx.x; asm volatile("" : "+v"(tid_));
    const int tid = tid_, wid = __builtin_amdgcn_readfirstlane(tid >> 6), lane = tid & 63, wr = wid >> 2, wc = wid & 3, fr = lane & 15, fq = lane >> 4;
    const int K = g.K, nt = K / BK;
    unsigned voffA[2], voffB[2];
#pragma unroll
    for (int i = 0; i < 2; ++i) { int R, C; stage_rc(tid * 16 + i * 8192, R, C); const int Rb = Epi::PERM ? ((R & ~31) + perm32(R & 31)) : R;
        voffA[i] = (unsigned)(R * K + C) * 2u; voffB[i] = (unsigned)(Rb * K + C) * 2u; }
    const size_t kstep = (size_t)(BK * 2);
    const size_t hstep = (size_t)HALF * K * 2;
    const size_t tstep = 2 * hstep;
    const unsigned ldsw = (unsigned)wid * 1024u;
    const int aoff = lds_byte(wr * 64 + fr, fq * 8), boff = lds_byte(wc * 32 + fr, fq * 8);
#define PG8_SA(b, h) (((b) * 2 + (h)) * HTB)
#define PG8_SB(b, h) ((4 + (b) * 2 + (h)) * HTB)
#define PG8_STAGE(bufoff, gbase, voff) do { _Pragma("unroll") for (int _i = 0; _i < 2; ++_i) \
        __builtin_amdgcn_global_load_lds((const unsigned*)((const char*)(gbase) + (voff)[_i]), (PG8_LAS unsigned*)(lds + (bufoff) + ldsw + _i * 8192), 16, 0, 0); } while (0)
#define PG8_LDA(dst, b, h) do { _Pragma("unroll") for (int m = 0; m < 4; ++m) _Pragma("unroll") for (int k = 0; k < 2; ++k) dst[m][k] = *(const PG8_LAS bf16x8*)(lds + PG8_SA(b, h) + aoff + m * 2048 + k * 1024); } while (0)
#define PG8_LDB(dst, b, h) do { _Pragma("unroll") for (int n = 0; n < 2; ++n) _Pragma("unroll") for (int k = 0; k < 2; ++k) dst[n][k] = *(const PG8_LAS bf16x8*)(lds + PG8_SB(b, h) + boff + n * 2048 + k * 1024); } while (0)
#define PG8_MMA(ai, bj, At, Bt) do { __builtin_amdgcn_s_setprio(1); _Pragma("unroll") for (int m = 0; m < 4; ++m) _Pragma("unroll") for (int n = 0; n < 2; ++n) _Pragma("unroll") for (int k = 0; k < 2; ++k) \
        acc[ai][bj][m][n] = __builtin_amdgcn_mfma_f32_16x16x32_bf16(Bt[n][k], At[m][k], acc[ai][bj][m][n], 0, 0, 0); __builtin_amdgcn_s_setprio(0); } while (0)
#define PG8_WAIT_V(n) asm volatile("s_waitcnt vmcnt(" #n ")" ::: "memory")
#define PG8_WAIT_L(n) asm volatile("s_waitcnt lgkmcnt(" #n ")" ::: "memory")
#define PG8_BAR __builtin_amdgcn_s_barrier()
#define PG8_SCHED __builtin_amdgcn_sched_barrier(0)
    Unit cur, nxt; int ui = 0;
    if (!S.next(0, cur)) return;
    f32x4 acc[2][2][4][2];
#pragma unroll
    for (int a = 0; a < 2; ++a)
#pragma unroll
        for (int b = 0; b < 2; ++b)
#pragma unroll
            for (int m = 0; m < 4; ++m)
#pragma unroll
                for (int n = 0; n < 2; ++n) acc[a][b][m][n] = (f32x4){0.f, 0.f, 0.f, 0.f};
    bf16x8 At[4][2], B0[2][2], B1[2][2];
    const char* cA = (const char*)g.A + (size_t)cur.pm * tstep; const char* cB = (const char*)g.Bt + (size_t)cur.pn * tstep;
    S.a_ready(cur);
    if constexpr (SP2) {
        PG8_STAGE(PG8_SB(0, 0), cB, voffB); PG8_STAGE(PG8_SB(0, 1), cB + hstep, voffB); PG8_STAGE(PG8_SA(0, 0), cA, voffA); PG8_STAGE(PG8_SA(0, 1), cA + hstep, voffA);
        if (wr == 1) PG8_BAR;
        PG8_WAIT_V(2); PG8_BAR;
        PG8_STAGE(PG8_SB(1, 0), cB + kstep, voffB); PG8_STAGE(PG8_SA(1, 0), cA + kstep, voffA); PG8_STAGE(PG8_SB(1, 1), cB + hstep + kstep, voffB);
        PG8_WAIT_V(6); PG8_BAR;
    } else {
        PG8_STAGE(PG8_SB(0, 0), cB, voffB); PG8_STAGE(PG8_SA(0, 0), cA, voffA); PG8_STAGE(PG8_SB(0, 1), cB + hstep, voffB); PG8_STAGE(PG8_SA(0, 1), cA + hstep, voffA);
        if (wr == 1) PG8_BAR;
        PG8_WAIT_V(4); PG8_BAR;
        PG8_STAGE(PG8_SB(1, 0), cB + kstep, voffB); PG8_STAGE(PG8_SA(1, 0), cA + kstep, voffA); PG8_STAGE(PG8_SB(1, 1), cB + hstep + kstep, voffB);
        PG8_WAIT_V(6); PG8_BAR;
    }
    for (;;) {
        const bool has_next = S.next(ui + 1, nxt);
        const char* nA = has_next ? (const char*)g.A + (size_t)nxt.pm * tstep : cA; const char* nB = has_next ? (const char*)g.Bt + (size_t)nxt.pn * tstep : cB;
        for (int t = 0; t < nt; t += 2) {
            if constexpr (Epi::HAS_MID) { if (t == (nt >> 1)) E.mid(acc, cur, wr, wc, fr, fq); }
            const bool last = (t == nt - 2);
            const char* a1 = cA + (size_t)(t + 1) * kstep;
            const char* a2 = last ? nA : cA + (size_t)(t + 2) * kstep; const char* b2 = last ? nB : cB + (size_t)(t + 2) * kstep;
            const char* a3 = a2 + kstep; const char* b3 = b2 + kstep;
            if (last && has_next) S.a_ready(nxt);
            if constexpr (SP2) {
            PG8_LDB(B0, 0, 0); PG8_LDB(B1, 0, 1); PG8_SCHED; PG8_LDA(At, 0, 0); PG8_STAGE(PG8_SA(1, 1), a1 + hstep, voffA);
            PG8_WAIT_V(8); PG8_WAIT_L(0); PG8_BAR; PG8_MMA(0, 0, At, B0); PG8_MMA(0, 1, At, B1); PG8_BAR; PG8_SCHED;
            PG8_LDA(At, 0, 1); PG8_STAGE(PG8_SB(0, 0), b2, voffB); PG8_STAGE(PG8_SB(0, 1), b2 + hstep, voffB); PG8_STAGE(PG8_SA(0, 0), a2, voffA);
            PG8_WAIT_V(8); PG8_WAIT_L(0); PG8_BAR; PG8_MMA(1, 0, At, B0); PG8_MMA(1, 1, At, B1); PG8_BAR; PG8_SCHED;
            PG8_LDB(B0, 1, 0); PG8_LDB(B1, 1, 1); PG8_SCHED; PG8_LDA(At, 1, 0); PG8_STAGE(PG8_SA(0, 1), a2 + hstep, voffA);
            PG8_WAIT_V(8); PG8_WAIT_L(0); PG8_BAR; PG8_MMA(0, 0, At, B0); PG8_MMA(0, 1, At, B1); PG8_BAR; PG8_SCHED;
            PG8_LDA(At, 1, 1); PG8_STAGE(PG8_SB(1, 0), b3, voffB); PG8_STAGE(PG8_SB(1, 1), b3 + hstep, voffB); PG8_STAGE(PG8_SA(1, 0), a3, voffA);
            PG8_WAIT_V(8); PG8_WAIT_L(0); PG8_BAR; PG8_MMA(1, 0, At, B0); PG8_MMA(1, 1, At, B1); PG8_BAR; PG8_SCHED;
            } else {
            PG8_LDB(B0, 0, 0); PG8_SCHED; PG8_LDA(At, 0, 0); PG8_STAGE(PG8_SA(1, 1), a1 + hstep, voffA);
            PG8_WAIT_L(8); PG8_BAR; PG8_WAIT_L(0); PG8_MMA(0, 0, At, B0); PG8_BAR; PG8_SCHED;
            PG8_LDB(B1, 0, 1); PG8_STAGE(PG8_SB(0, 0), b2, voffB);
            PG8_BAR; PG8_WAIT_L(0); PG8_MMA(0, 1, At, B1); PG8_BAR;
            PG8_LDA(At, 0, 1); PG8_STAGE(PG8_SA(0, 0), a2, voffA);
            PG8_BAR; PG8_WAIT_L(0); PG8_MMA(1, 0, At, B0); PG8_BAR; PG8_SCHED;
            PG8_STAGE(PG8_SB(0, 1), b2 + hstep, voffB);
            PG8_WAIT_V(6); PG8_BAR; PG8_MMA(1, 1, At, B1); PG8_BAR;
            PG8_LDB(B0, 1, 0); PG8_SCHED; PG8_LDA(At, 1, 0); PG8_STAGE(PG8_SA(0, 1), a2 + hstep, voffA);
            PG8_WAIT_L(8); PG8_BAR; PG8_WAIT_L(0); PG8_MMA(0, 0, At, B0); PG8_BAR; PG8_SCHED;
            PG8_LDB(B1, 1, 1); PG8_STAGE(PG8_SB(1, 0), b3, voffB);
            PG8_BAR; PG8_WAIT_L(0); PG8_MMA(0, 1, At, B1); PG8_BAR;
            PG8_LDA(At, 1, 1); PG8_STAGE(PG8_SA(1, 0), a3, voffA);
            PG8_BAR; PG8_WAIT_L(0); PG8_MMA(1, 0, At, B0); PG8_BAR; PG8_SCHED;
            PG8_STAGE(PG8_SB(1, 1), b3 + hstep, voffB);
            PG8_WAIT_V(6); PG8_BAR; PG8_MMA(1, 1, At, B1); PG8_BAR;
            }
        }
        if constexpr (ALIGN_EPI) { if (wr == 0) PG8_BAR; }
        if constexpr (!Epi::AFTER_DRAIN) { E(acc, cur, wr, wc, fr, fq); S.done(cur); }
        if (!has_next) break;
#pragma unroll
        for (int a = 0; a < 2; ++a)
#pragma unroll
            for (int b = 0; b < 2; ++b)
#pragma unroll
                for (int m = 0; m < 4; ++m)
#pragma unroll
                    for (int n = 0; n < 2; ++n) acc[a][b][m][n] = (f32x4){0.f, 0.f, 0.f, 0.f};
        cur = nxt; cA = nA; cB = nB; ++ui;
        if constexpr (ALIGN_EPI) { if (wr == 1) PG8_BAR; }
    }
    PG8_WAIT_V(0);
    if constexpr (!ALIGN_EPI) { if (wr == 0) PG8_BAR; }
    PG8_BAR;
    if constexpr (Epi::AFTER_DRAIN) { E.fused(acc, cur, wr, wc, fr, fq, lds, wid, lane); S.done(cur); }
#undef PG8_SA
#undef PG8_SB
#undef PG8_STAGE
#undef PG8_LDA
#undef PG8_LDB
#undef PG8_MMA
#undef PG8_WAIT_V
#undef PG8_WAIT_L
#undef PG8_BAR
#undef PG8_SCHED
}
}

namespace att {
#define LAS __attribute__((address_space(3)))
typedef unsigned short bf16_t;
typedef short bf16x8 __attribute__((ext_vector_type(8)));
typedef short s16x4 __attribute__((ext_vector_type(4)));
typedef short v4i16_t __attribute__((ext_vector_type(4)));
typedef float f32x16 __attribute__((ext_vector_type(16)));
typedef float f32x4 __attribute__((ext_vector_type(4)));
typedef unsigned u32x4 __attribute__((ext_vector_type(4)));
typedef unsigned u32x2 __attribute__((ext_vector_type(2)));
using pg8::cvtpk;
__device__ __forceinline__ s16x4 vtr(const LAS unsigned char* p) { return __builtin_bit_cast(s16x4, __builtin_amdgcn_ds_read_tr16_b64_v4i16((LAS v4i16_t*)p)); }
__device__ __forceinline__ int crow(int i, int h) { return (i & 3) + 8 * (i >> 2) + 4 * h; }
__device__ __forceinline__ float xhalf_max(float v) { auto rr = __builtin_amdgcn_permlane32_swap(__float_as_uint(v), __float_as_uint(v), false, false); return fmaxf(__uint_as_float(rr[0]), __uint_as_float(rr[1])); }
__device__ __forceinline__ float xhalf_sum(float v) { auto rr = __builtin_amdgcn_permlane32_swap(__float_as_uint(v), __float_as_uint(v), false, false); return __uint_as_float(rr[0]) + __uint_as_float(rr[1]); }
#define MFMA32(a, b, c) __builtin_amdgcn_mfma_f32_32x32x16_bf16((a), (b), (c), 0, 0, 0)
constexpr float NEGV = -1e30f;
constexpr int ATT_LDS_MAX = 2 * (64 * 272 + 64 * 320);

#ifndef ATT_PROBE
#define ATT_PROBE 0
#endif
#if ATT_PROBE
#define ATT_TS(k) do { if ((k) == ATT_PROBE - 1) att_t = __builtin_amdgcn_s_memrealtime(); if ((k) == ATT_PROBE) att_acc += __builtin_amdgcn_s_memrealtime() - att_t; } while (0)
#else
#define ATT_TS(k) do {} while (0)
#endif
template <int KW, int DV, bool SWA>
__device__ __forceinline__ void attn_unit(LAS unsigned char* lds, const int tid, const int wid, const int lane,
                                          bf16_t* Qw, const bf16_t* Kreal, const bf16_t* Kmeta, const int kpitch, const bf16_t* Vreal, const bf16_t* Vmeta, const int vpitch,
                                          const int t0, const int t1, const int qrel0, const float sink_l2, const float lam, const float* gain, bf16_t* Od, unsigned long long& att_acc) {
    unsigned long long att_t = 0; (void)att_t;
    constexpr int KP = KW * 2 + 16, VP = (DV == 64) ? 192 : 320, KBUF = 64 * KP, VBUF = 64 * VP;
    constexpr int NKC = KW / 64, NVC = DV / 64, KCPR = KW / 8, VCPR = DV / 8, NDB = DV / 32;
    constexpr float THR = 8.f;
    const int r = lane & 31, h = lane >> 5;
    bf16x8 qf[4];
#pragma unroll
    for (int st = 0; st < 4; ++st) qf[st] = *(const bf16x8*)(Qw + (size_t)r * 2048 + 16 * st + 8 * h);
    u32x4 kreg[1][NKC], vreg[1][NVC];
    const int krow_ = tid / KCPR, kcc_ = tid % KCPR, vrow_ = tid / VCPR, vcc_ = tid % VCPR;
#define ATT_LOAD(S, Ks, Vs) do { \
        _Pragma("unroll") for (int i_ = 0; i_ < NKC; ++i_) kreg[S][i_] = *(const u32x4*)((Ks) + (size_t)(krow_ + i_ * (512 / KCPR)) * kpitch + kcc_ * 8); \
        _Pragma("unroll") for (int i_ = 0; i_ < NVC; ++i_) vreg[S][i_] = *(const u32x4*)((Vs) + (size_t)(vrow_ + i_ * (512 / VCPR)) * vpitch + vcc_ * 8); } while (0)
#define ATT_STORE(S, buf) do { \
        _Pragma("unroll") for (int i_ = 0; i_ < NKC; ++i_) *(LAS u32x4*)(lds + (buf) * KBUF + (krow_ + i_ * (512 / KCPR)) * KP + kcc_ * 16) = kreg[S][i_]; \
        _Pragma("unroll") for (int i_ = 0; i_ < NVC; ++i_) *(LAS u32x4*)(lds + 2 * KBUF + (buf) * VBUF + (vrow_ + i_ * (512 / VCPR)) * VP + vcc_ * 16) = vreg[S][i_]; } while (0)
    const int nt = 1 + (t1 - t0);
    ATT_LOAD(0, Kmeta, Vmeta);
    ATT_STORE(0, 0);
    ATT_LOAD(0, Kreal + (size_t)t0 * 64 * kpitch, Vreal + (size_t)t0 * 64 * vpitch);
    __syncthreads();
    const int kcolw = SWA ? 0 : 64 * (wid >> 2);
    const int koff = r * KP + (kcolw + 8 * h) * 2;
    const int voff = (4 * h + ((lane & 15) >> 2)) * VP + (16 * ((lane >> 4) & 1) + 4 * (lane & 3)) * 2;
    f32x16 o[NDB];
    float mhat, l;
    f32x16 s0, s1;
    bf16x8 pf[4];
#define ATT_QK(buf, C0) do { const LAS unsigned char* kb_ = lds + (buf) * KBUF + koff; \
        __builtin_amdgcn_s_setprio(1); \
        _Pragma("unroll") for (int st = 0; st < 4; ++st) { \
            const bf16x8 a0_ = *(const LAS bf16x8*)(kb_ + st * 32), a1_ = *(const LAS bf16x8*)(kb_ + 32 * KP + st * 32); \
            if (st == 0) { s0 = MFMA32(a0_, qf[0], C0); s1 = MFMA32(a1_, qf[0], C0); } else { s0 = MFMA32(a0_, qf[st], s0); s1 = MFMA32(a1_, qf[st], s1); } } \
        __builtin_amdgcn_s_setprio(0); } while (0)
#define ATT_MAX(mx) do { float a_ = fmaxf(fmaxf(s0[0], s0[1]), s1[0]), b_ = fmaxf(fmaxf(s0[2], s0[3]), s1[1]); a_ = fmaxf(fmaxf(a_, s1[2]), s1[3]); \
        _Pragma("unroll") for (int i = 4; i < 16; i += 4) { a_ = fmaxf(fmaxf(a_, s0[i]), s0[i + 1]); b_ = fmaxf(fmaxf(b_, s0[i + 2]), s0[i + 3]); a_ = fmaxf(fmaxf(a_, s1[i]), s1[i + 1]); b_ = fmaxf(fmaxf(b_, s1[i + 2]), s1[i + 3]); } \
        mx = fmaxf(a_, b_); mx = xhalf_max(mx); } while (0)
#define ATT_EXP_PACK() do { float ra_ = 0.f, rb_ = 0.f; \
        _Pragma("unroll") for (int i = 0; i < 16; ++i) { s0[i] = __builtin_amdgcn_exp2f(s0[i]); s1[i] = __builtin_amdgcn_exp2f(s1[i]); ra_ += s0[i]; rb_ += s1[i]; } \
        l += ra_ + rb_; u32x4 w_; \
        w_.x = cvtpk(s0[0], s0[1]); w_.y = cvtpk(s0[2], s0[3]); w_.z = cvtpk(s0[4], s0[5]); w_.w = cvtpk(s0[6], s0[7]); pf[0] = __builtin_bit_cast(bf16x8, w_); \
        w_.x = cvtpk(s0[8], s0[9]); w_.y = cvtpk(s0[10], s0[11]); w_.z = cvtpk(s0[12], s0[13]); w_.w = cvtpk(s0[14], s0[15]); pf[1] = __builtin_bit_cast(bf16x8, w_); \
        w_.x = cvtpk(s1[0], s1[1]); w_.y = cvtpk(s1[2], s1[3]); w_.z = cvtpk(s1[4], s1[5]); w_.w = cvtpk(s1[6], s1[7]); pf[2] = __builtin_bit_cast(bf16x8, w_); \
        w_.x = cvtpk(s1[8], s1[9]); w_.y = cvtpk(s1[10], s1[11]); w_.z = cvtpk(s1[12], s1[13]); w_.w = cvtpk(s1[14], s1[15]); pf[3] = __builtin_bit_cast(bf16x8, w_); } while (0)
#define ATT_EXP_H(S, P0_, P1_) do { float ra_ = 0.f, rb_ = 0.f; \
        _Pragma("unroll") for (int i = 0; i < 16; i += 2) { S[i] = __builtin_amdgcn_exp2f(S[i]); S[i + 1] = __builtin_amdgcn_exp2f(S[i + 1]); ra_ += S[i]; rb_ += S[i + 1]; } \
        l += ra_ + rb_; u32x4 w_; \
        w_.x = cvtpk(S[0], S[1]); w_.y = cvtpk(S[2], S[3]); w_.z = cvtpk(S[4], S[5]); w_.w = cvtpk(S[6], S[7]); P0_ = __builtin_bit_cast(bf16x8, w_); \
        w_.x = cvtpk(S[8], S[9]); w_.y = cvtpk(S[10], S[11]); w_.z = cvtpk(S[12], S[13]); w_.w = cvtpk(S[14], S[15]); P1_ = __builtin_bit_cast(bf16x8, w_); } while (0)
    s16x4 vlo[2][NDB], vhi[2][NDB];
#define ATT_VRD(buf, ks, B) do { const LAS unsigned char* vb_ = lds + 2 * KBUF + (buf) * VBUF + voff; \
        _Pragma("unroll") for (int db = 0; db < NDB; ++db) { vlo[B][db] = vtr(vb_ + (16 * (ks)) * VP + db * 64); vhi[B][db] = vtr(vb_ + (16 * (ks) + 8) * VP + db * 64); } } while (0)
#define ATT_PV(buf, NKS) do { \
        __builtin_amdgcn_s_setprio(1); \
        _Pragma("unroll") for (int ks = 0; ks < (NKS); ++ks) { \
            if (ks + 1 < (NKS)) ATT_VRD(buf, ks + 1, (ks + 1) & 1); \
            _Pragma("unroll") for (int db = 0; db < NDB; ++db) { \
                const bf16x8 va_ = __builtin_shufflevector(vlo[ks & 1][db], vhi[ks & 1][db], 0, 1, 2, 3, 4, 5, 6, 7); \
                o[db] = MFMA32(va_, pf[ks], o[db]); } \
            __builtin_amdgcn_sched_barrier(0); } \
        __builtin_amdgcn_s_setprio(0); } while (0)
#define ATT_SMPV(buf) do { \
        ATT_EXP_H(s0, pf[0], pf[1]); \
        __builtin_amdgcn_sched_barrier(0); \
        ATT_VRD(buf, 1, 1); \
        _Pragma("unroll") for (int db = 0; db < NDB; ++db) { const bf16x8 va_ = __builtin_shufflevector(vlo[0][db], vhi[0][db], 0, 1, 2, 3, 4, 5, 6, 7); o[db] = MFMA32(va_, pf[0], o[db]); } \
        ATT_VRD(buf, 2, 0); \
        _Pragma("unroll") for (int db = 0; db < NDB; ++db) { const bf16x8 va_ = __builtin_shufflevector(vlo[1][db], vhi[1][db], 0, 1, 2, 3, 4, 5, 6, 7); o[db] = MFMA32(va_, pf[1], o[db]); } \
        ATT_EXP_H(s1, pf[2], pf[3]); \
        _Pragma("unroll") for (int g_ = 0; g_ < 2 * NDB; ++g_) { __builtin_amdgcn_sched_group_barrier(0x008, 1, 0); __builtin_amdgcn_sched_group_barrier(0x100, 2, 0); __builtin_amdgcn_sched_group_barrier(0x002, 40 / (2 * NDB), 0); } \
        __builtin_amdgcn_sched_barrier(0); \
        ATT_VRD(buf, 3, 1); \
        _Pragma("unroll") for (int db = 0; db < NDB; ++db) { const bf16x8 va_ = __builtin_shufflevector(vlo[0][db], vhi[0][db], 0, 1, 2, 3, 4, 5, 6, 7); o[db] = MFMA32(va_, pf[2], o[db]); } \
        __builtin_amdgcn_sched_barrier(0); \
        _Pragma("unroll") for (int db = 0; db < NDB; ++db) { const bf16x8 va_ = __builtin_shufflevector(vlo[1][db], vhi[1][db], 0, 1, 2, 3, 4, 5, 6, 7); o[db] = MFMA32(va_, pf[3], o[db]); } \
        __builtin_amdgcn_sched_barrier(0); } while (0)
    f32x16 zero16;
#pragma unroll
    for (int i = 0; i < 16; ++i) zero16[i] = 0.f;
    {
        ATT_QK(0, zero16);
#pragma unroll
        for (int i = 0; i < 16; ++i) { if (i >= 8) s0[i] = NEGV; s1[i] = NEGV; }
        ATT_VRD(0, 0, 0);
        float mx; ATT_MAX(mx);
        mhat = mx; l = 0.f;
#pragma unroll
        for (int i = 0; i < 16; ++i) { s0[i] -= mx; s1[i] -= mx; }
        ATT_EXP_PACK();
#pragma unroll
        for (int db = 0; db < NDB; ++db) o[db] = zero16;
        ATT_PV(0, 1);
        ATT_STORE(0, 1);
        if (2 < nt) ATT_LOAD(0, Kreal + (size_t)(t0 + 1) * 64 * kpitch, Vreal + (size_t)(t0 + 1) * 64 * vpitch);
        __syncthreads();
    }
#define ATT_TILE(it, PAR) do { \
          \
        bool skip_ = false, edge_ = false; \
        if (SWA) { const int k0_ = (t0 + (it) - 1) * 64; skip_ = (k0_ > qrel0 + 31 + 128) || (k0_ + 63 < qrel0 - 128); edge_ = !((k0_ >= qrel0 + 31 - 128) && (k0_ + 63 <= qrel0 + 128)); } \
        if (!skip_) { f32x16 negm_; _Pragma("unroll") for (int i = 0; i < 16; ++i) negm_[i] = -mhat; \
            ATT_QK(PAR, negm_); } \
        if ((it) + 1 < nt) ATT_STORE(0, (PAR) ^ 1);                       \
        if ((it) + 2 < nt) ATT_LOAD(0, Kreal + (size_t)(t0 + (it) + 1) * 64 * kpitch, Vreal + (size_t)(t0 + (it) + 1) * 64 * vpitch);     \
        if (!skip_) { \
            ATT_VRD(PAR, 0, 0);                                           \
            if (SWA && edge_) { const int d0_ = (t0 + (it) - 1) * 64 - (qrel0 + r); \
                _Pragma("unroll") for (int i = 0; i < 16; ++i) { const int d_ = d0_ + crow(i, h); if (d_ < -128 || d_ > 128) s0[i] = NEGV; if (d_ + 32 < -128 || d_ + 32 > 128) s1[i] = NEGV; } } \
            float mx_; ATT_MAX(mx_); \
            if (__builtin_expect(__any(mx_ > THR), 0)) { const float dl_ = fmaxf(mx_, 0.f); mhat += dl_; \
                _Pragma("unroll") for (int i = 0; i < 16; ++i) { s0[i] -= dl_; s1[i] -= dl_; } \
                const float f_ = __builtin_amdgcn_exp2f(-dl_); l *= f_; \
                _Pragma("unroll") for (int db = 0; db < NDB; ++db) _Pragma("unroll") for (int i = 0; i < 16; ++i) o[db][i] *= f_; } \
            ATT_SMPV(PAR); } \
        __syncthreads(); } while (0)
    for (int it = 1; it < nt; it += 2) { ATT_TILE(it, 1); ATT_TILE(it + 1, 0); }
#undef ATT_TILE
#undef ATT_QK
#undef ATT_MAX
#undef ATT_EXP_PACK
#undef ATT_PV
#undef ATT_SMPV
#undef ATT_EXP_H
#undef ATT_VRD
#undef ATT_LOAD
#undef ATT_STORE
    const float m = mhat;
    l = xhalf_sum(l);
    if constexpr (SWA) {
        l += __builtin_amdgcn_exp2f(sink_l2 - m);
        const float inv = 1.f / l;
#pragma unroll
        for (int db = 0; db < NDB; ++db)
#pragma unroll
            for (int g4 = 0; g4 < 4; ++g4) {
                u32x2 w; w.x = cvtpk(o[db][4 * g4] * inv, o[db][4 * g4 + 1] * inv); w.y = cvtpk(o[db][4 * g4 + 2] * inv, o[db][4 * g4 + 3] * inv);
                *(u32x2*)(Qw + (size_t)r * 2048 + 32 * db + 8 * g4 + 4 * h) = w;
            }
    } else {
        const float inv = 1.f / l;
        LAS float* xb = (LAS float*)lds;
        if (wid >= 4) {
            const float sc = lam * inv;
#pragma unroll
            for (int db = 0; db < NDB; ++db)
#pragma unroll
                for (int i = 0; i < 16; ++i) xb[((wid - 4) * 128 + 32 * db + crow(i, h)) * 32 + r] = o[db][i] * sc;
        }
        __syncthreads();
        if (wid < 4) {
            float ss = 0.f;
#pragma unroll
            for (int db = 0; db < NDB; ++db)
#pragma unroll
                for (int i = 0; i < 16; ++i) { const float v = o[db][i] * inv - xb[(wid * 128 + 32 * db + crow(i, h)) * 32 + r]; o[db][i] = v; ss += v * v; }
            ss = xhalf_sum(ss);
            const float rstd = 0.8f / sqrtf(ss * (1.f / 128.f) + 1e-6f);
#pragma unroll
            for (int db = 0; db < NDB; ++db)
#pragma unroll
                for (int g4 = 0; g4 < 4; ++g4) {
                    const int d = 32 * db + 8 * g4 + 4 * h; const f32x4 gg = *(const f32x4*)(gain + d);
                    u32x2 w; w.x = cvtpk(o[db][4 * g4] * rstd * gg[0], o[db][4 * g4 + 1] * rstd * gg[1]); w.y = cvtpk(o[db][4 * g4 + 2] * rstd * gg[2], o[db][4 * g4 + 3] * rstd * gg[3]);
                    *(u32x2*)(Od + (size_t)r * 2048 + d) = w;
                }
        }
        __syncthreads();
    }
}
constexpr int SW_KP = 144, SW_VP = 192, SW_KT = 64 * SW_KP, SW_VT = 64 * SW_VP, SW_VOFF = 7 * SW_KT, SW_LDS = 7 * (SW_KT + SW_VT);
__device__ __forceinline__ void swa_unit(LAS unsigned char* lds, const int tid, const int wid, const int lane, bf16_t* QOrow  ,
                                         const bf16_t* Kreal, const bf16_t* Kmeta, const bf16_t* Vreal, const bf16_t* Vmeta, const int t0, const int ntr, const int qblk0, const float* sink4) {
    constexpr float THR = 8.f;
    const int r = lane & 31, h = lane >> 5;
    {
        u32x4 kr[7], vr[7];
        const int row = tid >> 3, cc = tid & 7;
#pragma unroll
        for (int j = 0; j < 7; ++j) if (j <= ntr) {
            const bf16_t* ks = (j == 0) ? Kmeta : Kreal + (size_t)(t0 + j - 1) * 64 * 256; const bf16_t* vs = (j == 0) ? Vmeta : Vreal + (size_t)(t0 + j - 1) * 64 * 256;
            kr[j] = *(const u32x4*)(ks + (size_t)row * 256 + cc * 8); vr[j] = *(const u32x4*)(vs + (size_t)row * 256 + cc * 8); }
#pragma unroll
        for (int j = 0; j < 7; ++j) if (j <= ntr) {
            *(LAS u32x4*)(lds + j * SW_KT + row * SW_KP + cc * 16) = kr[j]; *(LAS u32x4*)(lds + SW_VOFF + j * SW_VT + row * SW_VP + cc * 16) = vr[j]; }
    }
    __syncthreads();
    const int koff = r * SW_KP + (8 * h) * 2;
    const int voff = (4 * h + ((lane & 15) >> 2)) * SW_VP + (16 * ((lane >> 4) & 1) + 4 * (lane & 3)) * 2;
    f32x16 zero16;
#pragma unroll
    for (int i = 0; i < 16; ++i) zero16[i] = 0.f;
    const int qrel0 = qblk0 + 32 * (wid & 3);
#pragma unroll 1
    for (int pass = 0; pass < 2; ++pass) {
        const int hd = 2 * pass + (wid >> 2);
        bf16_t* Qw = QOrow + (size_t)(32 * (wid & 3)) * 2048 + hd * 64;
        bf16x8 qf[4];
#pragma unroll
        for (int st = 0; st < 4; ++st) qf[st] = *(const bf16x8*)(Qw + (size_t)r * 2048 + 16 * st + 8 * h);
        const float sink_l2 = sink4[hd] * 1.4426950408889634f;
        f32x16 o[2], s0, s1; bf16x8 pf[4]; float mhat, l = 0.f;
#define SW_QK(j, C0) do { const LAS unsigned char* kb_ = lds + (j) * SW_KT + koff; \
        _Pragma("unroll") for (int st = 0; st < 4; ++st) { \
            const bf16x8 a0_ = *(const LAS bf16x8*)(kb_ + st * 32), a1_ = *(const LAS bf16x8*)(kb_ + 32 * SW_KP + st * 32); \
            if (st == 0) { s0 = MFMA32(a0_, qf[0], C0); s1 = MFMA32(a1_, qf[0], C0); } else { s0 = MFMA32(a0_, qf[st], s0); s1 = MFMA32(a1_, qf[st], s1); } } } while (0)
#define SW_MAX(mx) do { float a_ = fmaxf(fmaxf(s0[0], s0[1]), s1[0]), b_ = fmaxf(fmaxf(s0[2], s0[3]), s1[1]); a_ = fmaxf(fmaxf(a_, s1[2]), s1[3]); \
        _Pragma("unroll") for (int i = 4; i < 16; i += 4) { a_ = fmaxf(fmaxf(a_, s0[i]), s0[i + 1]); b_ = fmaxf(fmaxf(b_, s0[i + 2]), s0[i + 3]); a_ = fmaxf(fmaxf(a_, s1[i]), s1[i + 1]); b_ = fmaxf(fmaxf(b_, s1[i + 2]), s1[i + 3]); } \
        mx = xhalf_max(fmaxf(a_, b_)); } while (0)
#define SW_EXP_H(S, P0_, P1_) do { float ra_ = 0.f, rb_ = 0.f; \
        _Pragma("unroll") for (int i = 0; i < 16; i += 2) { S[i] = __builtin_amdgcn_exp2f(S[i]); S[i + 1] = __builtin_amdgcn_exp2f(S[i + 1]); ra_ += S[i]; rb_ += S[i + 1]; } \
        l += ra_ + rb_; u32x4 w_; \
        w_.x = cvtpk(S[0], S[1]); w_.y = cvtpk(S[2], S[3]); w_.z = cvtpk(S[4], S[5]); w_.w = cvtpk(S[6], S[7]); P0_ = __builtin_bit_cast(bf16x8, w_); \
        w_.x = cvtpk(S[8], S[9]); w_.y = cvtpk(S[10], S[11]); w_.z = cvtpk(S[12], S[13]); w_.w = cvtpk(S[14], S[15]); P1_ = __builtin_bit_cast(bf16x8, w_); } while (0)
#define SW_PV(j, NKS) do { const LAS unsigned char* vb_ = lds + SW_VOFF + (j) * SW_VT + voff; \
        _Pragma("unroll") for (int ks = 0; ks < (NKS); ++ks) \
            _Pragma("unroll") for (int db = 0; db < 2; ++db) { \
                const s16x4 lo_ = vtr(vb_ + (16 * ks) * SW_VP + db * 64), hi_ = vtr(vb_ + (16 * ks + 8) * SW_VP + db * 64); \
                const bf16x8 va_ = __builtin_shufflevector(lo_, hi_, 0, 1, 2, 3, 4, 5, 6, 7); \
                o[db] = MFMA32(va_, pf[ks], o[db]); } } while (0)
        {
            SW_QK(0, zero16);
#pragma unroll
            for (int i = 0; i < 16; ++i) { if (i >= 8) s0[i] = NEGV; s1[i] = NEGV; }
            float mx; SW_MAX(mx);
            mhat = mx;
#pragma unroll
            for (int i = 0; i < 16; ++i) s0[i] -= mx;
            SW_EXP_H(s0, pf[0], pf[1]);
            o[0] = zero16; o[1] = zero16;
            SW_PV(0, 1);
        }
#pragma unroll 1
        for (int j = 1; j <= ntr; ++j) {
            const int k0 = (t0 + j - 1) * 64;
            if ((k0 > qrel0 + 31 + 128) || (k0 + 63 < qrel0 - 128)) continue;
            const bool edge = !((k0 >= qrel0 + 31 - 128) && (k0 + 63 <= qrel0 + 128));
            f32x16 negm_;
#pragma unroll
            for (int i = 0; i < 16; ++i) negm_[i] = -mhat;
            SW_QK(j, negm_);
            if (edge) { const int d0_ = k0 - (qrel0 + r);
#pragma unroll
                for (int i = 0; i < 16; ++i) { const int d_ = d0_ + crow(i, h); if (d_ < -128 || d_ > 128) s0[i] = NEGV; if (d_ + 32 < -128 || d_ + 32 > 128) s1[i] = NEGV; } }
            float mx_; SW_MAX(mx_);
            if (__builtin_expect(__any(mx_ > THR), 0)) { const float dl_ = fmaxf(mx_, 0.f); mhat += dl_;
#pragma unroll
                for (int i = 0; i < 16; ++i) { s0[i] -= dl_; s1[i] -= dl_; }
                const float f_ = __builtin_amdgcn_exp2f(-dl_); l *= f_;
#pragma unroll
                for (int db = 0; db < 2; ++db)
#pragma unroll
                    for (int i = 0; i < 16; ++i) o[db][i] *= f_; }
            SW_EXP_H(s0, pf[0], pf[1]); SW_EXP_H(s1, pf[2], pf[3]);
            SW_PV(j, 4);
        }
#undef SW_QK
#undef SW_MAX
#undef SW_EXP_H
#undef SW_PV
        l = xhalf_sum(l);
        l += __builtin_amdgcn_exp2f(sink_l2 - mhat);
        const float inv = 1.f / l;
#pragma unroll
        for (int db = 0; db < 2; ++db)
#pragma unroll
            for (int g4 = 0; g4 < 4; ++g4) {
                u32x2 w; w.x = cvtpk(o[db][4 * g4] * inv, o[db][4 * g4 + 1] * inv); w.y = cvtpk(o[db][4 * g4 + 2] * inv, o[db][4 * g4 + 3] * inv);
                *(u32x2*)(Qw + (size_t)r * 2048 + 32 * db + 8 * g4 + 4 * h) = w;
            }
    }
    __syncthreads();
}
}

typedef unsigned short bf16;
typedef float f32x4 __attribute__((ext_vector_type(4)));
typedef unsigned u32x4 __attribute__((ext_vector_type(4)));
typedef unsigned u32x2 __attribute__((ext_vector_type(2)));
using pg8::cvtpk; using pg8::bf_lo; using pg8::bf_hi;
constexpr int NTOK = 32768, DM = 1024, NIN = 6656, DFF = 2816, SEQL = 2048;
constexpr float RMS_EPS = 1e-6f;
constexpr int LDS_MAIN = 151552, LDS_BYTES = LDS_MAIN + 256;
static_assert(att::ATT_LDS_MAX <= LDS_MAIN && att::SW_LDS <= LDS_MAIN && pg8::STAGE_BYTES <= LDS_MAIN, "LDS map");

__device__ __forceinline__ float wave_sum(float v) {
#pragma unroll
    for (int o = 1; o < 64; o <<= 1) v += __shfl_xor(v, o);
    return v;
}
template <int MODE> __device__ __forceinline__ int rowmap(int n) {
    if (MODE == 1) {
        const bool perm = (n < 1280) || (n >= 1536 && n < 3584);
        if (!perm) return n;
        const int d = n & 63; return (n & ~63) + ((d < 32) ? 2 * d : 2 * (d - 32) + 1);
    } else if (MODE == 2) {
        if (n < DFF) return 8 * (n >> 2) + (n & 3);
        const int j = n - DFF; return 8 * (j >> 2) + 4 + (j & 3);
    }
    return n;
}
template <int MODE> __device__ __forceinline__ void p0_transpose_item(const float* W, int N, bf16* WT, int ldk, int koff, LAS float* scr, int item, int lane, const float* kscale = nullptr) {
    const int nblk = N / 32, kb = item / nblk, nb = item % nblk, k0 = 64 * kb, n0 = 32 * nb;
#pragma unroll 8
    for (int i = 0; i < 32; ++i) { const int kk = 2 * i + (lane >> 5); scr[kk * 33 + (lane & 31)] = W[(size_t)(k0 + kk) * N + n0 + (lane & 31)]; }
    asm volatile("s_waitcnt lgkmcnt(0)" ::: "memory");
    const int c = lane & 7;
    f32x4 ks0 = {1.f, 1.f, 1.f, 1.f}, ks1 = {1.f, 1.f, 1.f, 1.f};
    if (kscale) { ks0 = *(const f32x4*)(kscale + k0 + 8 * c); ks1 = *(const f32x4*)(kscale + k0 + 8 * c + 4); }
#pragma unroll
    for (int j = 0; j < 4; ++j) { const int n = (lane >> 3) + 8 * j; const LAS float* s = scr + (8 * c) * 33 + n;
        u32x4 o; o.x = cvtpk(s[0 * 33] * ks0[0], s[1 * 33] * ks0[1]); o.y = cvtpk(s[2 * 33] * ks0[2], s[3 * 33] * ks0[3]); o.z = cvtpk(s[4 * 33] * ks1[0], s[5 * 33] * ks1[1]); o.w = cvtpk(s[6 * 33] * ks1[2], s[7 * 33] * ks1[3]);
        *(u32x4*)(WT + (size_t)rowmap<MODE>(n0 + n) * ldk + koff + k0 + 8 * c) = o; }
    asm volatile("s_waitcnt lgkmcnt(0)" ::: "memory");
}

#define XB_TMO      128
#define XB_XCNT(j)  (256  + 64 * (j))
#define XB_XSUB(j)  (1280 + 64 * (j))
#define XB_XGEN(j)  (2304 + 64 * (j))
#define XB_TOP      3328
#define XB_TOPGEN   3392
#define XCD_BAR_WORDS 3456
#define XB_SPIN_CAP (1u << 18)

__device__ __forceinline__ unsigned xb_ld(unsigned* p)              { return __hip_atomic_load(p, __ATOMIC_RELAXED, __HIP_MEMORY_SCOPE_AGENT); }
__device__ __forceinline__ unsigned xb_add(unsigned* p, unsigned v) { return __hip_atomic_fetch_add(p, v, __ATOMIC_RELAXED, __HIP_MEMORY_SCOPE_AGENT); }
__device__ __forceinline__ unsigned xb_xcc_id() { return (unsigned)__builtin_amdgcn_s_getreg((3 << 11) | 20) & 0xFu; }
#define XB_SPIN(cond, bar) do { unsigned _sp = 0; while (cond) { __builtin_amdgcn_s_sleep(1); \
    if ((++_sp & 255u) == 0u) { if (xb_ld(&(bar)[XB_TMO])) break; if (_sp > XB_SPIN_CAP) { atomicAdd(&(bar)[XB_TMO], 1u); break; } } } } while (0)

struct XcdBarrier {
    unsigned* bar; unsigned x;
    volatile LAS unsigned* st;
};

__device__ __forceinline__ XcdBarrier xcd_barrier_post(unsigned* bar, volatile LAS unsigned* st) {
    XcdBarrier b; b.bar = bar; b.x = xb_xcc_id(); b.st = st;
    if (threadIdx.x == 0) (void)xb_add(&bar[XB_XCNT(b.x)], 1u);
    return b;
}
__device__ __forceinline__ void xcd_barrier_complete(unsigned* bar, unsigned x, unsigned& nloc, unsigned& nx) {
    const unsigned G = gridDim.x * gridDim.y * gridDim.z;
    unsigned sum, cnt, mine, sp = 0u;
    for (;;) {
        sum = 0u; cnt = 0u; mine = 0u;
#pragma unroll
        for (unsigned j = 0; j < 16; ++j) { const unsigned c = xb_ld(&bar[XB_XCNT(j)]); sum += c; cnt += (c > 0u) ? 1u : 0u; mine = (j == x) ? c : mine; }
        if (sum == G) break;
        __builtin_amdgcn_s_sleep(1);
        if ((++sp & 255u) == 0u) { if (xb_ld(&bar[XB_TMO])) break; if (sp > XB_SPIN_CAP) { atomicAdd(&bar[XB_TMO], 1u); break; } }
    }
    nloc = mine > 0u ? mine : 1u; nx = cnt > 0u ? cnt : 1u;
}

__device__ __forceinline__ void xcd_barrier(const XcdBarrier& b) {
    asm volatile("s_waitcnt vmcnt(0)" ::: "memory");
    __syncthreads();
    if (threadIdx.x == 0) {
        unsigned* bar = b.bar;
        __builtin_amdgcn_s_waitcnt(0);
        unsigned nloc = b.st[0], nx = b.st[1];
        if (nloc == 0u) { xcd_barrier_complete(bar, b.x, nloc, nx); b.st[0] = nloc; b.st[1] = nx; }
        const unsigned old = xb_add(&bar[XB_XSUB(b.x)], 1u);
        const unsigned gen = old / nloc;
        if (old + 1u == (gen + 1u) * nloc) {
            __builtin_amdgcn_fence(__ATOMIC_RELEASE, "agent");
            asm volatile("s_waitcnt vmcnt(0)" ::: "memory");
            const unsigned og = xb_add(&bar[XB_TOP], 1u);
            const unsigned tg = og / nx;
            if (og + 1u == (tg + 1u) * nx) xb_add(&bar[XB_TOPGEN], 1u);
            else XB_SPIN(xb_ld(&bar[XB_TOPGEN]) == tg, bar);
            __builtin_amdgcn_fence(__ATOMIC_ACQUIRE, "agent");
            xb_add(&bar[XB_XGEN(b.x)], 1u);
            asm volatile("s_waitcnt vmcnt(0)" ::: "memory");
        } else {
            XB_SPIN(xb_ld(&bar[XB_XGEN(b.x)]) == gen, bar);
            __builtin_amdgcn_fence(__ATOMIC_ACQUIRE, "agent");
            asm volatile("s_waitcnt vmcnt(0)" ::: "memory");
        }
    }
    __syncthreads();
}

constexpr size_t WS_BAR = 512 * 1024;
#ifndef PH_MASK
#define PH_MASK 0x1ff
#endif
#define PH_ON(k) ((PH_MASK >> (k)) & 1)
#ifndef PROBE_PHASE
#define PROBE_PHASE (-1)
#endif
#define PROBE_T0(k) do { if (PROBE_PHASE == (k) && threadIdx.x == 0) probe_t0 = __builtin_amdgcn_s_memrealtime(); } while (0)
#define PROBE_DELAY(k) do { if (PROBE_PHASE == (k)) { if (threadIdx.x == 0) { const unsigned long long t1_ = __builtin_amdgcn_s_memrealtime(), dt_ = t1_ - probe_t0; while (__builtin_amdgcn_s_memrealtime() - t1_ < dt_) __builtin_amdgcn_s_sleep(8); } __syncthreads(); } } while (0)
struct Args { const float* in[19]; float* out; unsigned char* ws; };

__global__ void __launch_bounds__(512, 2) fwd_megakernel(Args a) {
    extern __shared__ __attribute__((aligned(16))) unsigned char lds_raw[];
    cg::grid_group grid = cg::this_grid();
    LAS unsigned char* lds = (LAS unsigned char*)lds_raw;
    const int tid = threadIdx.x, lane = tid & 63, wid = __builtin_amdgcn_readfirstlane(tid >> 6);
    const int G = gridDim.x, bx = blockIdx.x;
    const int vcu = (G % 8 == 0) ? (bx % 8) * (G / 8) + bx / 8 : bx;
    const int gw = bx * 8 + wid, NGW = G * 8;
    unsigned char* ws = a.ws;
    unsigned long long probe_t0 = 0; (void)probe_t0;
    volatile LAS unsigned* xb_st = (volatile LAS unsigned*)(lds + LDS_MAIN);
    if (threadIdx.x < 2) xb_st[threadIdx.x] = 0u;
    __syncthreads();
    const XcdBarrier xbar = xcd_barrier_post((unsigned*)(ws + WS_BAR), xb_st);
#define p_x (a.in[0])
#define p_meta_tokens (a.in[1])
#define p_pre_mix_gain (a.in[2])
#define p_w_in (a.in[3])
#define p_b_gate (a.in[4])
#define p_attn_sink (a.in[5])
#define p_lq1 (a.in[6])
#define p_lk1 (a.in[7])
#define p_lq2 (a.in[8])
#define p_lk2 (a.in[9])
#define p_subln_gain (a.in[10])
#define p_w_bswa (a.in[11])
#define p_w_bdiff (a.in[12])
#define p_w_out (a.in[13])
#define p_post_mix_gain (a.in[14])
#define p_pre_ffn_gain (a.in[15])
#define p_w_ffn_in (a.in[16])
#define p_w_ffn_out (a.in[17])
#define p_post_ffn_gain (a.in[18])
#define p_ss1 ((float*)(ws + WS_SS1))
#define p_ss3 ((float*)(ws + WS_SS3))
#define p_rope ((float*)(ws + WS_ROPE))
#define p_KAm ((bf16*)(ws + WS_KAM))
#define p_VAm ((bf16*)(ws + WS_VAM))
#define p_KBm ((bf16*)(ws + WS_KBM))
#define p_VBm ((bf16*)(ws + WS_VBM))
#define p_Win_t ((bf16*)(ws + WS_WIN))
#define p_Wcat_t ((bf16*)(ws + WS_WCAT))
#define p_Wout_t ((bf16*)(ws + WS_WOUT))
#define p_Wffi_t ((bf16*)(ws + WS_WFFI))
#define p_Wffo_t ((bf16*)(ws + WS_WFFO))
#define p_U ((bf16*)(ws + WS_U))
#define p_QO ((bf16*)(ws + WS_QO))
#define p_KA ((bf16*)(ws + WS_KA))
#define p_VA ((bf16*)(ws + WS_VA))
#define p_KB ((bf16*)(ws + WS_KB))
#define p_VB ((bf16*)(ws + WS_VB))
#define p_MERGED ((bf16*)(ws + WS_MERGED))
#define p_Y ((bf16*)(ws + WS_Y))
#define p_F ((bf16*)(ws + WS_F))
#define p_FO ((bf16*)(ws + WS_FO))
#define p_H1 ((bf16*)(ws + WS_H1))
#define p_GATES ((bf16*)a.out)
#define p_out (a.out)

#if PH_ON(0)
    PROBE_T0(0);
    {
        int tid_o = threadIdx.x; asm volatile("" : "+v"(tid_o));
        const int tid = tid_o, lane = tid & 63, wid = __builtin_amdgcn_readfirstlane(tid >> 6), gw = bx * 8 + wid; (void)tid; (void)gw;
        for (int e = bx * 512 + tid; e < 65536; e += G * 512) p_ss1[e] = 0.f;
        for (int e = bx * 512 + tid; e < 2064 * 32; e += G * 512) {
            const int pos = e >> 5, i = e & 31; const float inv = powf(10000.f, -(float)i * (1.f / 32.f)); const float ang = (float)pos * inv;
            p_rope[2 * e] = cosf(ang); p_rope[2 * e + 1] = sinf(ang);
        }
        if (bx < 40) {
            const int item = bx;
            LAS float* um = (LAS float*)lds; LAS float* red = (LAS float*)(lds + 65536);
#pragma unroll
            for (int rr = 0; rr < 2; ++rr) {
                const int row = 2 * wid + rr; const float* xr = p_meta_tokens + row * DM; float v[16]; float s = 0.f;
#pragma unroll
                for (int j = 0; j < 16; ++j) { v[j] = xr[lane + 64 * j]; s += v[j] * v[j]; }
                s = wave_sum(s); const float rstd = 1.f / sqrtf(s * (1.f / DM) + RMS_EPS);
#pragma unroll
                for (int j = 0; j < 16; ++j) um[row * DM + lane + 64 * j] = v[j] * rstd * p_pre_mix_gain[lane + 64 * j];
            }
            __syncthreads();
            int c0, ldd, dcol; bf16* dst; bool dorope;
            if (item < 4)       { c0 = 1024 + 64 * item;        dst = p_KAm; ldd = 256;  dcol = 64 * item;        dorope = true; }
            else if (item < 8)  { c0 = 1280 + 64 * (item - 4);  dst = p_VAm; ldd = 256;  dcol = 64 * (item - 4);  dorope = false; }
            else if (item < 24) { c0 = 2560 + 64 * (item - 8);  dst = p_KBm; ldd = 1024; dcol = 64 * (item - 8);  dorope = true; }
            else                { c0 = 3584 + 64 * (item - 24); dst = p_VBm; ldd = 1024; dcol = 64 * (item - 24); dorope = false; }
#define FMAC(c_, a_, b_) asm("v_fmac_f32_e32 %0, %1, %2" : "+v"(c_) : "v"(a_), "v"(b_))
            float acc[16];
#pragma unroll
            for (int rI = 0; rI < 16; ++rI) acc[rI] = 0.f;
            const float* wp = p_w_in + (size_t)(128 * wid) * NIN + c0 + lane;
#pragma unroll 1
            for (int kc = 0; kc < 4; ++kc) {
                float wv[32];
#pragma unroll
                for (int e = 0; e < 32; ++e) wv[e] = wp[(size_t)(32 * kc + e) * NIN];
#pragma unroll
                for (int k4 = 0; k4 < 8; ++k4) {
                    asm volatile("" ::: "memory");
#pragma unroll
                    for (int rI = 0; rI < 16; ++rI) { const f32x4 uu = *(const LAS f32x4*)(um + rI * DM + 128 * wid + 32 * kc + 4 * k4); FMAC(acc[rI], uu[0], wv[4 * k4]); FMAC(acc[rI], uu[1], wv[4 * k4 + 1]); FMAC(acc[rI], uu[2], wv[4 * k4 + 2]); FMAC(acc[rI], uu[3], wv[4 * k4 + 3]); }
                }
            }
#pragma unroll
            for (int rI = 0; rI < 16; ++rI) red[(wid * 16 + rI) * 64 + lane] = acc[rI];
            __syncthreads();
            {
                const int rI = tid >> 5, i = tid & 31; float x1 = 0.f, x2 = 0.f;
#pragma unroll
                for (int w = 0; w < 8; ++w) { x1 += red[(w * 16 + rI) * 64 + i]; x2 += red[(w * 16 + rI) * 64 + i + 32]; }
                if (dorope) {
                    const float inv = powf(10000.f, -(float)i * (1.f / 32.f)); const float ang = (float)rI * inv; const float c = cosf(ang), s = sinf(ang);
                    *(unsigned*)(dst + rI * ldd + dcol + 2 * i) = cvtpk(x1 * c - x2 * s, x2 * c + x1 * s);
                } else {
                    dst[rI * ldd + dcol + i] = (bf16)(cvtpk(x1, 0.f) & 0xffffu); dst[rI * ldd + dcol + i + 32] = (bf16)(cvtpk(x2, 0.f) & 0xffffu);
                }
                for (int e = tid; e < 1536; e += 512) { const int rr = 16 + e / 32, cc = (e % 32) * 2; *(unsigned*)(dst + rr * ldd + dcol + cc) = 0u; }
            }
            __syncthreads();
        }
        {
            LAS float* scr = (LAS float*)(lds + wid * 16384);
            constexpr int I_IN = 16 * (NIN / 32), I_SQ = 16 * 32, I_FI = 16 * (2 * DFF / 32), I_FO = (DFF / 64) * 32;
            constexpr int NITEMS = I_IN + 3 * I_SQ + I_FI + I_FO;
            const bool skipw = (G > 80) && (bx < 40);
            const int wfirst = (G > 80) ? (bx - 40) * 8 + wid : gw, wstride = (G > 80) ? (G - 40) * 8 : NGW;
            if (!skipw) for (int it = wfirst; it < NITEMS; it += wstride) {
                int q = it;
                if (q < I_IN) { p0_transpose_item<1>(p_w_in, NIN, p_Win_t, DM, 0, scr, q, lane, p_pre_mix_gain); continue; } q -= I_IN;
                if (q < I_SQ) { p0_transpose_item<0>(p_w_bswa, DM, p_Wcat_t, 2048, 0, scr, q, lane); continue; } q -= I_SQ;
                if (q < I_SQ) { p0_transpose_item<0>(p_w_bdiff, DM, p_Wcat_t, 2048, 1024, scr, q, lane); continue; } q -= I_SQ;
                if (q < I_SQ) { p0_transpose_item<0>(p_w_out, DM, p_Wout_t, DM, 0, scr, q, lane); continue; } q -= I_SQ;
                if (q < I_FI) { p0_transpose_item<2>(p_w_ffn_in, 2 * DFF, p_Wffi_t, DM, 0, scr, q, lane, p_pre_ffn_gain); continue; } q -= I_FI;
                p0_transpose_item<0>(p_w_ffn_out, DM, p_Wffo_t, DFF, 0, scr, q, lane);
            }
        }
        for (int base = gw; base < NTOK; base += 4 * NGW) {
            f32x4 v[4][4]; float sq[4];
#pragma unroll
            for (int q = 0; q < 4; ++q) { const int mrow = (base + q * NGW < NTOK) ? base + q * NGW : NTOK - 1; const f32x4* xr = (const f32x4*)(p_x + (size_t)mrow * DM) + lane;
#pragma unroll
                for (int j = 0; j < 4; ++j) v[q][j] = xr[64 * j]; }
#pragma unroll
            for (int q = 0; q < 4; ++q) { float s = 0.f;
#pragma unroll
                for (int j = 0; j < 4; ++j) s += (v[q][j][0] * v[q][j][0] + v[q][j][1] * v[q][j][1]) + (v[q][j][2] * v[q][j][2] + v[q][j][3] * v[q][j][3]);
                sq[q] = 1.f / sqrtf(wave_sum(s) * (1.f / DM) + RMS_EPS); }
#pragma unroll
            for (int q = 0; q < 4; ++q) { if (base + q * NGW < NTOK) { u32x2* o8 = (u32x2*)(p_U + (size_t)(base + q * NGW) * DM) + lane; if (lane == 0) ((float*)(ws + WS_RSX))[base + q * NGW] = sq[q];
#pragma unroll
                for (int j = 0; j < 4; ++j) { const float rstd = sq[q]; u32x2 w; w.x = cvtpk(v[q][j][0] * rstd, v[q][j][1] * rstd); w.y = cvtpk(v[q][j][2] * rstd, v[q][j][3] * rstd); o8[64 * j] = w; } } }
        }
    }
    if (a.ws == nullptr) grid.sync();
    xcd_barrier(xbar);
    PROBE_DELAY(0);

#endif
#if PH_ON(1)
    PROBE_T0(1);
    {
        pg8::Gemm g{p_U, p_Win_t, NTOK, NIN, DM}; pg8::StaticOrder S; S.init(NTOK, NIN, G, bx);
        pg8::EpiInProj E{ws, p_GATES, p_b_gate};
        pg8::gemm_phase<pg8::EpiInProj, pg8::StaticOrder, true, true>(lds, g, S, E);
    }
    xcd_barrier(xbar);
    PROBE_DELAY(1);

#endif
#if PH_ON(2)
    PROBE_T0(2);
    {
        int tid_o = threadIdx.x; asm volatile("" : "+v"(tid_o));
        const int tid = tid_o, lane = tid & 63, wid = __builtin_amdgcn_readfirstlane(tid >> 6);
        unsigned long long att_acc = 0, att_dummy = 0;
        float lam;
        { float p1 = p_lq1[lane] * p_lk1[lane], p2 = p_lq2[lane] * p_lk2[lane]; p1 = wave_sum(p1); p2 = wave_sum(p2); lam = expf(p1) - expf(p2) + 0.2f; }
        for (int uidx = vcu; uidx < 2048; uidx += G) {
            const int i = uidx & 15, hh = (uidx >> 4) & 7, b = uidx >> 7;
            const size_t qrow = (size_t)b * SEQL + i * 128 + 32 * (wid & 3);
            att::attn_unit<128, 128, false>(lds, tid, wid, lane, p_QO + qrow * 2048 + 1024 + hh * 128 + 64 * (wid >> 2),
                                            p_KB + (size_t)b * SEQL * 1024 + hh * 128, p_KBm + hh * 128, 1024, p_VB + (size_t)b * SEQL * 1024 + hh * 128, p_VBm + hh * 128, 1024,
                                            0, 32, 0, 0.f, lam, p_subln_gain, p_QO + qrow * 2048 + 1024 + hh * 128, att_acc);
        }
#if ATT_PROBE == 9
        const unsigned long long swa_t0 = __builtin_amdgcn_s_memrealtime();
#endif
        for (int uidx = vcu; uidx < 1024; uidx += G) {
            const int i = uidx & 15, gk = (uidx >> 4) & 3, b = uidx >> 6;
            const int t0 = (i >= 1) ? 2 * (i - 1) : 0, t1 = (2 * (i + 2) < 32) ? 2 * (i + 2) : 32;
            att::swa_unit(lds, tid, wid, lane, p_QO + ((size_t)b * SEQL + i * 128) * 2048 + gk * 256,
                          p_KA + (size_t)b * SEQL * 256 + gk * 64, p_KAm + gk * 64, p_VA + (size_t)b * SEQL * 256 + gk * 64, p_VAm + gk * 64, t0, t1 - t0, i * 128, p_attn_sink + gk * 4);
        }
#if ATT_PROBE == 9
        att_acc = __builtin_amdgcn_s_memrealtime() - swa_t0;
#endif
#if ATT_PROBE
        if (wid == 0) { const unsigned long long t1_ = __builtin_amdgcn_s_memrealtime(); while (__builtin_amdgcn_s_memrealtime() - t1_ < att_acc) __builtin_amdgcn_s_sleep(8); }
        __syncthreads();
#endif
    }
    xcd_barrier(xbar);
    PROBE_DELAY(2);

#endif
#if PH_ON(3)
    PROBE_T0(3);
    {
        pg8::Gemm g{p_QO, p_Wcat_t, NTOK, DM, 2048}; pg8::StaticOrder S; S.init(NTOK, DM, G, bx);
        pg8::EpiMerge E{p_GATES, p_MERGED};
        pg8::gemm_phase<pg8::EpiMerge, pg8::StaticOrder, true, true>(lds, g, S, E);
    }
    xcd_barrier(xbar);
    PROBE_DELAY(3);

#endif
#if PH_ON(4)
    PROBE_T0(4);
    {
        pg8::Gemm g{p_MERGED, p_Wout_t, NTOK, DM, DM}; pg8::StaticOrder S; S.init(NTOK, DM, G, bx);
        pg8::EpiYSS E{p_Y, p_ss1};
        pg8::gemm_phase<pg8::EpiYSS, pg8::StaticOrder, true, true>(lds, g, S, E);
    }
    xcd_barrier(xbar);
    PROBE_DELAY(4);

#endif
#if PH_ON(5)
    PROBE_T0(5);
    {
        int tid_o = threadIdx.x; asm volatile("" : "+v"(tid_o));
        const int tid = tid_o, lane = tid & 63, wid = __builtin_amdgcn_readfirstlane(tid >> 6), gw = bx * 8 + wid; (void)tid; (void)gw;
    for (int base = gw; base < NTOK; base += 4 * NGW) {
        f32x4 hv[4][4]; u32x2 yw[4][4]; u32x2 xw[4][4]; float r1[4], rx[4];
#pragma unroll
        for (int q = 0; q < 4; ++q) { const int mrow = (base + q * NGW < NTOK) ? base + q * NGW : NTOK - 1;
            const u32x2* xr = (const u32x2*)(p_U + (size_t)mrow * DM) + lane; const u32x2* yr = (const u32x2*)(p_Y + (size_t)mrow * DM) + lane;
            r1[q] = p_ss1[mrow]; rx[q] = ((const float*)(ws + WS_RSX))[mrow];
#pragma unroll
            for (int j = 0; j < 4; ++j) { xw[q][j] = xr[64 * j]; yw[q][j] = yr[64 * j]; } }
#pragma unroll
        for (int q = 0; q < 4; ++q) {
            const float rstd1 = 1.f / sqrtf(r1[q] * (1.f / DM) + RMS_EPS), xs = 1.f / rx[q]; float s2 = 0.f;
#pragma unroll
            for (int j = 0; j < 4; ++j) { const f32x4 g = *((const f32x4*)p_post_mix_gain + lane + 64 * j); f32x4 t; t[0] = bf_lo(xw[q][j].x) * xs; t[1] = bf_hi(xw[q][j].x) * xs; t[2] = bf_lo(xw[q][j].y) * xs; t[3] = bf_hi(xw[q][j].y) * xs;
                t[0] += bf_lo(yw[q][j].x) * rstd1 * g[0]; t[1] += bf_hi(yw[q][j].x) * rstd1 * g[1]; t[2] += bf_lo(yw[q][j].y) * rstd1 * g[2]; t[3] += bf_hi(yw[q][j].y) * rstd1 * g[3];
                hv[q][j] = t; s2 += (t[0] * t[0] + t[1] * t[1]) + (t[2] * t[2] + t[3] * t[3]); }
            r1[q] = 1.f / sqrtf(wave_sum(s2) * (1.f / DM) + RMS_EPS);
        }
#pragma unroll
        for (int q = 0; q < 4; ++q) { if (base + q * NGW < NTOK) { const int mrow = base + q * NGW; const float rstd2 = r1[q];
            u32x2* hrow = (u32x2*)(p_H1 + (size_t)mrow * DM) + lane; if (lane == 0) ((float*)(ws + WS_RS2))[mrow] = rstd2;
#pragma unroll
            for (int j = 0; j < 4; ++j) { u32x2 hw; hw.x = cvtpk(hv[q][j][0] * rstd2, hv[q][j][1] * rstd2); hw.y = cvtpk(hv[q][j][2] * rstd2, hv[q][j][3] * rstd2); hrow[64 * j] = hw; } } }
    }
    }
    xcd_barrier(xbar);
    PROBE_DELAY(5);

#endif
#if PH_ON(6)
    PROBE_T0(6);
    {
        pg8::Gemm g{p_H1, p_Wffi_t, NTOK, 2 * DFF, DM}; pg8::StaticOrder S; S.init(NTOK, 2 * DFF, G, bx);
        pg8::EpiSwiGLU E{p_F};
        pg8::gemm_phase<pg8::EpiSwiGLU, pg8::StaticOrder, true, true>(lds, g, S, E);
    }
    xcd_barrier(xbar);
    PROBE_DELAY(6);

#endif
#if PH_ON(7)
    PROBE_T0(7);
    {
        pg8::Gemm g{p_F, p_Wffo_t, NTOK, DM, DFF}; pg8::StaticOrder S; S.init(NTOK, DM, G, bx);
        pg8::EpiYSS E{p_FO, p_ss3};
        pg8::gemm_phase<pg8::EpiYSS, pg8::StaticOrder, true, true>(lds, g, S, E);
    }
    xcd_barrier(xbar);
    PROBE_DELAY(7);

#endif
#if PH_ON(8)
    PROBE_T0(8);
    {
        int tid_o = threadIdx.x; asm volatile("" : "+v"(tid_o));
        const int tid = tid_o, lane = tid & 63, wid = __builtin_amdgcn_readfirstlane(tid >> 6), gw = bx * 8 + wid; (void)tid; (void)gw;
    for (int base = gw; base < NTOK; base += 4 * NGW) {
        u32x2 hw[4][4]; u32x2 fw[4][4]; float r3[4], r2[4];
#pragma unroll
        for (int q = 0; q < 4; ++q) { const int mrow = (base + q * NGW < NTOK) ? base + q * NGW : NTOK - 1;
            const u32x2* hr = (const u32x2*)(p_H1 + (size_t)mrow * DM) + lane; const u32x2* fr_ = (const u32x2*)(p_FO + (size_t)mrow * DM) + lane;
            r3[q] = p_ss3[mrow]; r2[q] = ((const float*)(ws + WS_RS2))[mrow];
#pragma unroll
            for (int j = 0; j < 4; ++j) { hw[q][j] = hr[64 * j]; fw[q][j] = fr_[64 * j]; } }
#pragma unroll
        for (int q = 0; q < 4; ++q) { if (base + q * NGW < NTOK) { const int mrow = base + q * NGW; const float rstd3 = 1.f / sqrtf(r3[q] * (1.f / DM) + RMS_EPS);
            f32x4* orow = (f32x4*)(p_out + (size_t)mrow * DM) + lane;
#pragma unroll
            for (int j = 0; j < 4; ++j) { const f32x4 g = *((const f32x4*)p_post_ffn_gain + lane + 64 * j); const float hs = 1.f / r2[q]; f32x4 o; o[0] = bf_lo(hw[q][j].x) * hs; o[1] = bf_hi(hw[q][j].x) * hs; o[2] = bf_lo(hw[q][j].y) * hs; o[3] = bf_hi(hw[q][j].y) * hs;
                o[0] += bf_lo(fw[q][j].x) * rstd3 * g[0]; o[1] += bf_hi(fw[q][j].x) * rstd3 * g[1]; o[2] += bf_lo(fw[q][j].y) * rstd3 * g[2]; o[3] += bf_hi(fw[q][j].y) * rstd3 * g[3];
                orow[64 * j] = o; } } }
    }
    }
#if PROBE_PHASE == 9
    for (int i9 = 0; i9 < 10; ++i9) grid.sync();
#endif
#if PROBE_PHASE == 8
    xcd_barrier(xbar);
    PROBE_DELAY(8);
#endif
#endif
}


extern "C" void kernel_launch(void* const* d_in, const int* in_sizes, int n_in, void* d_out, int out_size, void* d_ws, size_t ws_size, hipStream_t stream) {
    static int grid_blocks = 0;
    if (grid_blocks == 0) {
        if (n_in != 19 || out_size != NTOK * DM || ws_size < WS_END) { fprintf(stderr, "kernel_launch: unexpected shapes (n_in %d, out %d, ws %zu)\n", n_in, out_size, ws_size); grid_blocks = -1; return; }
        int dev = 0, cus = 0, per_cu = 0;
        hipGetDevice(&dev);
        hipDeviceGetAttribute(&cus, hipDeviceAttributeMultiprocessorCount, dev);
        hipFuncSetAttribute((const void*)fwd_megakernel, hipFuncAttributeMaxDynamicSharedMemorySize, LDS_BYTES);
        hipOccupancyMaxActiveBlocksPerMultiprocessor(&per_cu, (const void*)fwd_megakernel, 512, LDS_BYTES);
        if (per_cu < 1) { fprintf(stderr, "kernel_launch: occupancy query says %d blocks per CU\n", per_cu); per_cu = 1; }
        if (per_cu > 1) per_cu = 1;
        grid_blocks = cus * per_cu;
    }
    if (grid_blocks < 0) return;
    if (hipMemsetAsync((unsigned char*)d_ws + WS_BAR, 0, XCD_BAR_WORDS * 4, stream) != hipSuccess) { fprintf(stderr, "kernel_launch: memset of the barrier words failed\n"); return; }
    Args a{};
    for (int i = 0; i < 19; ++i) a.in[i] = (const float*)d_in[i];
    a.out = (float*)d_out; a.ws = (unsigned char*)d_ws;
    void* args[] = {&a};
    hipError_t e = hipLaunchCooperativeKernel((const void*)fwd_megakernel, dim3(grid_blocks), dim3(512), args, LDS_BYTES, stream);
    if (e != hipSuccess) fprintf(stderr, "cooperative launch failed: %s (grid %d)\n", hipGetErrorString(e), grid_blocks);
}
```

```cpp
#include <hip/hip_runtime.h>
#include <hip/hip_cooperative_groups.h>
#include <cstdio>
#include <cstdint>
namespace cg = cooperative_groups;

constexpr size_t MiB = 1u << 20;
constexpr size_t WS_RSX = 256 * 1024, WS_RS2 = 384 * 1024;
constexpr size_t WS_SS1 = 0, WS_SS3 = 128 * 1024, WS_ROPE = 1 * MiB, WS_KAM = 2 * MiB, WS_VAM = WS_KAM + 32 * 1024, WS_KBM = WS_KAM + 64 * 1024, WS_VBM = WS_KAM + 192 * 1024;
constexpr size_t WS_WIN = 4 * MiB, WS_WCAT = 17 * MiB, WS_WOUT = 21 * MiB, WS_WFFI = 23 * MiB, WS_WFFO = 34 * MiB;
constexpr size_t WS_U = 48 * MiB, WS_QO = 112 * MiB, WS_KA = 240 * MiB, WS_VA = 256 * MiB, WS_KB = 272 * MiB, WS_VB = 336 * MiB, WS_MERGED = 400 * MiB;
constexpr size_t WS_Y = 272 * MiB, WS_F = 112 * MiB, WS_FO = 48 * MiB  , WS_H1 = 400 * MiB  , WS_END = 464 * MiB;

namespace pg8 {
#define PG8_LAS __attribute__((address_space(3)))
typedef unsigned short bf16_t;
typedef short bf16x8 __attribute__((ext_vector_type(8)));
typedef float f32x4 __attribute__((ext_vector_type(4)));
typedef unsigned u32x4 __attribute__((ext_vector_type(4)));
constexpr int BM = 256, BK = 64, HALF = 128, HTB = HALF * BK * 2  , STAGE_BYTES = 8 * HTB, NXCD = 8, WGM = 4;

__host__ __device__ __forceinline__ int lds_byte(int r, int c) { const int st = (r >> 4) * 2 + (c >> 5), rr = r & 15, cc = c & 31, ob = rr * 64 + cc * 2; return st * 1024 + (ob ^ (((ob >> 9) & 1) << 5)); }
__host__ __device__ __forceinline__ void stage_rc(int b, int& R, int& C) { const int st = b / 1024, sb = b % 1024, swz = sb ^ (((sb >> 9) & 1) << 5); R = (st >> 1) * 16 + swz / 64; C = (st & 1) * 32 + (swz % 64) / 2; }
__host__ __device__ __forceinline__ int perm32(int rho) { const int n = rho >> 4, i = rho & 15; return 8 * (i >> 2) + 4 * n + (i & 3); }

struct Unit { int pm, pn; };
struct Gemm { const bf16_t* A; const bf16_t* Bt; int M, N, K; };

struct StaticOrder {
    int nM, nN, nwg, G, c, wgm;
    __host__ __device__ void init(int M, int N, int G_, int c_, int wgm_ = WGM) { nM = M / BM; nN = N / BM; nwg = nM * nN; G = G_; c = c_; wgm = wgm_; }
    __host__ __device__ bool next(int i, Unit& u) const {
        const long L = (long)i * G + c; if (L >= nwg) return false;
        int wgid = (int)L; { const int q = nwg / NXCD, r = nwg % NXCD, xcd = wgid % NXCD, off = wgid / NXCD; wgid = (xcd < r ? xcd * (q + 1) : r * (q + 1) + (xcd - r) * q) + off; }
        const int nig = wgm * nN, gid = wgid / nig, fm = gid * wgm, gsz = (nM - fm) < wgm ? (nM - fm) : wgm;
        u.pm = fm + ((wgid % nig) % gsz); u.pn = (wgid % nig) / gsz; return true;
    }
    __device__ __forceinline__ void a_ready(const Unit&) const {}
    __device__ __forceinline__ void done(const Unit&) const {}
};


typedef float f32x2_t __attribute__((ext_vector_type(2))); typedef __bf16 bf16x2_t __attribute__((ext_vector_type(2)));
__device__ __forceinline__ unsigned cvtpk(float lo, float hi) { f32x2_t v = {lo, hi}; bf16x2_t b = __builtin_convertvector(v, bf16x2_t); return __builtin_bit_cast(unsigned, b); }
__device__ __forceinline__ float bf_lo(unsigned w) { return __uint_as_float(w << 16); }
__device__ __forceinline__ float bf_hi(unsigned w) { return __uint_as_float(w & 0xffff0000u); }
constexpr float QK_C2 = 0.125f * 1.4426950408889634f;

struct EpiInProj {
    static constexpr bool PERM = true, AFTER_DRAIN = false, HAS_MID = false;
    unsigned char* ws; bf16_t* G; const float* bgate;
    __device__ __forceinline__ void mid(f32x4 (&)[2][2][4][2], const Unit&, int, int, int, int) const {}
    __device__ __forceinline__ void operator()(const f32x4 (&acc)[2][2][4][2], const Unit& u, int wr, int wc, int fr, int fq) const {
        const int pn = u.pn, row0 = u.pm * BM + wr * 64 + fr, cl = wc * 32 + 8 * fq;
        bf16_t* dst; int ldc, cb, mode; float sc0 = 1.f;
        const float* rope = (const float*)(ws + WS_ROPE);
        if (pn < 4)       { dst = (bf16_t*)(ws + WS_QO);        ldc = 2048; cb = pn * 256;        mode = 1; sc0 = QK_C2; }
        else if (pn == 4) { dst = (bf16_t*)(ws + WS_KA);        ldc = 256;  cb = 0;               mode = 1; }
        else if (pn == 5) { dst = (bf16_t*)(ws + WS_VA);        ldc = 256;  cb = 0;               mode = 0; }
        else if (pn < 10) { dst = (bf16_t*)(ws + WS_QO) + 1024; ldc = 2048; cb = (pn - 6) * 256;  mode = 1; sc0 = QK_C2; }
        else if (pn < 14) { dst = (bf16_t*)(ws + WS_KB);        ldc = 1024; cb = (pn - 10) * 256; mode = 1; }
        else if (pn < 18) { dst = (bf16_t*)(ws + WS_VB);        ldc = 1024; cb = (pn - 14) * 256; mode = 0; }
        else              { dst = G;                            ldc = 2048; cb = (pn - 18) * 256; mode = 2; }
        if (mode == 1) {
            const int i0 = 16 * (wc & 1) + 4 * fq;
#pragma unroll
            for (int ai = 0; ai < 2; ++ai)
#pragma unroll
                for (int m = 0; m < 4; ++m) {
                    const int row = row0 + ai * HALF + m * 16, pos = 16 + (row & 2047);
                    const f32x4 c0 = *(const f32x4*)(rope + (size_t)(pos * 32 + i0) * 2), c1 = *(const f32x4*)(rope + (size_t)(pos * 32 + i0 + 2) * 2);
                    const float sc = sc0;
#pragma unroll
                    for (int bj = 0; bj < 2; ++bj) {
                        const f32x4 v0 = acc[ai][bj][m][0], v1 = acc[ai][bj][m][1]; u32x4 w;
                        w.x = cvtpk((v0[0] * c0[0] - v0[1] * c0[1]) * sc, (v0[1] * c0[0] + v0[0] * c0[1]) * sc);
                        w.y = cvtpk((v0[2] * c0[2] - v0[3] * c0[3]) * sc, (v0[3] * c0[2] + v0[2] * c0[3]) * sc);
                        w.z = cvtpk((v1[0] * c1[0] - v1[1] * c1[1]) * sc, (v1[1] * c1[0] + v1[0] * c1[1]) * sc);
                        w.w = cvtpk((v1[2] * c1[2] - v1[3] * c1[3]) * sc, (v1[3] * c1[2] + v1[2] * c1[3]) * sc);
                        *(u32x4*)(dst + (size_t)row * ldc + cb + bj * HALF + cl) = w;
                    }
                }
        } else if (mode == 0) {
#pragma unroll
            for (int ai = 0; ai < 2; ++ai)
#pragma unroll
                for (int m = 0; m < 4; ++m) {
                    const int row = row0 + ai * HALF + m * 16;
#pragma unroll
                    for (int bj = 0; bj < 2; ++bj) {
                        const f32x4 v0 = acc[ai][bj][m][0], v1 = acc[ai][bj][m][1]; u32x4 w;
                        w.x = cvtpk(v0[0], v0[1]); w.y = cvtpk(v0[2], v0[3]); w.z = cvtpk(v1[0], v1[1]); w.w = cvtpk(v1[2], v1[3]);
                        *(u32x4*)(dst + (size_t)row * ldc + cb + bj * HALF + cl) = w;
                    }
                }
        } else {
            f32x4 bv[2][2];
#pragma unroll
            for (int bj = 0; bj < 2; ++bj)
#pragma unroll
                for (int n = 0; n < 2; ++n) bv[bj][n] = *(const f32x4*)(bgate + cb + bj * HALF + cl + 4 * n);
#pragma unroll
            for (int ai = 0; ai < 2; ++ai)
#pragma unroll
                for (int m = 0; m < 4; ++m) {
                    const int row = row0 + ai * HALF + m * 16;
#pragma unroll
                    for (int bj = 0; bj < 2; ++bj) {
                        const f32x4 v0 = acc[ai][bj][m][0] + bv[bj][0], v1 = acc[ai][bj][m][1] + bv[bj][1]; float s[8];
#pragma unroll
                        for (int e = 0; e < 4; ++e) { s[e] = __builtin_amdgcn_rcpf(1.f + __expf(-v0[e])); s[4 + e] = __builtin_amdgcn_rcpf(1.f + __expf(-v1[e])); }
                        u32x4 w; w.x = cvtpk(s[0], s[1]); w.y = cvtpk(s[2], s[3]); w.z = cvtpk(s[4], s[5]); w.w = cvtpk(s[6], s[7]);
                        *(u32x4*)(dst + (size_t)row * ldc + cb + bj * HALF + cl) = w;
                    }
                }
        }
    }
};

struct EpiMerge {
    static constexpr bool PERM = true, AFTER_DRAIN = false, HAS_MID = true;
    const bf16_t* G; bf16_t* out;
    __device__ __forceinline__ void mid(f32x4 (&acc)[2][2][4][2], const Unit& u, int wr, int wc, int fr, int fq) const {
        int row0 = u.pm * BM + wr * 64 + fr, col0 = u.pn * BM + wc * 32 + 8 * fq;
        asm volatile("" : "+v"(row0), "+v"(col0));
#pragma unroll
        for (int ai = 0; ai < 2; ++ai)
#pragma unroll
            for (int m = 0; m < 4; ++m) {
                const bf16_t* gp = G + (size_t)(row0 + ai * HALF + m * 16) * 2048 + col0;
#pragma unroll
                for (int bj = 0; bj < 2; ++bj) {
                    const u32x4 a = *(const u32x4*)(gp + bj * HALF), d = *(const u32x4*)(gp + 1024 + bj * HALF);
                    f32x4 r0, r1;
                    r0[0] = bf_lo(a.x) * __builtin_amdgcn_rcpf(fmaxf(bf_lo(d.x), 1e-20f)); r0[1] = bf_hi(a.x) * __builtin_amdgcn_rcpf(fmaxf(bf_hi(d.x), 1e-20f));
                    r0[2] = bf_lo(a.y) * __builtin_amdgcn_rcpf(fmaxf(bf_lo(d.y), 1e-20f)); r0[3] = bf_hi(a.y) * __builtin_amdgcn_rcpf(fmaxf(bf_hi(d.y), 1e-20f));
                    r1[0] = bf_lo(a.z) * __builtin_amdgcn_rcpf(fmaxf(bf_lo(d.z), 1e-20f)); r1[1] = bf_hi(a.z) * __builtin_amdgcn_rcpf(fmaxf(bf_hi(d.z), 1e-20f));
                    r1[2] = bf_lo(a.w) * __builtin_amdgcn_rcpf(fmaxf(bf_lo(d.w), 1e-20f)); r1[3] = bf_hi(a.w) * __builtin_amdgcn_rcpf(fmaxf(bf_hi(d.w), 1e-20f));
                    acc[ai][bj][m][0] *= r0; acc[ai][bj][m][1] *= r1;
                }
                asm volatile("" ::: "memory");
            }
    }
    __device__ __forceinline__ void operator()(const f32x4 (&acc)[2][2][4][2], const Unit& u, int wr, int wc, int fr, int fq) const {
        const int row0 = u.pm * BM + wr * 64 + fr, col0 = u.pn * BM + wc * 32 + 8 * fq;
#pragma unroll
        for (int ai = 0; ai < 2; ++ai)
#pragma unroll
            for (int m = 0; m < 4; ++m) {
                const int row = row0 + ai * HALF + m * 16; const bf16_t* gp = G + (size_t)row * 2048 + 1024 + col0;
#pragma unroll
                for (int bj = 0; bj < 2; ++bj) {
                    const u32x4 d = *(const u32x4*)(gp + bj * HALF); const f32x4 v0 = acc[ai][bj][m][0], v1 = acc[ai][bj][m][1]; u32x4 w;
                    w.x = cvtpk(v0[0] * fmaxf(bf_lo(d.x), 1e-20f), v0[1] * fmaxf(bf_hi(d.x), 1e-20f)); w.y = cvtpk(v0[2] * fmaxf(bf_lo(d.y), 1e-20f), v0[3] * fmaxf(bf_hi(d.y), 1e-20f));
                    w.z = cvtpk(v1[0] * fmaxf(bf_lo(d.z), 1e-20f), v1[1] * fmaxf(bf_hi(d.z), 1e-20f)); w.w = cvtpk(v1[2] * fmaxf(bf_lo(d.w), 1e-20f), v1[3] * fmaxf(bf_hi(d.w), 1e-20f));
                    *(u32x4*)(out + (size_t)row * 1024 + col0 + bj * HALF) = w;
                }
                asm volatile("" ::: "memory");
            }
    }
};

struct EpiYSS {
    static constexpr bool PERM = true, AFTER_DRAIN = false, HAS_MID = false;
    bf16_t* Y; float* ss;
    __device__ __forceinline__ void mid(f32x4 (&)[2][2][4][2], const Unit&, int, int, int, int) const {}
    __device__ __forceinline__ void operator()(const f32x4 (&acc)[2][2][4][2], const Unit& u, int wr, int wc, int fr, int fq) const {
        const int row0 = u.pm * BM + wr * 64 + fr, col0 = u.pn * BM + wc * 32 + 8 * fq;
#pragma unroll
        for (int ai = 0; ai < 2; ++ai)
#pragma unroll
            for (int m = 0; m < 4; ++m) {
                const int row = row0 + ai * HALF + m * 16; float s = 0.f;
#pragma unroll
                for (int bj = 0; bj < 2; ++bj) {
                    const f32x4 v0 = acc[ai][bj][m][0], v1 = acc[ai][bj][m][1]; u32x4 w;
                    s += (v0[0] * v0[0] + v0[1] * v0[1]) + (v0[2] * v0[2] + v0[3] * v0[3]) + (v1[0] * v1[0] + v1[1] * v1[1]) + (v1[2] * v1[2] + v1[3] * v1[3]);
                    w.x = cvtpk(v0[0], v0[1]); w.y = cvtpk(v0[2], v0[3]); w.z = cvtpk(v1[0], v1[1]); w.w = cvtpk(v1[2], v1[3]);
                    *(u32x4*)(Y + (size_t)row * 1024 + col0 + bj * HALF) = w;
                }
                s += __shfl_xor(s, 16); s += __shfl_xor(s, 32);
                if (fq == 0) atomicAdd(ss + row, s);
            }
    }
};

struct EpiSwiGLU {
    static constexpr bool PERM = true, AFTER_DRAIN = false, HAS_MID = false;
    bf16_t* F;
    __device__ __forceinline__ void mid(f32x4 (&)[2][2][4][2], const Unit&, int, int, int, int) const {}
    __device__ __forceinline__ void operator()(const f32x4 (&acc)[2][2][4][2], const Unit& u, int wr, int wc, int fr, int fq) const {
        const int row0 = u.pm * BM + wr * 64 + fr, col0 = u.pn * 128 + wc * 16 + 4 * fq;
#pragma unroll
        for (int ai = 0; ai < 2; ++ai)
#pragma unroll
            for (int m = 0; m < 4; ++m) {
                const int row = row0 + ai * HALF + m * 16;
#pragma unroll
                for (int bj = 0; bj < 2; ++bj) {
                    const f32x4 g = acc[ai][bj][m][0], up = acc[ai][bj][m][1]; float o[4];
#pragma unroll
                    for (int e = 0; e < 4; ++e) o[e] = g[e] * __builtin_amdgcn_rcpf(1.f + __expf(-g[e])) * up[e];
                    unsigned long long w = (unsigned long long)cvtpk(o[0], o[1]) | ((unsigned long long)cvtpk(o[2], o[3]) << 32);
                    *(unsigned long long*)(F + (size_t)row * 2816 + col0 + bj * 64) = w;
                }
            }
    }
};

template <class Epi, class Sched, bool ALIGN_EPI = false, bool SP2 = false>
__device__ __forceinline__ void gemm_phase(PG8_LAS unsigned char* lds, const Gemm g, const Sched& S, Epi& E) {
    int tid_ = threadIdx.x; asm volatile("" : "+v"(tid_));
    const int tid = tid_, wid = __builtin_amdgcn_readfirstlane(tid >> 6), lane = tid & 63, wr = wid >> 2, wc = wid & 3, fr = lane & 15, fq = lane >> 4;
    const int K = g.K, nt = K / BK;
    unsigned voffA[2], voffB[2];
#pragma unroll
    for (int i = 0; i < 2; ++i) { int R, C; stage_rc(tid * 16 + i * 8192, R, C); const int Rb = Epi::PERM ? ((R & ~31) + perm32(R & 31)) : R;
        voffA[i] = (unsigned)(R * K + C) * 2u; voffB[i] = (unsigned)(Rb * K + C) * 2u; }
    const size_t kstep = (size_t)(BK * 2);
    const size_t hstep = (size_t)HALF * K * 2;
    const size_t tstep = 2 * hstep;
    const unsigned ldsw = (unsigned)wid * 1024u;
    const int aoff = lds_byte(wr * 64 + fr, fq * 8), boff = lds_byte(wc * 32 + fr, fq * 8);
#define PG8_SA(b, h) (((b) * 2 + (h)) * HTB)
#define PG8_SB(b, h) ((4 + (b) * 2 + (h)) * HTB)
#define PG8_STAGE(bufoff, gbase, voff) do { _Pragma("unroll") for (int _i = 0; _i < 2; ++_i) \
        __builtin_amdgcn_global_load_lds((const unsigned*)((const char*)(gbase) + (voff)[_i]), (PG8_LAS unsigned*)(lds + (bufoff) + ldsw + _i * 8192), 16, 0, 0); } while (0)
#define PG8_LDA(dst, b, h) do { _Pragma("unroll") for (int m = 0; m < 4; ++m) _Pragma("unroll") for (int k = 0; k < 2; ++k) dst[m][k] = *(const PG8_LAS bf16x8*)(lds + PG8_SA(b, h) + aoff + m * 2048 + k * 1024); } while (0)
#define PG8_LDB(dst, b, h) do { _Pragma("unroll") for (int n = 0; n < 2; ++n) _Pragma("unroll") for (int k = 0; k < 2; ++k) dst[n][k] = *(const PG8_LAS bf16x8*)(lds + PG8_SB(b, h) + boff + n * 2048 + k * 1024); } while (0)
#define PG8_MMA(ai, bj, At, Bt) do { __builtin_amdgcn_s_setprio(1); _Pragma("unroll") for (int m = 0; m < 4; ++m) _Pragma("unroll") for (int n = 0; n < 2; ++n) _Pragma("unroll") for (int k = 0; k < 2; ++k) \
        acc[ai][bj][m][n] = __builtin_amdgcn_mfma_f32_16x16x32_bf16(Bt[n][k], At[m][k], acc[ai][bj][m][n], 0, 0, 0); __builtin_amdgcn_s_setprio(0); } while (0)
#define PG8_WAIT_V(n) asm volatile("s_waitcnt vmcnt(" #n ")" ::: "memory")
#define PG8_WAIT_L(n) asm volatile("s_waitcnt lgkmcnt(" #n ")" ::: "memory")
#define PG8_BAR __builtin_amdgcn_s_barrier()
#define PG8_SCHED __builtin_amdgcn_sched_barrier(0)
    Unit cur, nxt; int ui = 0;
    if (!S.next(0, cur)) return;
    f32x4 acc[2][2][4][2];
#pragma unroll
    for (int a = 0; a < 2; ++a)
#pragma unroll
        for (int b = 0; b < 2; ++b)
#pragma unroll
            for (int m = 0; m < 4; ++m)
#pragma unroll
                for (int n = 0; n < 2; ++n) acc[a][b][m][n] = (f32x4){0.f, 0.f, 0.f, 0.f};
    bf16x8 At[4][2], B0[2][2], B1[2][2];
    const char* cA = (const char*)g.A + (size_t)cur.pm * tstep; const char* cB = (const char*)g.Bt + (size_t)cur.pn * tstep;
    S.a_ready(cur);
    if constexpr (SP2) {
        PG8_STAGE(PG8_SB(0, 0), cB, voffB); PG8_STAGE(PG8_SB(0, 1), cB + hstep, voffB); PG8_STAGE(PG8_SA(0, 0), cA, voffA); PG8_STAGE(PG8_SA(0, 1), cA + hstep, voffA);
        if (wr == 1) PG8_BAR;
        PG8_WAIT_V(2); PG8_BAR;
        PG8_STAGE(PG8_SB(1, 0), cB + kstep, voffB); PG8_STAGE(PG8_SA(1, 0), cA + kstep, voffA); PG8_STAGE(PG8_SB(1, 1), cB + hstep + kstep, voffB);
        PG8_WAIT_V(6); PG8_BAR;
    } else {
        PG8_STAGE(PG8_SB(0, 0), cB, voffB); PG8_STAGE(PG8_SA(0, 0), cA, voffA); PG8_STAGE(PG8_SB(0, 1), cB + hstep, voffB); PG8_STAGE(PG8_SA(0, 1), cA + hstep, voffA);
        if (wr == 1) PG8_BAR;
        PG8_WAIT_V(4); PG8_BAR;
        PG8_STAGE(PG8_SB(1, 0), cB + kstep, voffB); PG8_STAGE(PG8_SA(1, 0), cA + kstep, voffA); PG8_STAGE(PG8_SB(1, 1), cB + hstep + kstep, voffB);
        PG8_WAIT_V(6); PG8_BAR;
    }
    for (;;) {
        const bool has_next = S.next(ui + 1, nxt);
        const char* nA = has_next ? (const char*)g.A + (size_t)nxt.pm * tstep : cA; const char* nB = has_next ? (const char*)g.Bt + (size_t)nxt.pn * tstep : cB;
        for (int t = 0; t < nt; t += 2) {
            if constexpr (Epi::HAS_MID) { if (t == (nt >> 1)) E.mid(acc, cur, wr, wc, fr, fq); }
            const bool last = (t == nt - 2);
            const char* a1 = cA + (size_t)(t + 1) * kstep;
            const char* a2 = last ? nA : cA + (size_t)(t + 2) * kstep; const char* b2 = last ? nB : cB + (size_t)(t + 2) * kstep;
            const char* a3 = a2 + kstep; const char* b3 = b2 + kstep;
            if (last && has_next) S.a_ready(nxt);
            if constexpr (SP2) {
            PG8_LDB(B0, 0, 0); PG8_LDB(B1, 0, 1); PG8_SCHED; PG8_LDA(At, 0, 0); PG8_STAGE(PG8_SA(1, 1), a1 + hstep, voffA);
            PG8_WAIT_V(8); PG8_WAIT_L(0); PG8_BAR; PG8_MMA(0, 0, At, B0); PG8_MMA(0, 1, At, B1); PG8_BAR; PG8_SCHED;
            PG8_LDA(At, 0, 1); PG8_STAGE(PG8_SB(0, 0), b2, voffB); PG8_STAGE(PG8_SB(0, 1), b2 + hstep, voffB); PG8_STAGE(PG8_SA(0, 0), a2, voffA);
            PG8_WAIT_V(8); PG8_WAIT_L(0); PG8_BAR; PG8_MMA(1, 0, At, B0); PG8_MMA(1, 1, At, B1); PG8_BAR; PG8_SCHED;
            PG8_LDB(B0, 1, 0); PG8_LDB(B1, 1, 1); PG8_SCHED; PG8_LDA(At, 1, 0); PG8_STAGE(PG8_SA(0, 1), a2 + hstep, voffA);
            PG8_WAIT_V(8); PG8_WAIT_L(0); PG8_BAR; PG8_MMA(0, 0, At, B0); PG8_MMA(0, 1, At, B1); PG8_BAR; PG8_SCHED;
            PG8_LDA(At, 1, 1); PG8_STAGE(PG8_SB(1, 0), b3, voffB); PG8_STAGE(PG8_SB(1, 1), b3 + hstep, voffB); PG8_STAGE(PG8_SA(1, 0), a3, voffA);
            PG8_WAIT_V(8); PG8_WAIT_L(0); PG8_BAR; PG8_MMA(1, 0, At, B0); PG8_MMA(1, 1, At, B1); PG8_BAR; PG8_SCHED;
            } else {
            PG8_LDB(B0, 0, 0); PG8_SCHED; PG8_LDA(At, 0, 0); PG8_STAGE(PG8_SA(1, 1), a1 + hstep, voffA);
            PG8_WAIT_L(8); PG8_BAR; PG8_WAIT_L(0); PG8_MMA(0, 0, At, B0); PG8_BAR; PG8_SCHED;
            PG8_LDB(B1, 0, 1); PG8_STAGE(PG8_SB(0, 0), b2, voffB);
            PG8_BAR; PG8_WAIT_L(0); PG8_MMA(0, 1, At, B1); PG8_BAR;
            PG8_LDA(At, 0, 1); PG8_STAGE(PG8_SA(0, 0), a2, voffA);
            PG8_BAR; PG8_WAIT_L(0); PG8_MMA(1, 0, At, B0); PG8_BAR; PG8_SCHED;
            PG8_STAGE(PG8_SB(0, 1), b2 + hstep, voffB);
            PG8_WAIT_V(6); PG8_BAR; PG8_MMA(1, 1, At, B1); PG8_BAR;
            PG8_LDB(B0, 1, 0); PG8_SCHED; PG8_LDA(At, 1, 0); PG8_STAGE(PG8_SA(0, 1), a2 + hstep, voffA);
            PG8_WAIT_L(8); PG8_BAR; PG8_WAIT_L(0); PG8_MMA(0, 0, At, B0); PG8_BAR; PG8_SCHED;
            PG8_LDB(B1, 1, 1); PG8_STAGE(PG8_SB(1, 0), b3, voffB);
            PG8_BAR; PG8_WAIT_L(0); PG8_MMA(0, 1, At, B1); PG8_BAR;
            PG8_LDA(At, 1, 1); PG8_STAGE(PG8_SA(1, 0), a3, voffA);
            PG8_BAR; PG8_WAIT_L(0); PG8_MMA(1, 0, At, B0); PG8_BAR; PG8_SCHED;
            PG8_STAGE(PG8_SB(1, 1), b3 + hstep, voffB);
            PG8_WAIT_V(6); PG8_BAR; PG8_MMA(1, 1, At, B1); PG8_BAR;
            }
        }
        if constexpr (ALIGN_EPI) { if (wr == 0) PG8_BAR; }
        if constexpr (!Epi::AFTER_DRAIN) { E(acc, cur, wr, wc, fr, fq); S.done(cur); }
        if (!has_next) break;
#pragma unroll
        for (int a = 0; a < 2; ++a)
#pragma unroll
            for (int b = 0; b < 2; ++b)
#pragma unroll
                for (int m = 0; m < 4; ++m)
#pragma unroll
                    for (int n = 0; n < 2; ++n) acc[a][b][m][n] = (f32x4){0.f, 0.f, 0.f, 0.f};
        cur = nxt; cA = nA; cB = nB; ++ui;
        if constexpr (ALIGN_EPI) { if (wr == 1) PG8_BAR; }
    }
    PG8_WAIT_V(0);
    if constexpr (!ALIGN_EPI) { if (wr == 0) PG8_BAR; }
    PG8_BAR;
    if constexpr (Epi::AFTER_DRAIN) { E.fused(acc, cur, wr, wc, fr, fq, lds, wid, lane); S.done(cur); }
#undef PG8_SA
#undef PG8_SB
#undef PG8_STAGE
#undef PG8_LDA
#undef PG8_LDB
#undef PG8_MMA
#undef PG8_WAIT_V
#undef PG8_WAIT_L
#undef PG8_BAR
#undef PG8_SCHED
}
}

namespace att {
#define LAS __attribute__((address_space(3)))
typedef unsigned short bf16_t;
typedef short bf16x8 __attribute__((ext_vector_type(8)));
typedef short s16x4 __attribute__((ext_vector_type(4)));
typedef short v4i16_t __attribute__((ext_vector_type(4)));
typedef float f32x16 __attribute__((ext_vector_type(16)));
typedef float f32x4 __attribute__((ext_vector_type(4)));
typedef unsigned u32x4 __attribute__((ext_vector_type(4)));
typedef unsigned u32x2 __attribute__((ext_vector_type(2)));
using pg8::cvtpk;
__device__ __forceinline__ s16x4 vtr(const LAS unsigned char* p) { return __builtin_bit_cast(s16x4, __builtin_amdgcn_ds_read_tr16_b64_v4i16((LAS v4i16_t*)p)); }
__device__ __forceinline__ int crow(int i, int h) { return (i & 3) + 8 * (i >> 2) + 4 * h; }
__device__ __forceinline__ float xhalf_max(float v) { auto rr = __builtin_amdgcn_permlane32_swap(__float_as_uint(v), __float_as_uint(v), false, false); return fmaxf(__uint_as_float(rr[0]), __uint_as_float(rr[1])); }
__device__ __forceinline__ float xhalf_sum(float v) { auto rr = __builtin_amdgcn_permlane32_swap(__float_as_uint(v), __float_as_uint(v), false, false); return __uint_as_float(rr[0]) + __uint_as_float(rr[1]); }
#define MFMA32(a, b, c) __builtin_amdgcn_mfma_f32_32x32x16_bf16((a), (b), (c), 0, 0, 0)
constexpr float NEGV = -1e30f;
constexpr int ATT_LDS_MAX = 2 * (64 * 272 + 64 * 320);

#ifndef ATT_PROBE
#define ATT_PROBE 0
#endif
#if ATT_PROBE
#define ATT_TS(k) do { if ((k) == ATT_PROBE - 1) att_t = __builtin_amdgcn_s_memrealtime(); if ((k) == ATT_PROBE) att_acc += __builtin_amdgcn_s_memrealtime() - att_t; } while (0)
#else
#define ATT_TS(k) do {} while (0)
#endif
template <int KW, int DV, bool SWA>
__device__ __forceinline__ void attn_unit(LAS unsigned char* lds, const int tid, const int wid, const int lane,
                                          bf16_t* Qw, const bf16_t* Kreal, const bf16_t* Kmeta, const int kpitch, const bf16_t* Vreal, const bf16_t* Vmeta, const int vpitch,
                                          const int t0, const int t1, const int qrel0, const float sink_l2, const float lam, const float* gain, bf16_t* Od, unsigned long long& att_acc) {
    unsigned long long att_t = 0; (void)att_t;
    constexpr int KP = KW * 2 + 16, VP = (DV == 64) ? 192 : 320, KBUF = 64 * KP, VBUF = 64 * VP;
    constexpr int NKC = KW / 64, NVC = DV / 64, KCPR = KW / 8, VCPR = DV / 8, NDB = DV / 32;
    constexpr float THR = 8.f;
    const int r = lane & 31, h = lane >> 5;
    bf16x8 qf[4];
#pragma unroll
    for (int st = 0; st < 4; ++st) qf[st] = *(const bf16x8*)(Qw + (size_t)r * 2048 + 16 * st + 8 * h);
    u32x4 kreg[1][NKC], vreg[1][NVC];
    const int krow_ = tid / KCPR, kcc_ = tid % KCPR, vrow_ = tid / VCPR, vcc_ = tid % VCPR;
#define ATT_LOAD(S, Ks, Vs) do { \
        _Pragma("unroll") for (int i_ = 0; i_ < NKC; ++i_) kreg[S][i_] = *(const u32x4*)((Ks) + (size_t)(krow_ + i_ * (512 / KCPR)) * kpitch + kcc_ * 8); \
        _Pragma("unroll") for (int i_ = 0; i_ < NVC; ++i_) vreg[S][i_] = *(const u32x4*)((Vs) + (size_t)(vrow_ + i_ * (512 / VCPR)) * vpitch + vcc_ * 8); } while (0)
#define ATT_STORE(S, buf) do { \
        _Pragma("unroll") for (int i_ = 0; i_ < NKC; ++i_) *(LAS u32x4*)(lds + (buf) * KBUF + (krow_ + i_ * (512 / KCPR)) * KP + kcc_ * 16) = kreg[S][i_]; \
        _Pragma("unroll") for (int i_ = 0; i_ < NVC; ++i_) *(LAS u32x4*)(lds + 2 * KBUF + (buf) * VBUF + (vrow_ + i_ * (512 / VCPR)) * VP + vcc_ * 16) = vreg[S][i_]; } while (0)
    const int nt = 1 + (t1 - t0);
    ATT_LOAD(0, Kmeta, Vmeta);
    ATT_STORE(0, 0);
    ATT_LOAD(0, Kreal + (size_t)t0 * 64 * kpitch, Vreal + (size_t)t0 * 64 * vpitch);
    __syncthreads();
    const int kcolw = SWA ? 0 : 64 * (wid >> 2);
    const int koff = r * KP + (kcolw + 8 * h) * 2;
    const int voff = (4 * h + ((lane & 15) >> 2)) * VP + (16 * ((lane >> 4) & 1) + 4 * (lane & 3)) * 2;
    f32x16 o[NDB];
    float mhat, l;
    f32x16 s0, s1;
    bf16x8 pf[4];
#define ATT_QK(buf, C0) do { const LAS unsigned char* kb_ = lds + (buf) * KBUF + koff; \
        __builtin_amdgcn_s_setprio(1); \
        _Pragma("unroll") for (int st = 0; st < 4; ++st) { \
            const bf16x8 a0_ = *(const LAS bf16x8*)(kb_ + st * 32), a1_ = *(const LAS bf16x8*)(kb_ + 32 * KP + st * 32); \
            if (st == 0) { s0 = MFMA32(a0_, qf[0], C0); s1 = MFMA32(a1_, qf[0], C0); } else { s0 = MFMA32(a0_, qf[st], s0); s1 = MFMA32(a1_, qf[st], s1); } } \
        __builtin_amdgcn_s_setprio(0); } while (0)
#define ATT_MAX(mx) do { float a_ = fmaxf(fmaxf(s0[0], s0[1]), s1[0]), b_ = fmaxf(fmaxf(s0[2], s0[3]), s1[1]); a_ = fmaxf(fmaxf(a_, s1[2]), s1[3]); \
        _Pragma("unroll") for (int i = 4; i < 16; i += 4) { a_ = fmaxf(fmaxf(a_, s0[i]), s0[i + 1]); b_ = fmaxf(fmaxf(b_, s0[i + 2]), s0[i + 3]); a_ = fmaxf(fmaxf(a_, s1[i]), s1[i + 1]); b_ = fmaxf(fmaxf(b_, s1[i + 2]), s1[i + 3]); } \
        mx = fmaxf(a_, b_); mx = xhalf_max(mx); } while (0)
#define ATT_EXP_PACK() do { float ra_ = 0.f, rb_ = 0.f; \
        _Pragma("unroll") for (int i = 0; i < 16; ++i) { s0[i] = __builtin_amdgcn_exp2f(s0[i]); s1[i] = __builtin_amdgcn_exp2f(s1[i]); ra_ += s0[i]; rb_ += s1[i]; } \
        l += ra_ + rb_; u32x4 w_; \
        w_.x = cvtpk(s0[0], s0[1]); w_.y = cvtpk(s0[2], s0[3]); w_.z = cvtpk(s0[4], s0[5]); w_.w = cvtpk(s0[6], s0[7]); pf[0] = __builtin_bit_cast(bf16x8, w_); \
        w_.x = cvtpk(s0[8], s0[9]); w_.y = cvtpk(s0[10], s0[11]); w_.z = cvtpk(s0[12], s0[13]); w_.w = cvtpk(s0[14], s0[15]); pf[1] = __builtin_bit_cast(bf16x8, w_); \
        w_.x = cvtpk(s1[0], s1[1]); w_.y = cvtpk(s1[2], s1[3]); w_.z = cvtpk(s1[4], s1[5]); w_.w = cvtpk(s1[6], s1[7]); pf[2] = __builtin_bit_cast(bf16x8, w_); \
        w_.x = cvtpk(s1[8], s1[9]); w_.y = cvtpk(s1[10], s1[11]); w_.z = cvtpk(s1[12], s1[13]); w_.w = cvtpk(s1[14], s1[15]); pf[3] = __builtin_bit_cast(bf16x8, w_); } while (0)
#define ATT_EXP_H(S, P0_, P1_) do { float ra_ = 0.f, rb_ = 0.f; \
        _Pragma("unroll") for (int i = 0; i < 16; i += 2) { S[i] = __builtin_amdgcn_exp2f(S[i]); S[i + 1] = __builtin_amdgcn_exp2f(S[i + 1]); ra_ += S[i]; rb_ += S[i + 1]; } \
        l += ra_ + rb_; u32x4 w_; \
        w_.x = cvtpk(S[0], S[1]); w_.y = cvtpk(S[2], S[3]); w_.z = cvtpk(S[4], S[5]); w_.w = cvtpk(S[6], S[7]); P0_ = __builtin_bit_cast(bf16x8, w_); \
        w_.x = cvtpk(S[8], S[9]); w_.y = cvtpk(S[10], S[11]); w_.z = cvtpk(S[12], S[13]); w_.w = cvtpk(S[14], S[15]); P1_ = __builtin_bit_cast(bf16x8, w_); } while (0)
    s16x4 vlo[2][NDB], vhi[2][NDB];
#define ATT_VRD(buf, ks, B) do { const LAS unsigned char* vb_ = lds + 2 * KBUF + (buf) * VBUF + voff; \
        _Pragma("unroll") for (int db = 0; db < NDB; ++db) { vlo[B][db] = vtr(vb_ + (16 * (ks)) * VP + db * 64); vhi[B][db] = vtr(vb_ + (16 * (ks) + 8) * VP + db * 64); } } while (0)
#define ATT_PV(buf, NKS) do { \
        __builtin_amdgcn_s_setprio(1); \
        _Pragma("unroll") for (int ks = 0; ks < (NKS); ++ks) { \
            if (ks + 1 < (NKS)) ATT_VRD(buf, ks + 1, (ks + 1) & 1); \
            _Pragma("unroll") for (int db = 0; db < NDB; ++db) { \
                const bf16x8 va_ = __builtin_shufflevector(vlo[ks & 1][db], vhi[ks & 1][db], 0, 1, 2, 3, 4, 5, 6, 7); \
                o[db] = MFMA32(va_, pf[ks], o[db]); } \
            __builtin_amdgcn_sched_barrier(0); } \
        __builtin_amdgcn_s_setprio(0); } while (0)
#define ATT_SMPV(buf) do { \
        ATT_EXP_H(s0, pf[0], pf[1]); \
        __builtin_amdgcn_sched_barrier(0); \
        ATT_VRD(buf, 1, 1); \
        _Pragma("unroll") for (int db = 0; db < NDB; ++db) { const bf16x8 va_ = __builtin_shufflevector(vlo[0][db], vhi[0][db], 0, 1, 2, 3, 4, 5, 6, 7); o[db] = MFMA32(va_, pf[0], o[db]); } \
        ATT_VRD(buf, 2, 0); \
        _Pragma("unroll") for (int db = 0; db < NDB; ++db) { const bf16x8 va_ = __builtin_shufflevector(vlo[1][db], vhi[1][db], 0, 1, 2, 3, 4, 5, 6, 7); o[db] = MFMA32(va_, pf[1], o[db]); } \
        ATT_EXP_H(s1, pf[2], pf[3]); \
        _Pragma("unroll") for (int g_ = 0; g_ < 2 * NDB; ++g_) { __builtin_amdgcn_sched_group_barrier(0x008, 1, 0); __builtin_amdgcn_sched_group_barrier(0x100, 2, 0); __builtin_amdgcn_sched_group_barrier(0x002, 40 / (2 * NDB), 0); } \
        __builtin_amdgcn_sched_barrier(0); \
        ATT_VRD(buf, 3, 1); \
        _Pragma("unroll") for (int db = 0; db < NDB; ++db) { const bf16x8 va_ = __builtin_shufflevector(vlo[0][db], vhi[0][db], 0, 1, 2, 3, 4, 5, 6, 7); o[db] = MFMA32(va_, pf[2], o[db]); } \
        __builtin_amdgcn_sched_barrier(0); \
        _Pragma("unroll") for (int db = 0; db < NDB; ++db) { const bf16x8 va_ = __builtin_shufflevector(vlo[1][db], vhi[1][db], 0, 1, 2, 3, 4, 5, 6, 7); o[db] = MFMA32(va_, pf[3], o[db]); } \
        __builtin_amdgcn_sched_barrier(0); } while (0)
    f32x16 zero16;
#pragma unroll
    for (int i = 0; i < 16; ++i) zero16[i] = 0.f;
    {
        ATT_QK(0, zero16);
#pragma unroll
        for (int i = 0; i < 16; ++i) { if (i >= 8) s0[i] = NEGV; s1[i] = NEGV; }
        ATT_VRD(0, 0, 0);
        float mx; ATT_MAX(mx);
        mhat = mx; l = 0.f;
#pragma unroll
        for (int i = 0; i < 16; ++i) { s0[i] -= mx; s1[i] -= mx; }
        ATT_EXP_PACK();
#pragma unroll
        for (int db = 0; db < NDB; ++db) o[db] = zero16;
        ATT_PV(0, 1);
        ATT_STORE(0, 1);
        if (2 < nt) ATT_LOAD(0, Kreal + (size_t)(t0 + 1) * 64 * kpitch, Vreal + (size_t)(t0 + 1) * 64 * vpitch);
        __syncthreads();
    }
#define ATT_TILE(it, PAR) do { \
          \
        bool skip_ = false, edge_ = false; \
        if (SWA) { const int k0_ = (t0 + (it) - 1) * 64; skip_ = (k0_ > qrel0 + 31 + 128) || (k0_ + 63 < qrel0 - 128); edge_ = !((k0_ >= qrel0 + 31 - 128) && (k0_ + 63 <= qrel0 + 128)); } \
        if (!skip_) { f32x16 negm_; _Pragma("unroll") for (int i = 0; i < 16; ++i) negm_[i] = -mhat; \
            ATT_QK(PAR, negm_); } \
        if ((it) + 1 < nt) ATT_STORE(0, (PAR) ^ 1);                       \
        if ((it) + 2 < nt) ATT_LOAD(0, Kreal + (size_t)(t0 + (it) + 1) * 64 * kpitch, Vreal + (size_t)(t0 + (it) + 1) * 64 * vpitch);     \
        if (!skip_) { \
            ATT_VRD(PAR, 0, 0);                                           \
            if (SWA && edge_) { const int d0_ = (t0 + (it) - 1) * 64 - (qrel0 + r); \
                _Pragma("unroll") for (int i = 0; i < 16; ++i) { const int d_ = d0_ + crow(i, h); if (d_ < -128 || d_ > 128) s0[i] = NEGV; if (d_ + 32 < -128 || d_ + 32 > 128) s1[i] = NEGV; } } \
            float mx_; ATT_MAX(mx_); \
            if (__builtin_expect(__any(mx_ > THR), 0)) { const float dl_ = fmaxf(mx_, 0.f); mhat += dl_; \
                _Pragma("unroll") for (int i = 0; i < 16; ++i) { s0[i] -= dl_; s1[i] -= dl_; } \
                const float f_ = __builtin_amdgcn_exp2f(-dl_); l *= f_; \
                _Pragma("unroll") for (int db = 0; db < NDB; ++db) _Pragma("unroll") for (int i = 0; i < 16; ++i) o[db][i] *= f_; } \
            ATT_SMPV(PAR); } \
        __syncthreads(); } while (0)
    for (int it = 1; it < nt; it += 2) { ATT_TILE(it, 1); ATT_TILE(it + 1, 0); }
#undef ATT_TILE
#undef ATT_QK
#undef ATT_MAX
#undef ATT_EXP_PACK
#undef ATT_PV
#undef ATT_SMPV
#undef ATT_EXP_H
#undef ATT_VRD
#undef ATT_LOAD
#undef ATT_STORE
    const float m = mhat;
    l = xhalf_sum(l);
    if constexpr (SWA) {
        l += __builtin_amdgcn_exp2f(sink_l2 - m);
        const float inv = 1.f / l;
#pragma unroll
        for (int db = 0; db < NDB; ++db)
#pragma unroll
            for (int g4 = 0; g4 < 4; ++g4) {
                u32x2 w; w.x = cvtpk(o[db][4 * g4] * inv, o[db][4 * g4 + 1] * inv); w.y = cvtpk(o[db][4 * g4 + 2] * inv, o[db][4 * g4 + 3] * inv);
                *(u32x2*)(Qw + (size_t)r * 2048 + 32 * db + 8 * g4 + 4 * h) = w;
            }
    } else {
        const float inv = 1.f / l;
        LAS float* xb = (LAS float*)lds;
        if (wid >= 4) {
            const float sc = lam * inv;
#pragma unroll
            for (int db = 0; db < NDB; ++db)
#pragma unroll
                for (int i = 0; i < 16; ++i) xb[((wid - 4) * 128 + 32 * db + crow(i, h)) * 32 + r] = o[db][i] * sc;
        }
        __syncthreads();
        if (wid < 4) {
            float ss = 0.f;
#pragma unroll
            for (int db = 0; db < NDB; ++db)
#pragma unroll
                for (int i = 0; i < 16; ++i) { const float v = o[db][i] * inv - xb[(wid * 128 + 32 * db + crow(i, h)) * 32 + r]; o[db][i] = v; ss += v * v; }
            ss = xhalf_sum(ss);
            const float rstd = 0.8f / sqrtf(ss * (1.f / 128.f) + 1e-6f);
#pragma unroll
            for (int db = 0; db < NDB; ++db)
#pragma unroll
                for (int g4 = 0; g4 < 4; ++g4) {
                    const int d = 32 * db + 8 * g4 + 4 * h; const f32x4 gg = *(const f32x4*)(gain + d);
                    u32x2 w; w.x = cvtpk(o[db][4 * g4] * rstd * gg[0], o[db][4 * g4 + 1] * rstd * gg[1]); w.y = cvtpk(o[db][4 * g4 + 2] * rstd * gg[2], o[db][4 * g4 + 3] * rstd * gg[3]);
                    *(u32x2*)(Od + (size_t)r * 2048 + d) = w;
                }
        }
        __syncthreads();
    }
}
constexpr int SW_KP = 144, SW_VP = 192, SW_KT = 64 * SW_KP, SW_VT = 64 * SW_VP, SW_VOFF = 7 * SW_KT, SW_LDS = 7 * (SW_KT + SW_VT);
__device__ __forceinline__ void swa_unit(LAS unsigned char* lds, const int tid, const int wid, const int lane, bf16_t* QOrow  ,
                                         const bf16_t* Kreal, const bf16_t* Kmeta, const bf16_t* Vreal, const bf16_t* Vmeta, const int t0, const int ntr, const int qblk0, const float* sink4) {
    constexpr float THR = 8.f;
    const int r = lane & 31, h = lane >> 5;
    {
        u32x4 kr[7], vr[7];
        const int row = tid >> 3, cc = tid & 7;
#pragma unroll
        for (int j = 0; j < 7; ++j) if (j <= ntr) {
            const bf16_t* ks = (j == 0) ? Kmeta : Kreal + (size_t)(t0 + j - 1) * 64 * 256; const bf16_t* vs = (j == 0) ? Vmeta : Vreal + (size_t)(t0 + j - 1) * 64 * 256;
            kr[j] = *(const u32x4*)(ks + (size_t)row * 256 + cc * 8); vr[j] = *(const u32x4*)(vs + (size_t)row * 256 + cc * 8); }
#pragma unroll
        for (int j = 0; j < 7; ++j) if (j <= ntr) {
            *(LAS u32x4*)(lds + j * SW_KT + row * SW_KP + cc * 16) = kr[j]; *(LAS u32x4*)(lds + SW_VOFF + j * SW_VT + row * SW_VP + cc * 16) = vr[j]; }
    }
    __syncthreads();
    const int koff = r * SW_KP + (8 * h) * 2;
    const int voff = (4 * h + ((lane & 15) >> 2)) * SW_VP + (16 * ((lane >> 4) & 1) + 4 * (lane & 3)) * 2;
    f32x16 zero16;
#pragma unroll
    for (int i = 0; i < 16; ++i) zero16[i] = 0.f;
    const int qrel0 = qblk0 + 32 * (wid & 3);
#pragma unroll 1
    for (int pass = 0; pass < 2; ++pass) {
        const int hd = 2 * pass + (wid >> 2);
        bf16_t* Qw = QOrow + (size_t)(32 * (wid & 3)) * 2048 + hd * 64;
        bf16x8 qf[4];
#pragma unroll
        for (int st = 0; st < 4; ++st) qf[st] = *(const bf16x8*)(Qw + (size_t)r * 2048 + 16 * st + 8 * h);
        const float sink_l2 = sink4[hd] * 1.4426950408889634f;
        f32x16 o[2], s0, s1; bf16x8 pf[4]; float mhat, l = 0.f;
#define SW_QK(j, C0) do { const LAS unsigned char* kb_ = lds + (j) * SW_KT + koff; \
        _Pragma("unroll") for (int st = 0; st < 4; ++st) { \
            const bf16x8 a0_ = *(const LAS bf16x8*)(kb_ + st * 32), a1_ = *(const LAS bf16x8*)(kb_ + 32 * SW_KP + st * 32); \
            if (st == 0) { s0 = MFMA32(a0_, qf[0], C0); s1 = MFMA32(a1_, qf[0], C0); } else { s0 = MFMA32(a0_, qf[st], s0); s1 = MFMA32(a1_, qf[st], s1); } } } while (0)
#define SW_MAX(mx) do { float a_ = fmaxf(fmaxf(s0[0], s0[1]), s1[0]), b_ = fmaxf(fmaxf(s0[2], s0[3]), s1[1]); a_ = fmaxf(fmaxf(a_, s1[2]), s1[3]); \
        _Pragma("unroll") for (int i = 4; i < 16; i += 4) { a_ = fmaxf(fmaxf(a_, s0[i]), s0[i + 1]); b_ = fmaxf(fmaxf(b_, s0[i + 2]), s0[i + 3]); a_ = fmaxf(fmaxf(a_, s1[i]), s1[i + 1]); b_ = fmaxf(fmaxf(b_, s1[i + 2]), s1[i + 3]); } \
        mx = xhalf_max(fmaxf(a_, b_)); } while (0)
#define SW_EXP_H(S, P0_, P1_) do { float ra_ = 0.f, rb_ = 0.f; \
        _Pragma("unroll") for (int i = 0; i < 16; i += 2) { S[i] = __builtin_amdgcn_exp2f(S[i]); S[i + 1] = __builtin_amdgcn_exp2f(S[i + 1]); ra_ += S[i]; rb_ += S[i + 1]; } \
        l += ra_ + rb_; u32x4 w_; \
        w_.x = cvtpk(S[0], S[1]); w_.y = cvtpk(S[2], S[3]); w_.z = cvtpk(S[4], S[5]); w_.w = cvtpk(S[6], S[7]); P0_ = __builtin_bit_cast(bf16x8, w_); \
        w_.x = cvtpk(S[8], S[9]); w_.y = cvtpk(S[10], S[11]); w_.z = cvtpk(S[12], S[13]); w_.w = cvtpk(S[14], S[15]); P1_ = __builtin_bit_cast(bf16x8, w_); } while (0)
#define SW_PV(j, NKS) do { const LAS unsigned char* vb_ = lds + SW_VOFF + (j) * SW_VT + voff; \
        _Pragma("unroll") for (int ks = 0; ks < (NKS); ++ks) \
            _Pragma("unroll") for (int db = 0; db < 2; ++db) { \
                const s16x4 lo_ = vtr(vb_ + (16 * ks) * SW_VP + db * 64), hi_ = vtr(vb_ + (16 * ks + 8) * SW_VP + db * 64); \
                const bf16x8 va_ = __builtin_shufflevector(lo_, hi_, 0, 1, 2, 3, 4, 5, 6, 7); \
                o[db] = MFMA32(va_, pf[ks], o[db]); } } while (0)
        {
            SW_QK(0, zero16);
#pragma unroll
            for (int i = 0; i < 16; ++i) { if (i >= 8) s0[i] = NEGV; s1[i] = NEGV; }
            float mx; SW_MAX(mx);
            mhat = mx;
#pragma unroll
            for (int i = 0; i < 16; ++i) s0[i] -= mx;
            SW_EXP_H(s0, pf[0], pf[1]);
            o[0] = zero16; o[1] = zero16;
            SW_PV(0, 1);
        }
#pragma unroll 1
        for (int j = 1; j <= ntr; ++j) {
            const int k0 = (t0 + j - 1) * 64;
            if ((k0 > qrel0 + 31 + 128) || (k0 + 63 < qrel0 - 128)) continue;
            const bool edge = !((k0 >= qrel0 + 31 - 128) && (k0 + 63 <= qrel0 + 128));
            f32x16 negm_;
#pragma unroll
            for (int i = 0; i < 16; ++i) negm_[i] = -mhat;
            SW_QK(j, negm_);
            if (edge) { const int d0_ = k0 - (qrel0 + r);
#pragma unroll
                for (int i = 0; i < 16; ++i) { const int d_ = d0_ + crow(i, h); if (d_ < -128 || d_ > 128) s0[i] = NEGV; if (d_ + 32 < -128 || d_ + 32 > 128) s1[i] = NEGV; } }
            float mx_; SW_MAX(mx_);
            if (__builtin_expect(__any(mx_ > THR), 0)) { const float dl_ = fmaxf(mx_, 0.f); mhat += dl_;
#pragma unroll
                for (int i = 0; i < 16; ++i) { s0[i] -= dl_; s1[i] -= dl_; }
                const float f_ = __builtin_amdgcn_exp2f(-dl_); l *= f_;
#pragma unroll
                for (int db = 0; db < 2; ++db)
#pragma unroll
                    for (int i = 0; i < 16; ++i) o[db][i] *= f_; }
            SW_EXP_H(s0, pf[0], pf[1]); SW_EXP_H(s1, pf[2], pf[3]);
            SW_PV(j, 4);
        }
#undef SW_QK
#undef SW_MAX
#undef SW_EXP_H
#undef SW_PV
        l = xhalf_sum(l);
        l += __builtin_amdgcn_exp2f(sink_l2 - mhat);
        const float inv = 1.f / l;
#pragma unroll
        for (int db = 0; db < 2; ++db)
#pragma unroll
            for (int g4 = 0; g4 < 4; ++g4) {
                u32x2 w; w.x = cvtpk(o[db][4 * g4] * inv, o[db][4 * g4 + 1] * inv); w.y = cvtpk(o[db][4 * g4 + 2] * inv, o[db][4 * g4 + 3] * inv);
                *(u32x2*)(Qw + (size_t)r * 2048 + 32 * db + 8 * g4 + 4 * h) = w;
            }
    }
    __syncthreads();
}
}

typedef unsigned short bf16;
typedef float f32x4 __attribute__((ext_vector_type(4)));
typedef unsigned u32x4 __attribute__((ext_vector_type(4)));
typedef unsigned u32x2 __attribute__((ext_vector_type(2)));
using pg8::cvtpk; using pg8::bf_lo; using pg8::bf_hi;
constexpr int NTOK = 32768, DM = 1024, NIN = 6656, DFF = 2816, SEQL = 2048;
constexpr float RMS_EPS = 1e-6f;
constexpr int LDS_MAIN = 151552, LDS_BYTES = LDS_MAIN + 256;
static_assert(att::ATT_LDS_MAX <= LDS_MAIN && att::SW_LDS <= LDS_MAIN && pg8::STAGE_BYTES <= LDS_MAIN, "LDS map");

__device__ __forceinline__ float wave_sum(float v) {
#pragma unroll
    for (int o = 1; o < 64; o <<= 1) v += __shfl_xor(v, o);
    return v;
}
template <int MODE> __device__ __forceinline__ int rowmap(int n) {
    if (MODE == 1) {
        const bool perm = (n < 1280) || (n >= 1536 && n < 3584);
        if (!perm) return n;
        const int d = n & 63; return (n & ~63) + ((d < 32) ? 2 * d : 2 * (d - 32) + 1);
    } else if (MODE == 2) {
        if (n < DFF) return 8 * (n >> 2) + (n & 3);
        const int j = n - DFF; return 8 * (j >> 2) + 4 + (j & 3);
    }
    return n;
}
template <int MODE> __device__ __forceinline__ void p0_transpose_item(const float* W, int N, bf16* WT, int ldk, int koff, LAS float* scr, int item, int lane, const float* kscale = nullptr) {
    const int nblk = N / 32, kb = item / nblk, nb = item % nblk, k0 = 64 * kb, n0 = 32 * nb;
#pragma unroll 8
    for (int i = 0; i < 32; ++i) { const int kk = 2 * i + (lane >> 5); scr[kk * 33 + (lane & 31)] = W[(size_t)(k0 + kk) * N + n0 + (lane & 31)]; }
    asm volatile("s_waitcnt lgkmcnt(0)" ::: "memory");
    const int c = lane & 7;
    f32x4 ks0 = {1.f, 1.f, 1.f, 1.f}, ks1 = {1.f, 1.f, 1.f, 1.f};
    if (kscale) { ks0 = *(const f32x4*)(kscale + k0 + 8 * c); ks1 = *(const f32x4*)(kscale + k0 + 8 * c + 4); }
#pragma unroll
    for (int j = 0; j < 4; ++j) { const int n = (lane >> 3) + 8 * j; const LAS float* s = scr + (8 * c) * 33 + n;
        u32x4 o; o.x = cvtpk(s[0 * 33] * ks0[0], s[1 * 33] * ks0[1]); o.y = cvtpk(s[2 * 33] * ks0[2], s[3 * 33] * ks0[3]); o.z = cvtpk(s[4 * 33] * ks1[0], s[5 * 33] * ks1[1]); o.w = cvtpk(s[6 * 33] * ks1[2], s[7 * 33] * ks1[3]);
        *(u32x4*)(WT + (size_t)rowmap<MODE>(n0 + n) * ldk + koff + k0 + 8 * c) = o; }
    asm volatile("s_waitcnt lgkmcnt(0)" ::: "memory");
}

#define XB_TMO      128
#define XB_XCNT(j)  (256  + 64 * (j))
#define XB_XSUB(j)  (1280 + 64 * (j))
#define XB_XGEN(j)  (2304 + 64 * (j))
#define XB_TOP      3328
#define XB_TOPGEN   3392
#define XCD_BAR_WORDS 3456
#define XB_SPIN_CAP (1u << 18)

__device__ __forceinline__ unsigned xb_ld(unsigned* p)              { return __hip_atomic_load(p, __ATOMIC_RELAXED, __HIP_MEMORY_SCOPE_AGENT); }
__device__ __forceinline__ unsigned xb_add(unsigned* p, unsigned v) { return __hip_atomic_fetch_add(p, v, __ATOMIC_RELAXED, __HIP_MEMORY_SCOPE_AGENT); }
__device__ __forceinline__ unsigned xb_xcc_id() { return (unsigned)__builtin_amdgcn_s_getreg((3 << 11) | 20) & 0xFu; }
#define XB_SPIN(cond, bar) do { unsigned _sp = 0; while (cond) { __builtin_amdgcn_s_sleep(1); \
    if ((++_sp & 255u) == 0u) { if (xb_ld(&(bar)[XB_TMO])) break; if (_sp > XB_SPIN_CAP) { atomicAdd(&(bar)[XB_TMO], 1u); break; } } } } while (0)

struct XcdBarrier {
    unsigned* bar; unsigned x;
    volatile LAS unsigned* st;
};

__device__ __forceinline__ XcdBarrier xcd_barrier_post(unsigned* bar, volatile LAS unsigned* st) {
    XcdBarrier b; b.bar = bar; b.x = xb_xcc_id(); b.st = st;
    if (threadIdx.x == 0) (void)xb_add(&bar[XB_XCNT(b.x)], 1u);
    return b;
}
__device__ __forceinline__ void xcd_barrier_complete(unsigned* bar, unsigned x, unsigned& nloc, unsigned& nx) {
    const unsigned G = gridDim.x * gridDim.y * gridDim.z;
    unsigned sum, cnt, mine, sp = 0u;
    for (;;) {
        sum = 0u; cnt = 0u; mine = 0u;
#pragma unroll
        for (unsigned j = 0; j < 16; ++j) { const unsigned c = xb_ld(&bar[XB_XCNT(j)]); sum += c; cnt += (c > 0u) ? 1u : 0u; mine = (j == x) ? c : mine; }
        if (sum == G) break;
        __builtin_amdgcn_s_sleep(1);
        if ((++sp & 255u) == 0u) { if (xb_ld(&bar[XB_TMO])) break; if (sp > XB_SPIN_CAP) { atomicAdd(&bar[XB_TMO], 1u); break; } }
    }
    nloc = mine > 0u ? mine : 1u; nx = cnt > 0u ? cnt : 1u;
}

__device__ __forceinline__ void xcd_barrier(const XcdBarrier& b) {
    asm volatile("s_waitcnt vmcnt(0)" ::: "memory");
    __syncthreads();
    if (threadIdx.x == 0) {
        unsigned* bar = b.bar;
        __builtin_amdgcn_s_waitcnt(0);
        unsigned nloc = b.st[0], nx = b.st[1];
        if (nloc == 0u) { xcd_barrier_complete(bar, b.x, nloc, nx); b.st[0] = nloc; b.st[1] = nx; }
        const unsigned old = xb_add(&bar[XB_XSUB(b.x)], 1u);
        const unsigned gen = old / nloc;
        if (old + 1u == (gen + 1u) * nloc) {
            __builtin_amdgcn_fence(__ATOMIC_RELEASE, "agent");
            asm volatile("s_waitcnt vmcnt(0)" ::: "memory");
            const unsigned og = xb_add(&bar[XB_TOP], 1u);
            const unsigned tg = og / nx;
            if (og + 1u == (tg + 1u) * nx) xb_add(&bar[XB_TOPGEN], 1u);
            else XB_SPIN(xb_ld(&bar[XB_TOPGEN]) == tg, bar);
            __builtin_amdgcn_fence(__ATOMIC_ACQUIRE, "agent");
            xb_add(&bar[XB_XGEN(b.x)], 1u);
            asm volatile("s_waitcnt vmcnt(0)" ::: "memory");
        } else {
            XB_SPIN(xb_ld(&bar[XB_XGEN(b.x)]) == gen, bar);
            __builtin_amdgcn_fence(__ATOMIC_ACQUIRE, "agent");
            asm volatile("s_waitcnt vmcnt(0)" ::: "memory");
        }
    }
    __syncthreads();
}

constexpr size_t WS_BAR = 512 * 1024;
#ifndef WGM_P1
#define WGM_P1 4
#endif
#ifndef WGM_P6
#define WGM_P6 4
#endif
#ifndef WGM_N1K
#define WGM_N1K 8
#endif
#ifndef PH_MASK
#define PH_MASK 0x1ff
#endif
#define PH_ON(k) ((PH_MASK >> (k)) & 1)
#ifndef PROBE_PHASE
#define PROBE_PHASE (-1)
#endif
#define PROBE_T0(k) do { if (PROBE_PHASE == (k) && threadIdx.x == 0) probe_t0 = __builtin_amdgcn_s_memrealtime(); } while (0)
#define PROBE_DELAY(k) do { if (PROBE_PHASE == (k)) { if (threadIdx.x == 0) { const unsigned long long t1_ = __builtin_amdgcn_s_memrealtime(), dt_ = t1_ - probe_t0; while (__builtin_amdgcn_s_memrealtime() - t1_ < dt_) __builtin_amdgcn_s_sleep(8); } __syncthreads(); } } while (0)
struct Args { const float* in[19]; float* out; unsigned char* ws; };

__global__ void __launch_bounds__(512, 2) fwd_megakernel(Args a) {
    extern __shared__ __attribute__((aligned(16))) unsigned char lds_raw[];
    cg::grid_group grid = cg::this_grid();
    LAS unsigned char* lds = (LAS unsigned char*)lds_raw;
    const int tid = threadIdx.x, lane = tid & 63, wid = __builtin_amdgcn_readfirstlane(tid >> 6);
    const int G = gridDim.x, bx = blockIdx.x;
    const int vcu = (G % 8 == 0) ? (bx % 8) * (G / 8) + bx / 8 : bx;
    const int gw = bx * 8 + wid, NGW = G * 8;
    unsigned char* ws = a.ws;
    unsigned long long probe_t0 = 0; (void)probe_t0;
    volatile LAS unsigned* xb_st = (volatile LAS unsigned*)(lds + LDS_MAIN);
    if (threadIdx.x < 2) xb_st[threadIdx.x] = 0u;
    __syncthreads();
    const XcdBarrier xbar = xcd_barrier_post((unsigned*)(ws + WS_BAR), xb_st);
#define p_x (a.in[0])
#define p_meta_tokens (a.in[1])
#define p_pre_mix_gain (a.in[2])
#define p_w_in (a.in[3])
#define p_b_gate (a.in[4])
#define p_attn_sink (a.in[5])
#define p_lq1 (a.in[6])
#define p_lk1 (a.in[7])
#define p_lq2 (a.in[8])
#define p_lk2 (a.in[9])
#define p_subln_gain (a.in[10])
#define p_w_bswa (a.in[11])
#define p_w_bdiff (a.in[12])
#define p_w_out (a.in[13])
#define p_post_mix_gain (a.in[14])
#define p_pre_ffn_gain (a.in[15])
#define p_w_ffn_in (a.in[16])
#define p_w_ffn_out (a.in[17])
#define p_post_ffn_gain (a.in[18])
#define p_ss1 ((float*)(ws + WS_SS1))
#define p_ss3 ((float*)(ws + WS_SS3))
#define p_rope ((float*)(ws + WS_ROPE))
#define p_KAm ((bf16*)(ws + WS_KAM))
#define p_VAm ((bf16*)(ws + WS_VAM))
#define p_KBm ((bf16*)(ws + WS_KBM))
#define p_VBm ((bf16*)(ws + WS_VBM))
#define p_Win_t ((bf16*)(ws + WS_WIN))
#define p_Wcat_t ((bf16*)(ws + WS_WCAT))
#define p_Wout_t ((bf16*)(ws + WS_WOUT))
#define p_Wffi_t ((bf16*)(ws + WS_WFFI))
#define p_Wffo_t ((bf16*)(ws + WS_WFFO))
#define p_U ((bf16*)(ws + WS_U))
#define p_QO ((bf16*)(ws + WS_QO))
#define p_KA ((bf16*)(ws + WS_KA))
#define p_VA ((bf16*)(ws + WS_VA))
#define p_KB ((bf16*)(ws + WS_KB))
#define p_VB ((bf16*)(ws + WS_VB))
#define p_MERGED ((bf16*)(ws + WS_MERGED))
#define p_Y ((bf16*)(ws + WS_Y))
#define p_F ((bf16*)(ws + WS_F))
#define p_FO ((bf16*)(ws + WS_FO))
#define p_H1 ((bf16*)(ws + WS_H1))
#define p_GATES ((bf16*)a.out)
#define p_out (a.out)

#if PH_ON(0)
    PROBE_T0(0);
    {
        int tid_o = threadIdx.x; asm volatile("" : "+v"(tid_o));
        const int tid = tid_o, lane = tid & 63, wid = __builtin_amdgcn_readfirstlane(tid >> 6), gw = bx * 8 + wid; (void)tid; (void)gw;
        for (int e = bx * 512 + tid; e < 65536; e += G * 512) p_ss1[e] = 0.f;
        for (int e = bx * 512 + tid; e < 2064 * 32; e += G * 512) {
            const int pos = e >> 5, i = e & 31; const float inv = powf(10000.f, -(float)i * (1.f / 32.f)); const float ang = (float)pos * inv;
            p_rope[2 * e] = cosf(ang); p_rope[2 * e + 1] = sinf(ang);
        }
        if (bx < 40) {
            const int item = bx;
            LAS float* um = (LAS float*)lds; LAS float* red = (LAS float*)(lds + 65536);
#pragma unroll
            for (int rr = 0; rr < 2; ++rr) {
                const int row = 2 * wid + rr; const float* xr = p_meta_tokens + row * DM; float v[16]; float s = 0.f;
#pragma unroll
                for (int j = 0; j < 16; ++j) { v[j] = xr[lane + 64 * j]; s += v[j] * v[j]; }
                s = wave_sum(s); const float rstd = 1.f / sqrtf(s * (1.f / DM) + RMS_EPS);
#pragma unroll
                for (int j = 0; j < 16; ++j) um[row * DM + lane + 64 * j] = v[j] * rstd * p_pre_mix_gain[lane + 64 * j];
            }
            __syncthreads();
            int c0, ldd, dcol; bf16* dst; bool dorope;
            if (item < 4)       { c0 = 1024 + 64 * item;        dst = p_KAm; ldd = 256;  dcol = 64 * item;        dorope = true; }
            else if (item < 8)  { c0 = 1280 + 64 * (item - 4);  dst = p_VAm; ldd = 256;  dcol = 64 * (item - 4);  dorope = false; }
            else if (item < 24) { c0 = 2560 + 64 * (item - 8);  dst = p_KBm; ldd = 1024; dcol = 64 * (item - 8);  dorope = true; }
            else                { c0 = 3584 + 64 * (item - 24); dst = p_VBm; ldd = 1024; dcol = 64 * (item - 24); dorope = false; }
#define FMAC(c_, a_, b_) asm("v_fmac_f32_e32 %0, %1, %2" : "+v"(c_) : "v"(a_), "v"(b_))
            float acc[16];
#pragma unroll
            for (int rI = 0; rI < 16; ++rI) acc[rI] = 0.f;
            const float* wp = p_w_in + (size_t)(128 * wid) * NIN + c0 + lane;
#pragma unroll 1
            for (int kc = 0; kc < 4; ++kc) {
                float wv[32];
#pragma unroll
                for (int e = 0; e < 32; ++e) wv[e] = wp[(size_t)(32 * kc + e) * NIN];
#pragma unroll
                for (int k4 = 0; k4 < 8; ++k4) {
                    asm volatile("" ::: "memory");
#pragma unroll
                    for (int rI = 0; rI < 16; ++rI) { const f32x4 uu = *(const LAS f32x4*)(um + rI * DM + 128 * wid + 32 * kc + 4 * k4); FMAC(acc[rI], uu[0], wv[4 * k4]); FMAC(acc[rI], uu[1], wv[4 * k4 + 1]); FMAC(acc[rI], uu[2], wv[4 * k4 + 2]); FMAC(acc[rI], uu[3], wv[4 * k4 + 3]); }
                }
            }
#pragma unroll
            for (int rI = 0; rI < 16; ++rI) red[(wid * 16 + rI) * 64 + lane] = acc[rI];
            __syncthreads();
            {
                const int rI = tid >> 5, i = tid & 31; float x1 = 0.f, x2 = 0.f;
#pragma unroll
                for (int w = 0; w < 8; ++w) { x1 += red[(w * 16 + rI) * 64 + i]; x2 += red[(w * 16 + rI) * 64 + i + 32]; }
                if (dorope) {
                    const float inv = powf(10000.f, -(float)i * (1.f / 32.f)); const float ang = (float)rI * inv; const float c = cosf(ang), s = sinf(ang);
                    *(unsigned*)(dst + rI * ldd + dcol + 2 * i) = cvtpk(x1 * c - x2 * s, x2 * c + x1 * s);
                } else {
                    dst[rI * ldd + dcol + i] = (bf16)(cvtpk(x1, 0.f) & 0xffffu); dst[rI * ldd + dcol + i + 32] = (bf16)(cvtpk(x2, 0.f) & 0xffffu);
                }
                for (int e = tid; e < 1536; e += 512) { const int rr = 16 + e / 32, cc = (e % 32) * 2; *(unsigned*)(dst + rr * ldd + dcol + cc) = 0u; }
            }
            __syncthreads();
        }
        {
            LAS float* scr = (LAS float*)(lds + wid * 16384);
            constexpr int I_IN = 16 * (NIN / 32), I_SQ = 16 * 32, I_FI = 16 * (2 * DFF / 32), I_FO = (DFF / 64) * 32;
            constexpr int NITEMS = I_IN + 3 * I_SQ + I_FI + I_FO;
            const bool skipw = (G > 80) && (bx < 40);
            const int wfirst = (G > 80) ? (bx - 40) * 8 + wid : gw, wstride = (G > 80) ? (G - 40) * 8 : NGW;
            if (!skipw) for (int it = wfirst; it < NITEMS; it += wstride) {
                int q = it;
                if (q < I_IN) { p0_transpose_item<1>(p_w_in, NIN, p_Win_t, DM, 0, scr, q, lane, p_pre_mix_gain); continue; } q -= I_IN;
                if (q < I_SQ) { p0_transpose_item<0>(p_w_bswa, DM, p_Wcat_t, 2048, 0, scr, q, lane); continue; } q -= I_SQ;
                if (q < I_SQ) { p0_transpose_item<0>(p_w_bdiff, DM, p_Wcat_t, 2048, 1024, scr, q, lane); continue; } q -= I_SQ;
                if (q < I_SQ) { p0_transpose_item<0>(p_w_out, DM, p_Wout_t, DM, 0, scr, q, lane); continue; } q -= I_SQ;
                if (q < I_FI) { p0_transpose_item<2>(p_w_ffn_in, 2 * DFF, p_Wffi_t, DM, 0, scr, q, lane, p_pre_ffn_gain); continue; } q -= I_FI;
                p0_transpose_item<0>(p_w_ffn_out, DM, p_Wffo_t, DFF, 0, scr, q, lane);
            }
        }
        for (int base = gw; base < NTOK; base += 4 * NGW) {
            f32x4 v[4][4]; float sq[4];
#pragma unroll
            for (int q = 0; q < 4; ++q) { const int mrow = (base + q * NGW < NTOK) ? base + q * NGW : NTOK - 1; const f32x4* xr = (const f32x4*)(p_x + (size_t)mrow * DM) + lane;
#pragma unroll
                for (int j = 0; j < 4; ++j) v[q][j] = xr[64 * j]; }
#pragma unroll
            for (int q = 0; q < 4; ++q) { float s = 0.f;
#pragma unroll
                for (int j = 0; j < 4; ++j) s += (v[q][j][0] * v[q][j][0] + v[q][j][1] * v[q][j][1]) + (v[q][j][2] * v[q][j][2] + v[q][j][3] * v[q][j][3]);
                sq[q] = 1.f / sqrtf(wave_sum(s) * (1.f / DM) + RMS_EPS); }
#pragma unroll
            for (int q = 0; q < 4; ++q) { if (base + q * NGW < NTOK) { u32x2* o8 = (u32x2*)(p_U + (size_t)(base + q * NGW) * DM) + lane; if (lane == 0) ((float*)(ws + WS_RSX))[base + q * NGW] = sq[q];
#pragma unroll
                for (int j = 0; j < 4; ++j) { const float rstd = sq[q]; u32x2 w; w.x = cvtpk(v[q][j][0] * rstd, v[q][j][1] * rstd); w.y = cvtpk(v[q][j][2] * rstd, v[q][j][3] * rstd); o8[64 * j] = w; } } }
        }
    }
    if (a.ws == nullptr) grid.sync();
    xcd_barrier(xbar);
    PROBE_DELAY(0);

#endif
#if PH_ON(1)
    PROBE_T0(1);
    {
        pg8::Gemm g{p_U, p_Win_t, NTOK, NIN, DM}; pg8::StaticOrder S; S.init(NTOK, NIN, G, bx, WGM_P1);
        pg8::EpiInProj E{ws, p_GATES, p_b_gate};
        pg8::gemm_phase<pg8::EpiInProj, pg8::StaticOrder, true, true>(lds, g, S, E);
    }
    xcd_barrier(xbar);
    PROBE_DELAY(1);

#endif
#if PH_ON(2)
    PROBE_T0(2);
    {
        int tid_o = threadIdx.x; asm volatile("" : "+v"(tid_o));
        const int tid = tid_o, lane = tid & 63, wid = __builtin_amdgcn_readfirstlane(tid >> 6);
        unsigned long long att_acc = 0, att_dummy = 0;
        float lam;
        { float p1 = p_lq1[lane] * p_lk1[lane], p2 = p_lq2[lane] * p_lk2[lane]; p1 = wave_sum(p1); p2 = wave_sum(p2); lam = expf(p1) - expf(p2) + 0.2f; }
        for (int uidx = vcu; uidx < 2048; uidx += G) {
            const int i = uidx & 15, hh = (uidx >> 4) & 7, b = uidx >> 7;
            const size_t qrow = (size_t)b * SEQL + i * 128 + 32 * (wid & 3);
            att::attn_unit<128, 128, false>(lds, tid, wid, lane, p_QO + qrow * 2048 + 1024 + hh * 128 + 64 * (wid >> 2),
                                            p_KB + (size_t)b * SEQL * 1024 + hh * 128, p_KBm + hh * 128, 1024, p_VB + (size_t)b * SEQL * 1024 + hh * 128, p_VBm + hh * 128, 1024,
                                            0, 32, 0, 0.f, lam, p_subln_gain, p_QO + qrow * 2048 + 1024 + hh * 128, att_acc);
        }
#if ATT_PROBE == 9
        const unsigned long long swa_t0 = __builtin_amdgcn_s_memrealtime();
#endif
        for (int uidx = vcu; uidx < 1024; uidx += G) {
            const int i = uidx & 15, gk = (uidx >> 4) & 3, b = uidx >> 6;
            const int t0 = (i >= 1) ? 2 * (i - 1) : 0, t1 = (2 * (i + 2) < 32) ? 2 * (i + 2) : 32;
            att::swa_unit(lds, tid, wid, lane, p_QO + ((size_t)b * SEQL + i * 128) * 2048 + gk * 256,
                          p_KA + (size_t)b * SEQL * 256 + gk * 64, p_KAm + gk * 64, p_VA + (size_t)b * SEQL * 256 + gk * 64, p_VAm + gk * 64, t0, t1 - t0, i * 128, p_attn_sink + gk * 4);
        }
#if ATT_PROBE == 9
        att_acc = __builtin_amdgcn_s_memrealtime() - swa_t0;
#endif
#if ATT_PROBE
        if (wid == 0) { const unsigned long long t1_ = __builtin_amdgcn_s_memrealtime(); while (__builtin_amdgcn_s_memrealtime() - t1_ < att_acc) __builtin_amdgcn_s_sleep(8); }
        __syncthreads();
#endif
    }
    xcd_barrier(xbar);
    PROBE_DELAY(2);

#endif
#if PH_ON(3)
    PROBE_T0(3);
    {
        pg8::Gemm g{p_QO, p_Wcat_t, NTOK, DM, 2048}; pg8::StaticOrder S; S.init(NTOK, DM, G, bx, WGM_N1K);
        pg8::EpiMerge E{p_GATES, p_MERGED};
        pg8::gemm_phase<pg8::EpiMerge, pg8::StaticOrder, true, true>(lds, g, S, E);
    }
    xcd_barrier(xbar);
    PROBE_DELAY(3);

#endif
#if PH_ON(4)
    PROBE_T0(4);
    {
        pg8::Gemm g{p_MERGED, p_Wout_t, NTOK, DM, DM}; pg8::StaticOrder S; S.init(NTOK, DM, G, bx, WGM_N1K);
        pg8::EpiYSS E{p_Y, p_ss1};
        pg8::gemm_phase<pg8::EpiYSS, pg8::StaticOrder, true, true>(lds, g, S, E);
    }
    xcd_barrier(xbar);
    PROBE_DELAY(4);

#endif
#if PH_ON(5)
    PROBE_T0(5);
    {
        int tid_o = threadIdx.x; asm volatile("" : "+v"(tid_o));
        const int tid = tid_o, lane = tid & 63, wid = __builtin_amdgcn_readfirstlane(tid >> 6), gw = bx * 8 + wid; (void)tid; (void)gw;
    for (int base = gw; base < NTOK; base += 4 * NGW) {
        f32x4 hv[4][4]; u32x2 yw[4][4]; u32x2 xw[4][4]; float r1[4], rx[4];
#pragma unroll
        for (int q = 0; q < 4; ++q) { const int mrow = (base + q * NGW < NTOK) ? base + q * NGW : NTOK - 1;
            const u32x2* xr = (const u32x2*)(p_U + (size_t)mrow * DM) + lane; const u32x2* yr = (const u32x2*)(p_Y + (size_t)mrow * DM) + lane;
            r1[q] = p_ss1[mrow]; rx[q] = ((const float*)(ws + WS_RSX))[mrow];
#pragma unroll
            for (int j = 0; j < 4; ++j) { xw[q][j] = xr[64 * j]; yw[q][j] = yr[64 * j]; } }
#pragma unroll
        for (int q = 0; q < 4; ++q) {
            const float rstd1 = 1.f / sqrtf(r1[q] * (1.f / DM) + RMS_EPS), xs = 1.f / rx[q]; float s2 = 0.f;
#pragma unroll
            for (int j = 0; j < 4; ++j) { const f32x4 g = *((const f32x4*)p_post_mix_gain + lane + 64 * j); f32x4 t; t[0] = bf_lo(xw[q][j].x) * xs; t[1] = bf_hi(xw[q][j].x) * xs; t[2] = bf_lo(xw[q][j].y) * xs; t[3] = bf_hi(xw[q][j].y) * xs;
                t[0] += bf_lo(yw[q][j].x) * rstd1 * g[0]; t[1] += bf_hi(yw[q][j].x) * rstd1 * g[1]; t[2] += bf_lo(yw[q][j].y) * rstd1 * g[2]; t[3] += bf_hi(yw[q][j].y) * rstd1 * g[3];
                hv[q][j] = t; s2 += (t[0] * t[0] + t[1] * t[1]) + (t[2] * t[2] + t[3] * t[3]); }
            r1[q] = 1.f / sqrtf(wave_sum(s2) * (1.f / DM) + RMS_EPS);
        }
#pragma unroll
        for (int q = 0; q < 4; ++q) { if (base + q * NGW < NTOK) { const int mrow = base + q * NGW; const float rstd2 = r1[q];
            u32x2* hrow = (u32x2*)(p_H1 + (size_t)mrow * DM) + lane; if (lane == 0) ((float*)(ws + WS_RS2))[mrow] = rstd2;
#pragma unroll
            for (int j = 0; j < 4; ++j) { u32x2 hw; hw.x = cvtpk(hv[q][j][0] * rstd2, hv[q][j][1] * rstd2); hw.y = cvtpk(hv[q][j][2] * rstd2, hv[q][j][3] * rstd2); hrow[64 * j] = hw; } } }
    }
    }
    xcd_barrier(xbar);
    PROBE_DELAY(5);

#endif
#if PH_ON(6)
    PROBE_T0(6);
    {
        pg8::Gemm g{p_H1, p_Wffi_t, NTOK, 2 * DFF, DM}; pg8::StaticOrder S; S.init(NTOK, 2 * DFF, G, bx, WGM_P6);
        pg8::EpiSwiGLU E{p_F};
        pg8::gemm_phase<pg8::EpiSwiGLU, pg8::StaticOrder, true, true>(lds, g, S, E);
    }
    xcd_barrier(xbar);
    PROBE_DELAY(6);

#endif
#if PH_ON(7)
    PROBE_T0(7);
    {
        pg8::Gemm g{p_F, p_Wffo_t, NTOK, DM, DFF}; pg8::StaticOrder S; S.init(NTOK, DM, G, bx, WGM_N1K);
        pg8::EpiYSS E{p_FO, p_ss3};
        pg8::gemm_phase<pg8::EpiYSS, pg8::StaticOrder, true, true>(lds, g, S, E);
    }
    xcd_barrier(xbar);
    PROBE_DELAY(7);

#endif
#if PH_ON(8)
    PROBE_T0(8);
    {
        int tid_o = threadIdx.x; asm volatile("" : "+v"(tid_o));
        const int tid = tid_o, lane = tid & 63, wid = __builtin_amdgcn_readfirstlane(tid >> 6), gw = bx * 8 + wid; (void)tid; (void)gw;
    for (int base = gw; base < NTOK; base += 4 * NGW) {
        u32x2 hw[4][4]; u32x2 fw[4][4]; float r3[4], r2[4];
#pragma unroll
        for (int q = 0; q < 4; ++q) { const int mrow = (base + q * NGW < NTOK) ? base + q * NGW : NTOK - 1;
            const u32x2* hr = (const u32x2*)(p_H1 + (size_t)mrow * DM) + lane; const u32x2* fr_ = (const u32x2*)(p_FO + (size_t)mrow * DM) + lane;
            r3[q] = p_ss3[mrow]; r2[q] = ((const float*)(ws + WS_RS2))[mrow];
#pragma unroll
            for (int j = 0; j < 4; ++j) { hw[q][j] = hr[64 * j]; fw[q][j] = fr_[64 * j]; } }
#pragma unroll
        for (int q = 0; q < 4; ++q) { if (base + q * NGW < NTOK) { const int mrow = base + q * NGW; const float rstd3 = 1.f / sqrtf(r3[q] * (1.f / DM) + RMS_EPS);
            f32x4* orow = (f32x4*)(p_out + (size_t)mrow * DM) + lane;
#pragma unroll
            for (int j = 0; j < 4; ++j) { const f32x4 g = *((const f32x4*)p_post_ffn_gain + lane + 64 * j); const float hs = 1.f / r2[q]; f32x4 o; o[0] = bf_lo(hw[q][j].x) * hs; o[1] = bf_hi(hw[q][j].x) * hs; o[2] = bf_lo(hw[q][j].y) * hs; o[3] = bf_hi(hw[q][j].y) * hs;
                o[0] += bf_lo(fw[q][j].x) * rstd3 * g[0]; o[1] += bf_hi(fw[q][j].x) * rstd3 * g[1]; o[2] += bf_lo(fw[q][j].y) * rstd3 * g[2]; o[3] += bf_hi(fw[q][j].y) * rstd3 * g[3];
                orow[64 * j] = o; } } }
    }
    }
#if PROBE_PHASE == 9
    for (int i9 = 0; i9 < 10; ++i9) grid.sync();
#endif
#if PROBE_PHASE == 8
    xcd_barrier(xbar);
    PROBE_DELAY(8);
#endif
#endif
}


extern "C" void kernel_launch(void* const* d_in, const int* in_sizes, int n_in, void* d_out, int out_size, void* d_ws, size_t ws_size, hipStream_t stream) {
    static int grid_blocks = 0;
    if (grid_blocks == 0) {
        if (n_in != 19 || out_size != NTOK * DM || ws_size < WS_END) { fprintf(stderr, "kernel_launch: unexpected shapes (n_in %d, out %d, ws %zu)\n", n_in, out_size, ws_size); grid_blocks = -1; return; }
        int dev = 0, cus = 0, per_cu = 0;
        hipGetDevice(&dev);
        hipDeviceGetAttribute(&cus, hipDeviceAttributeMultiprocessorCount, dev);
        hipFuncSetAttribute((const void*)fwd_megakernel, hipFuncAttributeMaxDynamicSharedMemorySize, LDS_BYTES);
        hipOccupancyMaxActiveBlocksPerMultiprocessor(&per_cu, (const void*)fwd_megakernel, 512, LDS_BYTES);
        if (per_cu < 1) { fprintf(stderr, "kernel_launch: occupancy query says %d blocks per CU\n", per_cu); per_cu = 1; }
        if (per_cu > 1) per_cu = 1;
        grid_blocks = cus * per_cu;
    }
    if (grid_blocks < 0) return;
    if (hipMemsetAsync((unsigned char*)d_ws + WS_BAR, 0, XCD_BAR_WORDS * 4, stream) != hipSuccess) { fprintf(stderr, "kernel_launch: memset of the barrier words failed\n"); return; }
    Args a{};
    for (int i = 0; i < 19; ++i) a.in[i] = (const float*)d_in[i];
    a.out = (float*)d_out; a.ws = (unsigned char*)d_ws;
    void* args[] = {&a};
    hipError_t e = hipLaunchCooperativeKernel((const void*)fwd_megakernel, dim3(grid_blocks), dim3(512), args, LDS_BYTES, stream);
    if (e != hipSuccess) fprintf(stderr, "cooperative launch failed: %s (grid %d)\n", hipGetErrorString(e), grid_blocks);
}
```

```cpp
#include <hip/hip_runtime.h>
#include <hip/hip_cooperative_groups.h>
#include <cstdio>
#include <cstdint>
namespace cg = cooperative_groups;

constexpr size_t MiB = 1u << 20;
constexpr size_t WS_RSX = 256 * 1024, WS_RS2 = 384 * 1024;
constexpr size_t WS_SS1 = 0, WS_SS3 = 128 * 1024, WS_ROPE = 1 * MiB, WS_KAM = 2 * MiB, WS_VAM = WS_KAM + 32 * 1024, WS_KBM = WS_KAM + 64 * 1024, WS_VBM = WS_KAM + 192 * 1024;
constexpr size_t WS_WIN = 4 * MiB, WS_WCAT = 17 * MiB, WS_WOUT = 21 * MiB, WS_WFFI = 23 * MiB, WS_WFFO = 34 * MiB;
constexpr size_t WS_U = 48 * MiB, WS_QO = 112 * MiB, WS_KA = 240 * MiB, WS_VA = 256 * MiB, WS_KB = 272 * MiB, WS_VB = 336 * MiB, WS_MERGED = 400 * MiB;
constexpr size_t WS_Y = 272 * MiB, WS_F = 112 * MiB, WS_FO = 48 * MiB  , WS_H1 = 400 * MiB  , WS_END = 464 * MiB;

namespace pg8 {
#define PG8_LAS __attribute__((address_space(3)))
typedef unsigned short bf16_t;
typedef short bf16x8 __attribute__((ext_vector_type(8)));
typedef float f32x4 __attribute__((ext_vector_type(4)));
typedef unsigned u32x4 __attribute__((ext_vector_type(4)));
constexpr int BM = 256, BK = 64, HALF = 128, HTB = HALF * BK * 2  , STAGE_BYTES = 8 * HTB, NXCD = 8, WGM = 4;

__host__ __device__ __forceinline__ int lds_byte(int r, int c) { const int st = (r >> 4) * 2 + (c >> 5), rr = r & 15, cc = c & 31, ob = rr * 64 + cc * 2; return st * 1024 + (ob ^ (((ob >> 9) & 1) << 5)); }
__host__ __device__ __forceinline__ void stage_rc(int b, int& R, int& C) { const int st = b / 1024, sb = b % 1024, swz = sb ^ (((sb >> 9) & 1) << 5); R = (st >> 1) * 16 + swz / 64; C = (st & 1) * 32 + (swz % 64) / 2; }
__host__ __device__ __forceinline__ int perm32(int rho) { const int n = rho >> 4, i = rho & 15; return 8 * (i >> 2) + 4 * n + (i & 3); }

struct Unit { int pm, pn; };
struct Gemm { const bf16_t* A; const bf16_t* Bt; int M, N, K; };

struct StaticOrder {
    int nM, nN, nwg, G, c, wgm;
    __host__ __device__ void init(int M, int N, int G_, int c_, int wgm_ = WGM) { nM = M / BM; nN = N / BM; nwg = nM * nN; G = G_; c = c_; wgm = wgm_; }
    __host__ __device__ bool next(int i, Unit& u) const {
        const long L = (long)i * G + c; if (L >= nwg) return false;
        int wgid = (int)L; { const int q = nwg / NXCD, r = nwg % NXCD, xcd = wgid % NXCD, off = wgid / NXCD; wgid = (xcd < r ? xcd * (q + 1) : r * (q + 1) + (xcd - r) * q) + off; }
        const int nig = wgm * nN, gid = wgid / nig, fm = gid * wgm, gsz = (nM - fm) < wgm ? (nM - fm) : wgm;
        u.pm = fm + ((wgid % nig) % gsz); u.pn = (wgid % nig) / gsz; return true;
    }
    __device__ __forceinline__ void a_ready(const Unit&) const {}
    __device__ __forceinline__ void done(const Unit&) const {}
};


typedef float f32x2_t __attribute__((ext_vector_type(2))); typedef __bf16 bf16x2_t __attribute__((ext_vector_type(2)));
__device__ __forceinline__ unsigned cvtpk(float lo, float hi) { f32x2_t v = {lo, hi}; bf16x2_t b = __builtin_convertvector(v, bf16x2_t); return __builtin_bit_cast(unsigned, b); }
__device__ __forceinline__ float bf_lo(unsigned w) { return __uint_as_float(w << 16); }
__device__ __forceinline__ float bf_hi(unsigned w) { return __uint_as_float(w & 0xffff0000u); }
constexpr float QK_C2 = 0.125f * 1.4426950408889634f;

struct EpiInProj {
    static constexpr bool PERM = true, AFTER_DRAIN = false, HAS_MID = false;
    unsigned char* ws; bf16_t* G; const float* bgate;
    __device__ __forceinline__ void mid(f32x4 (&)[2][2][4][2], const Unit&, int, int, int, int) const {}
    __device__ __forceinline__ void operator()(const f32x4 (&acc)[2][2][4][2], const Unit& u, int wr, int wc, int fr, int fq) const {
        const int pn = u.pn, row0 = u.pm * BM + wr * 64 + fr, cl = wc * 32 + 8 * fq;
        bf16_t* dst; int ldc, cb, mode; float sc0 = 1.f;
        const float* rope = (const float*)(ws + WS_ROPE);
        if (pn < 4)       { dst = (bf16_t*)(ws + WS_QO);        ldc = 2048; cb = pn * 256;        mode = 1; sc0 = QK_C2; }
        else if (pn == 4) { dst = (bf16_t*)(ws + WS_KA);        ldc = 256;  cb = 0;               mode = 1; }
        else if (pn == 5) { dst = (bf16_t*)(ws + WS_VA);        ldc = 256;  cb = 0;               mode = 0; }
        else if (pn < 10) { dst = (bf16_t*)(ws + WS_QO) + 1024; ldc = 2048; cb = (pn - 6) * 256;  mode = 1; sc0 = QK_C2; }
        else if (pn < 14) { dst = (bf16_t*)(ws + WS_KB);        ldc = 1024; cb = (pn - 10) * 256; mode = 1; }
        else if (pn < 18) { dst = (bf16_t*)(ws + WS_VB);        ldc = 1024; cb = (pn - 14) * 256; mode = 0; }
        else              { dst = G;                            ldc = 2048; cb = (pn - 18) * 256; mode = 2; }
        if (mode == 1) {
            const int i0 = 16 * (wc & 1) + 4 * fq;
#pragma unroll
            for (int ai = 0; ai < 2; ++ai)
#pragma unroll
                for (int m = 0; m < 4; ++m) {
                    const int row = row0 + ai * HALF + m * 16, pos = 16 + (row & 2047);
                    const f32x4 c0 = *(const f32x4*)(rope + (size_t)(pos * 32 + i0) * 2), c1 = *(const f32x4*)(rope + (size_t)(pos * 32 + i0 + 2) * 2);
                    const float sc = sc0;
#pragma unroll
                    for (int bj = 0; bj < 2; ++bj) {
                        const f32x4 v0 = acc[ai][bj][m][0], v1 = acc[ai][bj][m][1]; u32x4 w;
                        w.x = cvtpk((v0[0] * c0[0] - v0[1] * c0[1]) * sc, (v0[1] * c0[0] + v0[0] * c0[1]) * sc);
                        w.y = cvtpk((v0[2] * c0[2] - v0[3] * c0[3]) * sc, (v0[3] * c0[2] + v0[2] * c0[3]) * sc);
                        w.z = cvtpk((v1[0] * c1[0] - v1[1] * c1[1]) * sc, (v1[1] * c1[0] + v1[0] * c1[1]) * sc);
                        w.w = cvtpk((v1[2] * c1[2] - v1[3] * c1[3]) * sc, (v1[3] * c1[2] + v1[2] * c1[3]) * sc);
                        *(u32x4*)(dst + (size_t)row * ldc + cb + bj * HALF + cl) = w;
                    }
                }
        } else if (mode == 0) {
#pragma unroll
            for (int ai = 0; ai < 2; ++ai)
#pragma unroll
                for (int m = 0; m < 4; ++m) {
                    const int row = row0 + ai * HALF + m * 16;
#pragma unroll
                    for (int bj = 0; bj < 2; ++bj) {
                        const f32x4 v0 = acc[ai][bj][m][0], v1 = acc[ai][bj][m][1]; u32x4 w;
                        w.x = cvtpk(v0[0], v0[1]); w.y = cvtpk(v0[2], v0[3]); w.z = cvtpk(v1[0], v1[1]); w.w = cvtpk(v1[2], v1[3]);
                        *(u32x4*)(dst + (size_t)row * ldc + cb + bj * HALF + cl) = w;
                    }
                }
        } else {
            f32x4 bv[2][2];
#pragma unroll
            for (int bj = 0; bj < 2; ++bj)
#pragma unroll
                for (int n = 0; n < 2; ++n) bv[bj][n] = *(const f32x4*)(bgate + cb + bj * HALF + cl + 4 * n);
#pragma unroll
            for (int ai = 0; ai < 2; ++ai)
#pragma unroll
                for (int m = 0; m < 4; ++m) {
                    const int row = row0 + ai * HALF + m * 16;
#pragma unroll
                    for (int bj = 0; bj < 2; ++bj) {
                        const f32x4 v0 = acc[ai][bj][m][0] + bv[bj][0], v1 = acc[ai][bj][m][1] + bv[bj][1]; float s[8];
#pragma unroll
                        for (int e = 0; e < 4; ++e) { s[e] = __builtin_amdgcn_rcpf(1.f + __expf(-v0[e])); s[4 + e] = __builtin_amdgcn_rcpf(1.f + __expf(-v1[e])); }
                        u32x4 w; w.x = cvtpk(s[0], s[1]); w.y = cvtpk(s[2], s[3]); w.z = cvtpk(s[4], s[5]); w.w = cvtpk(s[6], s[7]);
                        *(u32x4*)(dst + (size_t)row * ldc + cb + bj * HALF + cl) = w;
                    }
                }
        }
    }
};

struct EpiMerge {
    static constexpr bool PERM = true, AFTER_DRAIN = false, HAS_MID = true;
    const bf16_t* G; bf16_t* out;
    __device__ __forceinline__ void mid(f32x4 (&acc)[2][2][4][2], const Unit& u, int wr, int wc, int fr, int fq) const {
        int row0 = u.pm * BM + wr * 64 + fr, col0 = u.pn * BM + wc * 32 + 8 * fq;
        asm volatile("" : "+v"(row0), "+v"(col0));
#pragma unroll
        for (int ai = 0; ai < 2; ++ai)
#pragma unroll
            for (int m = 0; m < 4; ++m) {
                const bf16_t* gp = G + (size_t)(row0 + ai * HALF + m * 16) * 2048 + col0;
#pragma unroll
                for (int bj = 0; bj < 2; ++bj) {
                    const u32x4 a = *(const u32x4*)(gp + bj * HALF), d = *(const u32x4*)(gp + 1024 + bj * HALF);
                    f32x4 r0, r1;
                    r0[0] = bf_lo(a.x) * __builtin_amdgcn_rcpf(fmaxf(bf_lo(d.x), 1e-20f)); r0[1] = bf_hi(a.x) * __builtin_amdgcn_rcpf(fmaxf(bf_hi(d.x), 1e-20f));
                    r0[2] = bf_lo(a.y) * __builtin_amdgcn_rcpf(fmaxf(bf_lo(d.y), 1e-20f)); r0[3] = bf_hi(a.y) * __builtin_amdgcn_rcpf(fmaxf(bf_hi(d.y), 1e-20f));
                    r1[0] = bf_lo(a.z) * __builtin_amdgcn_rcpf(fmaxf(bf_lo(d.z), 1e-20f)); r1[1] = bf_hi(a.z) * __builtin_amdgcn_rcpf(fmaxf(bf_hi(d.z), 1e-20f));
                    r1[2] = bf_lo(a.w) * __builtin_amdgcn_rcpf(fmaxf(bf_lo(d.w), 1e-20f)); r1[3] = bf_hi(a.w) * __builtin_amdgcn_rcpf(fmaxf(bf_hi(d.w), 1e-20f));
                    acc[ai][bj][m][0] *= r0; acc[ai][bj][m][1] *= r1;
                }
                asm volatile("" ::: "memory");
            }
    }
    __device__ __forceinline__ void operator()(const f32x4 (&acc)[2][2][4][2], const Unit& u, int wr, int wc, int fr, int fq) const {
        const int row0 = u.pm * BM + wr * 64 + fr, col0 = u.pn * BM + wc * 32 + 8 * fq;
#pragma unroll
        for (int ai = 0; ai < 2; ++ai)
#pragma unroll
            for (int m = 0; m < 4; ++m) {
                const int row = row0 + ai * HALF + m * 16; const bf16_t* gp = G + (size_t)row * 2048 + 1024 + col0;
#pragma unroll
                for (int bj = 0; bj < 2; ++bj) {
                    const u32x4 d = *(const u32x4*)(gp + bj * HALF); const f32x4 v0 = acc[ai][bj][m][0], v1 = acc[ai][bj][m][1]; u32x4 w;
                    w.x = cvtpk(v0[0] * fmaxf(bf_lo(d.x), 1e-20f), v0[1] * fmaxf(bf_hi(d.x), 1e-20f)); w.y = cvtpk(v0[2] * fmaxf(bf_lo(d.y), 1e-20f), v0[3] * fmaxf(bf_hi(d.y), 1e-20f));
                    w.z = cvtpk(v1[0] * fmaxf(bf_lo(d.z), 1e-20f), v1[1] * fmaxf(bf_hi(d.z), 1e-20f)); w.w = cvtpk(v1[2] * fmaxf(bf_lo(d.w), 1e-20f), v1[3] * fmaxf(bf_hi(d.w), 1e-20f));
                    *(u32x4*)(out + (size_t)row * 1024 + col0 + bj * HALF) = w;
                }
                asm volatile("" ::: "memory");
            }
    }
};

struct EpiYSS {
    static constexpr bool PERM = true, AFTER_DRAIN = false, HAS_MID = false;
    bf16_t* Y; float* ss;
    __device__ __forceinline__ void mid(f32x4 (&)[2][2][4][2], const Unit&, int, int, int, int) const {}
    __device__ __forceinline__ void operator()(const f32x4 (&acc)[2][2][4][2], const Unit& u, int wr, int wc, int fr, int fq) const {
        const int row0 = u.pm * BM + wr * 64 + fr, col0 = u.pn * BM + wc * 32 + 8 * fq;
#pragma unroll
        for (int ai = 0; ai < 2; ++ai)
#pragma unroll
            for (int m = 0; m < 4; ++m) {
                const int row = row0 + ai * HALF + m * 16; float s = 0.f;
#pragma unroll
                for (int bj = 0; bj < 2; ++bj) {
                    const f32x4 v0 = acc[ai][bj][m][0], v1 = acc[ai][bj][m][1]; u32x4 w;
                    s += (v0[0] * v0[0] + v0[1] * v0[1]) + (v0[2] * v0[2] + v0[3] * v0[3]) + (v1[0] * v1[0] + v1[1] * v1[1]) + (v1[2] * v1[2] + v1[3] * v1[3]);
                    w.x = cvtpk(v0[0], v0[1]); w.y = cvtpk(v0[2], v0[3]); w.z = cvtpk(v1[0], v1[1]); w.w = cvtpk(v1[2], v1[3]);
                    *(u32x4*)(Y + (size_t)row * 1024 + col0 + bj * HALF) = w;
                }
                s += __shfl_xor(s, 16); s += __shfl_xor(s, 32);
                if (fq == 0) atomicAdd(ss + row, s);
            }
    }
};

struct EpiSwiGLU {
    static constexpr bool PERM = true, AFTER_DRAIN = false, HAS_MID = false;
    bf16_t* F;
    __device__ __forceinline__ void mid(f32x4 (&)[2][2][4][2], const Unit&, int, int, int, int) const {}
    __device__ __forceinline__ void operator()(const f32x4 (&acc)[2][2][4][2], const Unit& u, int wr, int wc, int fr, int fq) const {
        const int row0 = u.pm * BM + wr * 64 + fr, col0 = u.pn * 128 + wc * 16 + 4 * fq;
#pragma unroll
        for (int ai = 0; ai < 2; ++ai)
#pragma unroll
            for (int m = 0; m < 4; ++m) {
                const int row = row0 + ai * HALF + m * 16;
#pragma unroll
                for (int bj = 0; bj < 2; ++bj) {
                    const f32x4 g = acc[ai][bj][m][0], up = acc[ai][bj][m][1]; float o[4];
#pragma unroll
                    for (int e = 0; e < 4; ++e) o[e] = g[e] * __builtin_amdgcn_rcpf(1.f + __expf(-g[e])) * up[e];
                    unsigned long long w = (unsigned long long)cvtpk(o[0], o[1]) | ((unsigned long long)cvtpk(o[2], o[3]) << 32);
                    *(unsigned long long*)(F + (size_t)row * 2816 + col0 + bj * 64) = w;
                }
            }
    }
};

template <class Epi, class Sched, bool ALIGN_EPI = false, bool SP2 = false>
__device__ __forceinline__ void gemm_phase(PG8_LAS unsigned char* lds, const Gemm g, const Sched& S, Epi& E) {
    int tid_ = threadIdx.x; asm volatile("" : "+v"(tid_));
    const int tid = tid_, wid = __builtin_amdgcn_readfirstlane(tid >> 6), lane = tid & 63, wr = wid >> 2, wc = wid & 3, fr = lane & 15, fq = lane >> 4;
    const int K = g.K, nt = K / BK;
    unsigned voffA[2], voffB[2];
#pragma unroll
    for (int i = 0; i < 2; ++i) { int R, C; stage_rc(tid * 16 + i * 8192, R, C); const int Rb = Epi::PERM ? ((R & ~31) + perm32(R & 31)) : R;
        voffA[i] = (unsigned)(R * K + C) * 2u; voffB[i] = (unsigned)(Rb * K + C) * 2u; }
    const size_t kstep = (size_t)(BK * 2);
    const size_t hstep = (size_t)HALF * K * 2;
    const size_t tstep = 2 * hstep;
    const unsigned ldsw = (unsigned)wid * 1024u;
    const int aoff = lds_byte(wr * 64 + fr, fq * 8), boff = lds_byte(wc * 32 + fr, fq * 8);
#define PG8_SA(b, h) (((b) * 2 + (h)) * HTB)
#define PG8_SB(b, h) ((4 + (b) * 2 + (h)) * HTB)
#define PG8_STAGE(bufoff, gbase, voff) do { _Pragma("unroll") for (int _i = 0; _i < 2; ++_i) \
        __builtin_amdgcn_global_load_lds((const unsigned*)((const char*)(gbase) + (voff)[_i]), (PG8_LAS unsigned*)(lds + (bufoff) + ldsw + _i * 8192), 16, 0, 0); } while (0)
#define PG8_LDA(dst, b, h) do { _Pragma("unroll") for (int m = 0; m < 4; ++m) _Pragma("unroll") for (int k = 0; k < 2; ++k) dst[m][k] = *(const PG8_LAS bf16x8*)(lds + PG8_SA(b, h) + aoff + m * 2048 + k * 1024); } while (0)
#define PG8_LDB(dst, b, h) do { _Pragma("unroll") for (int n = 0; n < 2; ++n) _Pragma("unroll") for (int k = 0; k < 2; ++k) dst[n][k] = *(const PG8_LAS bf16x8*)(lds + PG8_SB(b, h) + boff + n * 2048 + k * 1024); } while (0)
#define PG8_MMA(ai, bj, At, Bt) do { __builtin_amdgcn_s_setprio(1); _Pragma("unroll") for (int m = 0; m < 4; ++m) _Pragma("unroll") for (int n = 0; n < 2; ++n) _Pragma("unroll") for (int k = 0; k < 2; ++k) \
        acc[ai][bj][m][n] = __builtin_amdgcn_mfma_f32_16x16x32_bf16(Bt[n][k], At[m][k], acc[ai][bj][m][n], 0, 0, 0); __builtin_amdgcn_s_setprio(0); } while (0)
#define PG8_WAIT_V(n) asm volatile("s_waitcnt vmcnt(" #n ")" ::: "memory")
#define PG8_WAIT_L(n) asm volatile("s_waitcnt lgkmcnt(" #n ")" ::: "memory")
#define PG8_BAR __builtin_amdgcn_s_barrier()
#define PG8_SCHED __builtin_amdgcn_sched_barrier(0)
    Unit cur, nxt; int ui = 0;
    if (!S.next(0, cur)) return;
    f32x4 acc[2][2][4][2];
#pragma unroll
    for (int a = 0; a < 2; ++a)
#pragma unroll
        for (int b = 0; b < 2; ++b)
#pragma unroll
            for (int m = 0; m < 4; ++m)
#pragma unroll
                for (int n = 0; n < 2; ++n) acc[a][b][m][n] = (f32x4){0.f, 0.f, 0.f, 0.f};
    bf16x8 At[4][2], B0[2][2], B1[2][2];
    const char* cA = (const char*)g.A + (size_t)cur.pm * tstep; const char* cB = (const char*)g.Bt + (size_t)cur.pn * tstep;
    S.a_ready(cur);
    if constexpr (SP2) {
        PG8_STAGE(PG8_SB(0, 0), cB, voffB); PG8_STAGE(PG8_SB(0, 1), cB + hstep, voffB); PG8_STAGE(PG8_SA(0, 0), cA, voffA); PG8_STAGE(PG8_SA(0, 1), cA + hstep, voffA);
        if (wr == 1) PG8_BAR;
        PG8_WAIT_V(2); PG8_BAR;
        PG8_STAGE(PG8_SB(1, 0), cB + kstep, voffB); PG8_STAGE(PG8_SA(1, 0), cA + kstep, voffA); PG8_STAGE(PG8_SB(1, 1), cB + hstep + kstep, voffB);
        PG8_WAIT_V(6); PG8_BAR;
    } else {
        PG8_STAGE(PG8_SB(0, 0), cB, voffB); PG8_STAGE(PG8_SA(0, 0), cA, voffA); PG8_STAGE(PG8_SB(0, 1), cB + hstep, voffB); PG8_STAGE(PG8_SA(0, 1), cA + hstep, voffA);
        if (wr == 1) PG8_BAR;
        PG8_WAIT_V(4); PG8_BAR;
        PG8_STAGE(PG8_SB(1, 0), cB + kstep, voffB); PG8_STAGE(PG8_SA(1, 0), cA + kstep, voffA); PG8_STAGE(PG8_SB(1, 1), cB + hstep + kstep, voffB);
        PG8_WAIT_V(6); PG8_BAR;
    }
    for (;;) {
        const bool has_next = S.next(ui + 1, nxt);
        const char* nA = has_next ? (const char*)g.A + (size_t)nxt.pm * tstep : cA; const char* nB = has_next ? (const char*)g.Bt + (size_t)nxt.pn * tstep : cB;
        for (int t = 0; t < nt; t += 2) {
            if constexpr (Epi::HAS_MID) { if (t == (nt >> 1)) E.mid(acc, cur, wr, wc, fr, fq); }
            const bool last = (t == nt - 2);
            const char* a1 = cA + (size_t)(t + 1) * kstep;
            const char* a2 = last ? nA : cA + (size_t)(t + 2) * kstep; const char* b2 = last ? nB : cB + (size_t)(t + 2) * kstep;
            const char* a3 = a2 + kstep; const char* b3 = b2 + kstep;
            if (last && has_next) S.a_ready(nxt);
            if constexpr (SP2) {
            PG8_LDB(B0, 0, 0); PG8_LDB(B1, 0, 1); PG8_SCHED; PG8_LDA(At, 0, 0); PG8_STAGE(PG8_SA(1, 1), a1 + hstep, voffA);
            PG8_WAIT_V(8); PG8_WAIT_L(0); PG8_BAR; PG8_MMA(0, 0, At, B0); PG8_MMA(0, 1, At, B1); PG8_BAR; PG8_SCHED;
            PG8_LDA(At, 0, 1); PG8_STAGE(PG8_SB(0, 0), b2, voffB); PG8_STAGE(PG8_SB(0, 1), b2 + hstep, voffB); PG8_STAGE(PG8_SA(0, 0), a2, voffA);
            PG8_WAIT_V(8); PG8_WAIT_L(0); PG8_BAR; PG8_MMA(1, 0, At, B0); PG8_MMA(1, 1, At, B1); PG8_BAR; PG8_SCHED;
            PG8_LDB(B0, 1, 0); PG8_LDB(B1, 1, 1); PG8_SCHED; PG8_LDA(At, 1, 0); PG8_STAGE(PG8_SA(0, 1), a2 + hstep, voffA);
            PG8_WAIT_V(8); PG8_WAIT_L(0); PG8_BAR; PG8_MMA(0, 0, At, B0); PG8_MMA(0, 1, At, B1); PG8_BAR; PG8_SCHED;
            PG8_LDA(At, 1, 1); PG8_STAGE(PG8_SB(1, 0), b3, voffB); PG8_STAGE(PG8_SB(1, 1), b3 + hstep, voffB); PG8_STAGE(PG8_SA(1, 0), a3, voffA);
            PG8_WAIT_V(8); PG8_WAIT_L(0); PG8_BAR; PG8_MMA(1, 0, At, B0); PG8_MMA(1, 1, At, B1); PG8_BAR; PG8_SCHED;
            } else {
            PG8_LDB(B0, 0, 0); PG8_SCHED; PG8_LDA(At, 0, 0); PG8_STAGE(PG8_SA(1, 1), a1 + hstep, voffA);
            PG8_WAIT_L(8); PG8_BAR; PG8_WAIT_L(0); PG8_MMA(0, 0, At, B0); PG8_BAR; PG8_SCHED;
            PG8_LDB(B1, 0, 1); PG8_STAGE(PG8_SB(0, 0), b2, voffB);
            PG8_BAR; PG8_WAIT_L(0); PG8_MMA(0, 1, At, B1); PG8_BAR;
            PG8_LDA(At, 0, 1); PG8_STAGE(PG8_SA(0, 0), a2, voffA);
            PG8_BAR; PG8_WAIT_L(0); PG8_MMA(1, 0, At, B0); PG8_BAR; PG8_SCHED;
            PG8_STAGE(PG8_SB(0, 1), b2 + hstep, voffB);
            PG8_WAIT_V(6); PG8_BAR; PG8_MMA(1, 1, At, B1); PG8_BAR;
            PG8_LDB(B0, 1, 0); PG8_SCHED; PG8_LDA(At, 1, 0); PG8_STAGE(PG8_SA(0, 1), a2 + hstep, voffA);
            PG8_WAIT_L(8); PG8_BAR; PG8_WAIT_L(0); PG8_MMA(0, 0, At, B0); PG8_BAR; PG8_SCHED;
            PG8_LDB(B1, 1, 1); PG8_STAGE(PG8_SB(1, 0), b3, voffB);
            PG8_BAR; PG8_WAIT_L(0); PG8_MMA(0, 1, At, B1); PG8_BAR;
            PG8_LDA(At, 1, 1); PG8_STAGE(PG8_SA(1, 0), a3, voffA);
            PG8_BAR; PG8_WAIT_L(0); PG8_MMA(1, 0, At, B0); PG8_BAR; PG8_SCHED;
            PG8_STAGE(PG8_SB(1, 1), b3 + hstep, voffB);
            PG8_WAIT_V(6); PG8_BAR; PG8_MMA(1, 1, At, B1); PG8_BAR;
            }
        }
        if constexpr (ALIGN_EPI) { if (wr == 0) PG8_BAR; }
        if constexpr (!Epi::AFTER_DRAIN) { E(acc, cur, wr, wc, fr, fq); S.done(cur); }
        if (!has_next) break;
#pragma unroll
        for (int a = 0; a < 2; ++a)
#pragma unroll
            for (int b = 0; b < 2; ++b)
#pragma unroll
                for (int m = 0; m < 4; ++m)
#pragma unroll
                    for (int n = 0; n < 2; ++n) acc[a][b][m][n] = (f32x4){0.f, 0.f, 0.f, 0.f};
        cur = nxt; cA = nA; cB = nB; ++ui;
        if constexpr (ALIGN_EPI) { if (wr == 1) PG8_BAR; }
    }
    PG8_WAIT_V(0);
    if constexpr (!ALIGN_EPI) { if (wr == 0) PG8_BAR; }
    PG8_BAR;
    if constexpr (Epi::AFTER_DRAIN) { E.fused(acc, cur, wr, wc, fr, fq, lds, wid, lane); S.done(cur); }
#undef PG8_SA
#undef PG8_SB
#undef PG8_STAGE
#undef PG8_LDA
#undef PG8_LDB
#undef PG8_MMA
#undef PG8_WAIT_V
#undef PG8_WAIT_L
#undef PG8_BAR
#undef PG8_SCHED
}
}

namespace att {
#define LAS __attribute__((address_space(3)))
typedef unsigned short bf16_t;
typedef short bf16x8 __attribute__((ext_vector_type(8)));
typedef short s16x4 __attribute__((ext_vector_type(4)));
typedef short v4i16_t __attribute__((ext_vector_type(4)));
typedef float f32x16 __attribute__((ext_vector_type(16)));
typedef float f32x4 __attribute__((ext_vector_type(4)));
typedef unsigned u32x4 __attribute__((ext_vector_type(4)));
typedef unsigned u32x2 __attribute__((ext_vector_type(2)));
using pg8::cvtpk;
__device__ __forceinline__ s16x4 vtr(const LAS unsigned char* p) { return __builtin_bit_cast(s16x4, __builtin_amdgcn_ds_read_tr16_b64_v4i16((LAS v4i16_t*)p)); }
__device__ __forceinline__ int crow(int i, int h) { return (i & 3) + 8 * (i >> 2) + 4 * h; }
__device__ __forceinline__ float xhalf_max(float v) { auto rr = __builtin_amdgcn_permlane32_swap(__float_as_uint(v), __float_as_uint(v), false, false); return fmaxf(__uint_as_float(rr[0]), __uint_as_float(rr[1])); }
__device__ __forceinline__ float xhalf_sum(float v) { auto rr = __builtin_amdgcn_permlane32_swap(__float_as_uint(v), __float_as_uint(v), false, false); return __uint_as_float(rr[0]) + __uint_as_float(rr[1]); }
#define MFMA32(a, b, c) __builtin_amdgcn_mfma_f32_32x32x16_bf16((a), (b), (c), 0, 0, 0)
constexpr float NEGV = -1e30f;
constexpr int ATT_LDS_MAX = 2 * (64 * 272 + 64 * 320);

#ifndef ATT_PROBE
#define ATT_PROBE 0
#endif
#if ATT_PROBE
#define ATT_TS(k) do { if ((k) == ATT_PROBE - 1) att_t = __builtin_amdgcn_s_memrealtime(); if ((k) == ATT_PROBE) att_acc += __builtin_amdgcn_s_memrealtime() - att_t; } while (0)
#else
#define ATT_TS(k) do {} while (0)
#endif
template <int KW, int DV, bool SWA>
__device__ __forceinline__ void attn_unit(LAS unsigned char* lds, const int tid, const int wid, const int lane,
                                          bf16_t* Qw, const bf16_t* Kreal, const bf16_t* Kmeta, const int kpitch, const bf16_t* Vreal, const bf16_t* Vmeta, const int vpitch,
                                          const int t0, const int t1, const int qrel0, const float sink_l2, const float lam, const float* gain, bf16_t* Od, unsigned long long& att_acc) {
    unsigned long long att_t = 0; (void)att_t;
    constexpr int KP = KW * 2 + 16, VP = (DV == 64) ? 192 : 320, KBUF = 64 * KP, VBUF = 64 * VP;
    constexpr int NKC = KW / 64, NVC = DV / 64, KCPR = KW / 8, VCPR = DV / 8, NDB = DV / 32;
    constexpr float THR = 8.f;
    const int r = lane & 31, h = lane >> 5;
    bf16x8 qf[4];
#pragma unroll
    for (int st = 0; st < 4; ++st) qf[st] = *(const bf16x8*)(Qw + (size_t)r * 2048 + 16 * st + 8 * h);
    u32x4 kreg[1][NKC], vreg[1][NVC];
    const int krow_ = tid / KCPR, kcc_ = tid % KCPR, vrow_ = tid / VCPR, vcc_ = tid % VCPR;
#define ATT_LOAD(S, Ks, Vs) do { \
        _Pragma("unroll") for (int i_ = 0; i_ < NKC; ++i_) kreg[S][i_] = *(const u32x4*)((Ks) + (size_t)(krow_ + i_ * (512 / KCPR)) * kpitch + kcc_ * 8); \
        _Pragma("unroll") for (int i_ = 0; i_ < NVC; ++i_) vreg[S][i_] = *(const u32x4*)((Vs) + (size_t)(vrow_ + i_ * (512 / VCPR)) * vpitch + vcc_ * 8); } while (0)
#define ATT_STORE(S, buf) do { \
        _Pragma("unroll") for (int i_ = 0; i_ < NKC; ++i_) *(LAS u32x4*)(lds + (buf) * KBUF + (krow_ + i_ * (512 / KCPR)) * KP + kcc_ * 16) = kreg[S][i_]; \
        _Pragma("unroll") for (int i_ = 0; i_ < NVC; ++i_) *(LAS u32x4*)(lds + 2 * KBUF + (buf) * VBUF + (vrow_ + i_ * (512 / VCPR)) * VP + vcc_ * 16) = vreg[S][i_]; } while (0)
    const int nt = 1 + (t1 - t0);
    ATT_LOAD(0, Kmeta, Vmeta);
    ATT_STORE(0, 0);
    ATT_LOAD(0, Kreal + (size_t)t0 * 64 * kpitch, Vreal + (size_t)t0 * 64 * vpitch);
    __syncthreads();
    const int kcolw = SWA ? 0 : 64 * (wid >> 2);
    const int koff = r * KP + (kcolw + 8 * h) * 2;
    const int voff = (4 * h + ((lane & 15) >> 2)) * VP + (16 * ((lane >> 4) & 1) + 4 * (lane & 3)) * 2;
    f32x16 o[NDB];
    float mhat, l;
    f32x16 s0, s1;
    bf16x8 pf[4];
#define ATT_QK(buf, C0) do { const LAS unsigned char* kb_ = lds + (buf) * KBUF + koff; \
        __builtin_amdgcn_s_setprio(1); \
        _Pragma("unroll") for (int st = 0; st < 4; ++st) { \
            const bf16x8 a0_ = *(const LAS bf16x8*)(kb_ + st * 32), a1_ = *(const LAS bf16x8*)(kb_ + 32 * KP + st * 32); \
            if (st == 0) { s0 = MFMA32(a0_, qf[0], C0); s1 = MFMA32(a1_, qf[0], C0); } else { s0 = MFMA32(a0_, qf[st], s0); s1 = MFMA32(a1_, qf[st], s1); } } \
        __builtin_amdgcn_s_setprio(0); } while (0)
#define ATT_MAX(mx) do { float a_ = fmaxf(fmaxf(s0[0], s0[1]), s1[0]), b_ = fmaxf(fmaxf(s0[2], s0[3]), s1[1]); a_ = fmaxf(fmaxf(a_, s1[2]), s1[3]); \
        _Pragma("unroll") for (int i = 4; i < 16; i += 4) { a_ = fmaxf(fmaxf(a_, s0[i]), s0[i + 1]); b_ = fmaxf(fmaxf(b_, s0[i + 2]), s0[i + 3]); a_ = fmaxf(fmaxf(a_, s1[i]), s1[i + 1]); b_ = fmaxf(fmaxf(b_, s1[i + 2]), s1[i + 3]); } \
        mx = fmaxf(a_, b_); mx = xhalf_max(mx); } while (0)
#define ATT_EXP_PACK() do { float ra_ = 0.f, rb_ = 0.f; \
        _Pragma("unroll") for (int i = 0; i < 16; ++i) { s0[i] = __builtin_amdgcn_exp2f(s0[i]); s1[i] = __builtin_amdgcn_exp2f(s1[i]); ra_ += s0[i]; rb_ += s1[i]; } \
        l += ra_ + rb_; u32x4 w_; \
        w_.x = cvtpk(s0[0], s0[1]); w_.y = cvtpk(s0[2], s0[3]); w_.z = cvtpk(s0[4], s0[5]); w_.w = cvtpk(s0[6], s0[7]); pf[0] = __builtin_bit_cast(bf16x8, w_); \
        w_.x = cvtpk(s0[8], s0[9]); w_.y = cvtpk(s0[10], s0[11]); w_.z = cvtpk(s0[12], s0[13]); w_.w = cvtpk(s0[14], s0[15]); pf[1] = __builtin_bit_cast(bf16x8, w_); \
        w_.x = cvtpk(s1[0], s1[1]); w_.y = cvtpk(s1[2], s1[3]); w_.z = cvtpk(s1[4], s1[5]); w_.w = cvtpk(s1[6], s1[7]); pf[2] = __builtin_bit_cast(bf16x8, w_); \
        w_.x = cvtpk(s1[8], s1[9]); w_.y = cvtpk(s1[10], s1[11]); w_.z = cvtpk(s1[12], s1[13]); w_.w = cvtpk(s1[14], s1[15]); pf[3] = __builtin_bit_cast(bf16x8, w_); } while (0)
#define ATT_EXP_H(S, P0_, P1_) do { float ra_ = 0.f, rb_ = 0.f; \
        _Pragma("unroll") for (int i = 0; i < 16; i += 2) { S[i] = __builtin_amdgcn_exp2f(S[i]); S[i + 1] = __builtin_amdgcn_exp2f(S[i + 1]); ra_ += S[i]; rb_ += S[i + 1]; } \
        l += ra_ + rb_; u32x4 w_; \
        w_.x = cvtpk(S[0], S[1]); w_.y = cvtpk(S[2], S[3]); w_.z = cvtpk(S[4], S[5]); w_.w = cvtpk(S[6], S[7]); P0_ = __builtin_bit_cast(bf16x8, w_); \
        w_.x = cvtpk(S[8], S[9]); w_.y = cvtpk(S[10], S[11]); w_.z = cvtpk(S[12], S[13]); w_.w = cvtpk(S[14], S[15]); P1_ = __builtin_bit_cast(bf16x8, w_); } while (0)
    s16x4 vlo[2][NDB], vhi[2][NDB];
#define ATT_VRD(buf, ks, B) do { const LAS unsigned char* vb_ = lds + 2 * KBUF + (buf) * VBUF + voff; \
        _Pragma("unroll") for (int db = 0; db < NDB; ++db) { vlo[B][db] = vtr(vb_ + (16 * (ks)) * VP + db * 64); vhi[B][db] = vtr(vb_ + (16 * (ks) + 8) * VP + db * 64); } } while (0)
#define ATT_PV(buf, NKS) do { \
        __builtin_amdgcn_s_setprio(1); \
        _Pragma("unroll") for (int ks = 0; ks < (NKS); ++ks) { \
            if (ks + 1 < (NKS)) ATT_VRD(buf, ks + 1, (ks + 1) & 1); \
            _Pragma("unroll") for (int db = 0; db < NDB; ++db) { \
                const bf16x8 va_ = __builtin_shufflevector(vlo[ks & 1][db], vhi[ks & 1][db], 0, 1, 2, 3, 4, 5, 6, 7); \
                o[db] = MFMA32(va_, pf[ks], o[db]); } \
            __builtin_amdgcn_sched_barrier(0); } \
        __builtin_amdgcn_s_setprio(0); } while (0)
#define ATT_SMPV(buf) do { \
        ATT_EXP_H(s0, pf[0], pf[1]); \
        __builtin_amdgcn_sched_barrier(0); \
        ATT_VRD(buf, 1, 1); \
        _Pragma("unroll") for (int db = 0; db < NDB; ++db) { const bf16x8 va_ = __builtin_shufflevector(vlo[0][db], vhi[0][db], 0, 1, 2, 3, 4, 5, 6, 7); o[db] = MFMA32(va_, pf[0], o[db]); } \
        ATT_VRD(buf, 2, 0); \
        _Pragma("unroll") for (int db = 0; db < NDB; ++db) { const bf16x8 va_ = __builtin_shufflevector(vlo[1][db], vhi[1][db], 0, 1, 2, 3, 4, 5, 6, 7); o[db] = MFMA32(va_, pf[1], o[db]); } \
        ATT_EXP_H(s1, pf[2], pf[3]); \
        _Pragma("unroll") for (int g_ = 0; g_ < 2 * NDB; ++g_) { __builtin_amdgcn_sched_group_barrier(0x008, 1, 0); __builtin_amdgcn_sched_group_barrier(0x100, 2, 0); __builtin_amdgcn_sched_group_barrier(0x002, 40 / (2 * NDB), 0); } \
        __builtin_amdgcn_sched_barrier(0); \
        ATT_VRD(buf, 3, 1); \
        _Pragma("unroll") for (int db = 0; db < NDB; ++db) { const bf16x8 va_ = __builtin_shufflevector(vlo[0][db], vhi[0][db], 0, 1, 2, 3, 4, 5, 6, 7); o[db] = MFMA32(va_, pf[2], o[db]); } \
        __builtin_amdgcn_sched_barrier(0); \
        _Pragma("unroll") for (int db = 0; db < NDB; ++db) { const bf16x8 va_ = __builtin_shufflevector(vlo[1][db], vhi[1][db], 0, 1, 2, 3, 4, 5, 6, 7); o[db] = MFMA32(va_, pf[3], o[db]); } \
        __builtin_amdgcn_sched_barrier(0); } while (0)
    f32x16 zero16;
#pragma unroll
    for (int i = 0; i < 16; ++i) zero16[i] = 0.f;
    {
        ATT_QK(0, zero16);
#pragma unroll
        for (int i = 0; i < 16; ++i) { if (i >= 8) s0[i] = NEGV; s1[i] = NEGV; }
        ATT_VRD(0, 0, 0);
        float mx; ATT_MAX(mx);
        mhat = mx; l = 0.f;
#pragma unroll
        for (int i = 0; i < 16; ++i) { s0[i] -= mx; s1[i] -= mx; }
        ATT_EXP_PACK();
#pragma unroll
        for (int db = 0; db < NDB; ++db) o[db] = zero16;
        ATT_PV(0, 1);
        ATT_STORE(0, 1);
        if (2 < nt) ATT_LOAD(0, Kreal + (size_t)(t0 + 1) * 64 * kpitch, Vreal + (size_t)(t0 + 1) * 64 * vpitch);
        __syncthreads();
    }
#define ATT_TILE(it, PAR) do { \
          \
        bool skip_ = false, edge_ = false; \
        if (SWA) { const int k0_ = (t0 + (it) - 1) * 64; skip_ = (k0_ > qrel0 + 31 + 128) || (k0_ + 63 < qrel0 - 128); edge_ = !((k0_ >= qrel0 + 31 - 128) && (k0_ + 63 <= qrel0 + 128)); } \
        if (!skip_) { f32x16 negm_; _Pragma("unroll") for (int i = 0; i < 16; ++i) negm_[i] = -mhat; \
            ATT_QK(PAR, negm_); } \
        if ((it) + 1 < nt) ATT_STORE(0, (PAR) ^ 1);                       \
        if ((it) + 2 < nt) ATT_LOAD(0, Kreal + (size_t)(t0 + (it) + 1) * 64 * kpitch, Vreal + (size_t)(t0 + (it) + 1) * 64 * vpitch);     \
        if (!skip_) { \
            ATT_VRD(PAR, 0, 0);                                           \
            if (SWA && edge_) { const int d0_ = (t0 + (it) - 1) * 64 - (qrel0 + r); \
                _Pragma("unroll") for (int i = 0; i < 16; ++i) { const int d_ = d0_ + crow(i, h); if (d_ < -128 || d_ > 128) s0[i] = NEGV; if (d_ + 32 < -128 || d_ + 32 > 128) s1[i] = NEGV; } } \
            float mx_; ATT_MAX(mx_); \
            if (__builtin_expect(__any(mx_ > THR), 0)) { const float dl_ = fmaxf(mx_, 0.f); mhat += dl_; \
                _Pragma("unroll") for (int i = 0; i < 16; ++i) { s0[i] -= dl_; s1[i] -= dl_; } \
                const float f_ = __builtin_amdgcn_exp2f(-dl_); l *= f_; \
                _Pragma("unroll") for (int db = 0; db < NDB; ++db) _Pragma("unroll") for (int i = 0; i < 16; ++i) o[db][i] *= f_; } \
            ATT_SMPV(PAR); } \
        __syncthreads(); } while (0)
    for (int it = 1; it < nt; it += 2) { ATT_TILE(it, 1); ATT_TILE(it + 1, 0); }
#undef ATT_TILE
#undef ATT_QK
#undef ATT_MAX
#undef ATT_EXP_PACK
#undef ATT_PV
#undef ATT_SMPV
#undef ATT_EXP_H
#undef ATT_VRD
#undef ATT_LOAD
#undef ATT_STORE
    const float m = mhat;
    l = xhalf_sum(l);
    if constexpr (SWA) {
        l += __builtin_amdgcn_exp2f(sink_l2 - m);
        const float inv = 1.f / l;
#pragma unroll
        for (int db = 0; db < NDB; ++db)
#pragma unroll
            for (int g4 = 0; g4 < 4; ++g4) {
                u32x2 w; w.x = cvtpk(o[db][4 * g4] * inv, o[db][4 * g4 + 1] * inv); w.y = cvtpk(o[db][4 * g4 + 2] * inv, o[db][4 * g4 + 3] * inv);
                *(u32x2*)(Qw + (size_t)r * 2048 + 32 * db + 8 * g4 + 4 * h) = w;
            }
    } else {
        const float inv = 1.f / l;
        LAS float* xb = (LAS float*)lds;
        if (wid >= 4) {
            const float sc = lam * inv;
#pragma unroll
            for (int db = 0; db < NDB; ++db)
#pragma unroll
                for (int i = 0; i < 16; ++i) xb[((wid - 4) * 128 + 32 * db + crow(i, h)) * 32 + r] = o[db][i] * sc;
        }
        __syncthreads();
        if (wid < 4) {
            float ss = 0.f;
#pragma unroll
            for (int db = 0; db < NDB; ++db)
#pragma unroll
                for (int i = 0; i < 16; ++i) { const float v = o[db][i] * inv - xb[(wid * 128 + 32 * db + crow(i, h)) * 32 + r]; o[db][i] = v; ss += v * v; }
            ss = xhalf_sum(ss);
            const float rstd = 0.8f / sqrtf(ss * (1.f / 128.f) + 1e-6f);
#pragma unroll
            for (int db = 0; db < NDB; ++db)
#pragma unroll
                for (int g4 = 0; g4 < 4; ++g4) {
                    const int d = 32 * db + 8 * g4 + 4 * h; const f32x4 gg = *(const f32x4*)(gain + d);
                    u32x2 w; w.x = cvtpk(o[db][4 * g4] * rstd * gg[0], o[db][4 * g4 + 1] * rstd * gg[1]); w.y = cvtpk(o[db][4 * g4 + 2] * rstd * gg[2], o[db][4 * g4 + 3] * rstd * gg[3]);
                    *(u32x2*)(Od + (size_t)r * 2048 + d) = w;
                }
        }
        __syncthreads();
    }
}
constexpr int SW_KP = 144, SW_VP = 192, SW_KT = 64 * SW_KP, SW_VT = 64 * SW_VP, SW_VOFF = 7 * SW_KT, SW_LDS = 7 * (SW_KT + SW_VT);
__device__ __forceinline__ void swa_unit(LAS unsigned char* lds, const int tid, const int wid, const int lane, bf16_t* QOrow  ,
                                         const bf16_t* Kreal, const bf16_t* Kmeta, const bf16_t* Vreal, const bf16_t* Vmeta, const int t0, const int ntr, const int qblk0, const float* sink4) {
    constexpr float THR = 8.f;
    const int r = lane & 31, h = lane >> 5;
    {
        u32x4 kr[7], vr[7];
        const int row = tid >> 3, cc = tid & 7;
#pragma unroll
        for (int j = 0; j < 7; ++j) if (j <= ntr) {
            const bf16_t* ks = (j == 0) ? Kmeta : Kreal + (size_t)(t0 + j - 1) * 64 * 256; const bf16_t* vs = (j == 0) ? Vmeta : Vreal + (size_t)(t0 + j - 1) * 64 * 256;
            kr[j] = *(const u32x4*)(ks + (size_t)row * 256 + cc * 8); vr[j] = *(const u32x4*)(vs + (size_t)row * 256 + cc * 8); }
#pragma unroll
        for (int j = 0; j < 7; ++j) if (j <= ntr) {
            *(LAS u32x4*)(lds + j * SW_KT + row * SW_KP + cc * 16) = kr[j]; *(LAS u32x4*)(lds + SW_VOFF + j * SW_VT + row * SW_VP + cc * 16) = vr[j]; }
    }
    __syncthreads();
    const int koff = r * SW_KP + (8 * h) * 2;
    const int voff = (4 * h + ((lane & 15) >> 2)) * SW_VP + (16 * ((lane >> 4) & 1) + 4 * (lane & 3)) * 2;
    f32x16 zero16;
#pragma unroll
    for (int i = 0; i < 16; ++i) zero16[i] = 0.f;
    const int qrel0 = qblk0 + 32 * (wid & 3);
#pragma unroll 1
    for (int pass = 0; pass < 2; ++pass) {
        const int hd = 2 * pass + (wid >> 2);
        bf16_t* Qw = QOrow + (size_t)(32 * (wid & 3)) * 2048 + hd * 64;
        bf16x8 qf[4];
#pragma unroll
        for (int st = 0; st < 4; ++st) qf[st] = *(const bf16x8*)(Qw + (size_t)r * 2048 + 16 * st + 8 * h);
        const float sink_l2 = sink4[hd] * 1.4426950408889634f;
        f32x16 o[2], s0, s1; bf16x8 pf[4]; float mhat, l = 0.f;
#define SW_QK(j, C0) do { const LAS unsigned char* kb_ = lds + (j) * SW_KT + koff; \
        _Pragma("unroll") for (int st = 0; st < 4; ++st) { \
            const bf16x8 a0_ = *(const LAS bf16x8*)(kb_ + st * 32), a1_ = *(const LAS bf16x8*)(kb_ + 32 * SW_KP + st * 32); \
            if (st == 0) { s0 = MFMA32(a0_, qf[0], C0); s1 = MFMA32(a1_, qf[0], C0); } else { s0 = MFMA32(a0_, qf[st], s0); s1 = MFMA32(a1_, qf[st], s1); } } } while (0)
#define SW_MAX(mx) do { float a_ = fmaxf(fmaxf(s0[0], s0[1]), s1[0]), b_ = fmaxf(fmaxf(s0[2], s0[3]), s1[1]); a_ = fmaxf(fmaxf(a_, s1[2]), s1[3]); \
        _Pragma("unroll") for (int i = 4; i < 16; i += 4) { a_ = fmaxf(fmaxf(a_, s0[i]), s0[i + 1]); b_ = fmaxf(fmaxf(b_, s0[i + 2]), s0[i + 3]); a_ = fmaxf(fmaxf(a_, s1[i]), s1[i + 1]); b_ = fmaxf(fmaxf(b_, s1[i + 2]), s1[i + 3]); } \
        mx = xhalf_max(fmaxf(a_, b_)); } while (0)
#define SW_EXP_H(S, P0_, P1_) do { float ra_ = 0.f, rb_ = 0.f; \
        _Pragma("unroll") for (int i = 0; i < 16; i += 2) { S[i] = __builtin_amdgcn_exp2f(S[i]); S[i + 1] = __builtin_amdgcn_exp2f(S[i + 1]); ra_ += S[i]; rb_ += S[i + 1]; } \
        l += ra_ + rb_; u32x4 w_; \
        w_.x = cvtpk(S[0], S[1]); w_.y = cvtpk(S[2], S[3]); w_.z = cvtpk(S[4], S[5]); w_.w = cvtpk(S[6], S[7]); P0_ = __builtin_bit_cast(bf16x8, w_); \
        w_.x = cvtpk(S[8], S[9]); w_.y = cvtpk(S[10], S[11]); w_.z = cvtpk(S[12], S[13]); w_.w = cvtpk(S[14], S[15]); P1_ = __builtin_bit_cast(bf16x8, w_); } while (0)
#define SW_PV(j, NKS) do { const LAS unsigned char* vb_ = lds + SW_VOFF + (j) * SW_VT + voff; \
        _Pragma("unroll") for (int ks = 0; ks < (NKS); ++ks) \
            _Pragma("unroll") for (int db = 0; db < 2; ++db) { \
                const s16x4 lo_ = vtr(vb_ + (16 * ks) * SW_VP + db * 64), hi_ = vtr(vb_ + (16 * ks + 8) * SW_VP + db * 64); \
                const bf16x8 va_ = __builtin_shufflevector(lo_, hi_, 0, 1, 2, 3, 4, 5, 6, 7); \
                o[db] = MFMA32(va_, pf[ks], o[db]); } } while (0)
        {
            SW_QK(0, zero16);
#pragma unroll
            for (int i = 0; i < 16; ++i) { if (i >= 8) s0[i] = NEGV; s1[i] = NEGV; }
            float mx; SW_MAX(mx);
            mhat = mx;
#pragma unroll
            for (int i = 0; i < 16; ++i) s0[i] -= mx;
            SW_EXP_H(s0, pf[0], pf[1]);
            o[0] = zero16; o[1] = zero16;
            SW_PV(0, 1);
        }
#pragma unroll 1
        for (int j = 1; j <= ntr; ++j) {
            const int k0 = (t0 + j - 1) * 64;
            if ((k0 > qrel0 + 31 + 128) || (k0 + 63 < qrel0 - 128)) continue;
            const bool edge = !((k0 >= qrel0 + 31 - 128) && (k0 + 63 <= qrel0 + 128));
            f32x16 negm_;
#pragma unroll
            for (int i = 0; i < 16; ++i) negm_[i] = -mhat;
            SW_QK(j, negm_);
            if (edge) { const int d0_ = k0 - (qrel0 + r);
#pragma unroll
                for (int i = 0; i < 16; ++i) { const int d_ = d0_ + crow(i, h); if (d_ < -128 || d_ > 128) s0[i] = NEGV; if (d_ + 32 < -128 || d_ + 32 > 128) s1[i] = NEGV; } }
            float mx_; SW_MAX(mx_);
            if (__builtin_expect(__any(mx_ > THR), 0)) { const float dl_ = fmaxf(mx_, 0.f); mhat += dl_;
#pragma unroll
                for (int i = 0; i < 16; ++i) { s0[i] -= dl_; s1[i] -= dl_; }
                const float f_ = __builtin_amdgcn_exp2f(-dl_); l *= f_;
#pragma unroll
                for (int db = 0; db < 2; ++db)
#pragma unroll
                    for (int i = 0; i < 16; ++i) o[db][i] *= f_; }
            SW_EXP_H(s0, pf[0], pf[1]); SW_EXP_H(s1, pf[2], pf[3]);
            SW_PV(j, 4);
        }
#undef SW_QK
#undef SW_MAX
#undef SW_EXP_H
#undef SW_PV
        l = xhalf_sum(l);
        l += __builtin_amdgcn_exp2f(sink_l2 - mhat);
        const float inv = 1.f / l;
#pragma unroll
        for (int db = 0; db < 2; ++db)
#pragma unroll
            for (int g4 = 0; g4 < 4; ++g4) {
                u32x2 w; w.x = cvtpk(o[db][4 * g4] * inv, o[db][4 * g4 + 1] * inv); w.y = cvtpk(o[db][4 * g4 + 2] * inv, o[db][4 * g4 + 3] * inv);
                *(u32x2*)(Qw + (size_t)r * 2048 + 32 * db + 8 * g4 + 4 * h) = w;
            }
    }
    __syncthreads();
}
}

typedef unsigned short bf16;
typedef float f32x4 __attribute__((ext_vector_type(4)));
typedef unsigned u32x4 __attribute__((ext_vector_type(4)));
typedef unsigned u32x2 __attribute__((ext_vector_type(2)));
using pg8::cvtpk; using pg8::bf_lo; using pg8::bf_hi;
constexpr int NTOK = 32768, DM = 1024, NIN = 6656, DFF = 2816, SEQL = 2048;
constexpr float RMS_EPS = 1e-6f;
constexpr int LDS_MAIN = 151552, LDS_BYTES = LDS_MAIN + 256;
static_assert(att::ATT_LDS_MAX <= LDS_MAIN && att::SW_LDS <= LDS_MAIN && pg8::STAGE_BYTES <= LDS_MAIN, "LDS map");

__device__ __forceinline__ float wave_sum(float v) {
#pragma unroll
    for (int o = 1; o < 64; o <<= 1) v += __shfl_xor(v, o);
    return v;
}
template <int MODE> __device__ __forceinline__ int rowmap(int n) {
    if (MODE == 1) {
        const bool perm = (n < 1280) || (n >= 1536 && n < 3584);
        if (!perm) return n;
        const int d = n & 63; return (n & ~63) + ((d < 32) ? 2 * d : 2 * (d - 32) + 1);
    } else if (MODE == 2) {
        if (n < DFF) return 8 * (n >> 2) + (n & 3);
        const int j = n - DFF; return 8 * (j >> 2) + 4 + (j & 3);
    }
    return n;
}
template <int MODE> __device__ __forceinline__ void p0_transpose_item(const float* W, int N, bf16* WT, int ldk, int koff, LAS float* scr, int item, int lane, const float* kscale = nullptr) {
    const int nblk = N / 32, kb = item / nblk, nb = item % nblk, k0 = 64 * kb, n0 = 32 * nb;
#pragma unroll 8
    for (int i = 0; i < 32; ++i) { const int kk = 2 * i + (lane >> 5); scr[kk * 33 + (lane & 31)] = W[(size_t)(k0 + kk) * N + n0 + (lane & 31)]; }
    asm volatile("s_waitcnt lgkmcnt(0)" ::: "memory");
    const int c = lane & 7;
    f32x4 ks0 = {1.f, 1.f, 1.f, 1.f}, ks1 = {1.f, 1.f, 1.f, 1.f};
    if (kscale) { ks0 = *(const f32x4*)(kscale + k0 + 8 * c); ks1 = *(const f32x4*)(kscale + k0 + 8 * c + 4); }
#pragma unroll
    for (int j = 0; j < 4; ++j) { const int n = (lane >> 3) + 8 * j; const LAS float* s = scr + (8 * c) * 33 + n;
        u32x4 o; o.x = cvtpk(s[0 * 33] * ks0[0], s[1 * 33] * ks0[1]); o.y = cvtpk(s[2 * 33] * ks0[2], s[3 * 33] * ks0[3]); o.z = cvtpk(s[4 * 33] * ks1[0], s[5 * 33] * ks1[1]); o.w = cvtpk(s[6 * 33] * ks1[2], s[7 * 33] * ks1[3]);
        *(u32x4*)(WT + (size_t)rowmap<MODE>(n0 + n) * ldk + koff + k0 + 8 * c) = o; }
    asm volatile("s_waitcnt lgkmcnt(0)" ::: "memory");
}

#define XB_TMO      128
#define XB_XCNT(j)  (256  + 64 * (j))
#define XB_XSUB(j)  (1280 + 64 * (j))
#define XB_XGEN(j)  (2304 + 64 * (j))
#define XB_TOP      3328
#define XB_TOPGEN   3392
#define XCD_BAR_WORDS 3456
#define XB_SPIN_CAP (1u << 18)

__device__ __forceinline__ unsigned xb_ld(unsigned* p)              { return __hip_atomic_load(p, __ATOMIC_RELAXED, __HIP_MEMORY_SCOPE_AGENT); }
__device__ __forceinline__ unsigned xb_add(unsigned* p, unsigned v) { return __hip_atomic_fetch_add(p, v, __ATOMIC_RELAXED, __HIP_MEMORY_SCOPE_AGENT); }
__device__ __forceinline__ unsigned xb_xcc_id() { return (unsigned)__builtin_amdgcn_s_getreg((3 << 11) | 20) & 0xFu; }
#define XB_SPIN(cond, bar) do { unsigned _sp = 0; while (cond) { __builtin_amdgcn_s_sleep(1); \
    if ((++_sp & 255u) == 0u) { if (xb_ld(&(bar)[XB_TMO])) break; if (_sp > XB_SPIN_CAP) { atomicAdd(&(bar)[XB_TMO], 1u); break; } } } } while (0)

struct XcdBarrier {
    unsigned* bar; unsigned x;
    volatile LAS unsigned* st;
};

__device__ __forceinline__ XcdBarrier xcd_barrier_post(unsigned* bar, volatile LAS unsigned* st) {
    XcdBarrier b; b.bar = bar; b.x = xb_xcc_id(); b.st = st;
    if (threadIdx.x == 0) (void)xb_add(&bar[XB_XCNT(b.x)], 1u);
    return b;
}
__device__ __forceinline__ void xcd_barrier_complete(unsigned* bar, unsigned x, unsigned& nloc, unsigned& nx) {
    const unsigned G = gridDim.x * gridDim.y * gridDim.z;
    unsigned sum, cnt, mine, sp = 0u;
    for (;;) {
        sum = 0u; cnt = 0u; mine = 0u;
#pragma unroll
        for (unsigned j = 0; j < 16; ++j) { const unsigned c = xb_ld(&bar[XB_XCNT(j)]); sum += c; cnt += (c > 0u) ? 1u : 0u; mine = (j == x) ? c : mine; }
        if (sum == G) break;
        __builtin_amdgcn_s_sleep(1);
        if ((++sp & 255u) == 0u) { if (xb_ld(&bar[XB_TMO])) break; if (sp > XB_SPIN_CAP) { atomicAdd(&bar[XB_TMO], 1u); break; } }
    }
    nloc = mine > 0u ? mine : 1u; nx = cnt > 0u ? cnt : 1u;
}

__device__ __forceinline__ void xcd_barrier(const XcdBarrier& b) {
    asm volatile("s_waitcnt vmcnt(0)" ::: "memory");
    __syncthreads();
    if (threadIdx.x == 0) {
        unsigned* bar = b.bar;
        __builtin_amdgcn_s_waitcnt(0);
        unsigned nloc = b.st[0], nx = b.st[1];
        if (nloc == 0u) { xcd_barrier_complete(bar, b.x, nloc, nx); b.st[0] = nloc; b.st[1] = nx; }
        const unsigned old = xb_add(&bar[XB_XSUB(b.x)], 1u);
        const unsigned gen = old / nloc;
        if (old + 1u == (gen + 1u) * nloc) {
            __builtin_amdgcn_fence(__ATOMIC_RELEASE, "agent");
            asm volatile("s_waitcnt vmcnt(0)" ::: "memory");
            const unsigned og = xb_add(&bar[XB_TOP], 1u);
            const unsigned tg = og / nx;
            if (og + 1u == (tg + 1u) * nx) xb_add(&bar[XB_TOPGEN], 1u);
            else XB_SPIN(xb_ld(&bar[XB_TOPGEN]) == tg, bar);
            __builtin_amdgcn_fence(__ATOMIC_ACQUIRE, "agent");
            xb_add(&bar[XB_XGEN(b.x)], 1u);
            asm volatile("s_waitcnt vmcnt(0)" ::: "memory");
        } else {
            XB_SPIN(xb_ld(&bar[XB_XGEN(b.x)]) == gen, bar);
            __builtin_amdgcn_fence(__ATOMIC_ACQUIRE, "agent");
            asm volatile("s_waitcnt vmcnt(0)" ::: "memory");
        }
    }
    __syncthreads();
}

constexpr size_t WS_BAR = 512 * 1024;
#ifndef WGM_P1
#define WGM_P1 4
#endif
#ifndef WGM_P6
#define WGM_P6 4
#endif
#ifndef WGM_N1K
#define WGM_N1K 8
#endif
#ifndef PH_MASK
#define PH_MASK 0x1ff
#endif
#define PH_ON(k) ((PH_MASK >> (k)) & 1)
#ifndef PROBE_PHASE
#define PROBE_PHASE (-1)
#endif
#define PROBE_T0(k) do { if (PROBE_PHASE == (k) && threadIdx.x == 0) probe_t0 = __builtin_amdgcn_s_memrealtime(); } while (0)
#define PROBE_DELAY(k) do { if (PROBE_PHASE == (k)) { if (threadIdx.x == 0) { const unsigned long long t1_ = __builtin_amdgcn_s_memrealtime(), dt_ = t1_ - probe_t0; while (__builtin_amdgcn_s_memrealtime() - t1_ < dt_) __builtin_amdgcn_s_sleep(8); } __syncthreads(); } } while (0)
struct Args { const float* in[19]; float* out; unsigned char* ws; };

__global__ void __launch_bounds__(512, 2) fwd_megakernel(Args a) {
    extern __shared__ __attribute__((aligned(16))) unsigned char lds_raw[];
    cg::grid_group grid = cg::this_grid();
    LAS unsigned char* lds = (LAS unsigned char*)lds_raw;
    const int tid = threadIdx.x, lane = tid & 63, wid = __builtin_amdgcn_readfirstlane(tid >> 6);
    const int G = gridDim.x, bx = blockIdx.x;
    const int vcu = (G % 8 == 0) ? (bx % 8) * (G / 8) + bx / 8 : bx;
    const int gw = bx * 8 + wid, NGW = G * 8;
    unsigned char* ws = a.ws;
    unsigned long long probe_t0 = 0; (void)probe_t0;
    volatile LAS unsigned* xb_st = (volatile LAS unsigned*)(lds + LDS_MAIN);
    if (threadIdx.x < 2) xb_st[threadIdx.x] = 0u;
    __syncthreads();
    const XcdBarrier xbar = xcd_barrier_post((unsigned*)(ws + WS_BAR), xb_st);
#define p_x (a.in[0])
#define p_meta_tokens (a.in[1])
#define p_pre_mix_gain (a.in[2])
#define p_w_in (a.in[3])
#define p_b_gate (a.in[4])
#define p_attn_sink (a.in[5])
#define p_lq1 (a.in[6])
#define p_lk1 (a.in[7])
#define p_lq2 (a.in[8])
#define p_lk2 (a.in[9])
#define p_subln_gain (a.in[10])
#define p_w_bswa (a.in[11])
#define p_w_bdiff (a.in[12])
#define p_w_out (a.in[13])
#define p_post_mix_gain (a.in[14])
#define p_pre_ffn_gain (a.in[15])
#define p_w_ffn_in (a.in[16])
#define p_w_ffn_out (a.in[17])
#define p_post_ffn_gain (a.in[18])
#define p_ss1 ((float*)(ws + WS_SS1))
#define p_ss3 ((float*)(ws + WS_SS3))
#define p_rope ((float*)(ws + WS_ROPE))
#define p_KAm ((bf16*)(ws + WS_KAM))
#define p_VAm ((bf16*)(ws + WS_VAM))
#define p_KBm ((bf16*)(ws + WS_KBM))
#define p_VBm ((bf16*)(ws + WS_VBM))
#define p_Win_t ((bf16*)(ws + WS_WIN))
#define p_Wcat_t ((bf16*)(ws + WS_WCAT))
#define p_Wout_t ((bf16*)(ws + WS_WOUT))
#define p_Wffi_t ((bf16*)(ws + WS_WFFI))
#define p_Wffo_t ((bf16*)(ws + WS_WFFO))
#define p_U ((bf16*)(ws + WS_U))
#define p_QO ((bf16*)(ws + WS_QO))
#define p_KA ((bf16*)(ws + WS_KA))
#define p_VA ((bf16*)(ws + WS_VA))
#define p_KB ((bf16*)(ws + WS_KB))
#define p_VB ((bf16*)(ws + WS_VB))
#define p_MERGED ((bf16*)(ws + WS_MERGED))
#define p_Y ((bf16*)(ws + WS_Y))
#define p_F ((bf16*)(ws + WS_F))
#define p_FO ((bf16*)(ws + WS_FO))
#define p_H1 ((bf16*)(ws + WS_H1))
#define p_GATES ((bf16*)a.out)
#define p_out (a.out)

#if PH_ON(0)
    PROBE_T0(0);
    {
        int tid_o = threadIdx.x; asm volatile("" : "+v"(tid_o));
        const int tid = tid_o, lane = tid & 63, wid = __builtin_amdgcn_readfirstlane(tid >> 6), gw = bx * 8 + wid; (void)tid; (void)gw;
        for (int e = bx * 512 + tid; e < 65536; e += G * 512) p_ss1[e] = 0.f;
        for (int e = bx * 512 + tid; e < 2064 * 32; e += G * 512) {
            const int pos = e >> 5, i = e & 31; const float inv = powf(10000.f, -(float)i * (1.f / 32.f)); const float ang = (float)pos * inv;
            p_rope[2 * e] = cosf(ang); p_rope[2 * e + 1] = sinf(ang);
        }
        for (int base = gw; base < NTOK; base += 4 * NGW) {
            f32x4 v[4][4]; float sq[4];
#pragma unroll
            for (int q = 0; q < 4; ++q) { const int mrow = (base + q * NGW < NTOK) ? base + q * NGW : NTOK - 1; const f32x4* xr = (const f32x4*)(p_x + (size_t)mrow * DM) + lane;
#pragma unroll
                for (int j = 0; j < 4; ++j) v[q][j] = xr[64 * j]; }
#pragma unroll
            for (int q = 0; q < 4; ++q) { float s = 0.f;
#pragma unroll
                for (int j = 0; j < 4; ++j) s += (v[q][j][0] * v[q][j][0] + v[q][j][1] * v[q][j][1]) + (v[q][j][2] * v[q][j][2] + v[q][j][3] * v[q][j][3]);
                sq[q] = 1.f / sqrtf(wave_sum(s) * (1.f / DM) + RMS_EPS); }
#pragma unroll
            for (int q = 0; q < 4; ++q) { if (base + q * NGW < NTOK) { u32x2* o8 = (u32x2*)(p_U + (size_t)(base + q * NGW) * DM) + lane; if (lane == 0) ((float*)(ws + WS_RSX))[base + q * NGW] = sq[q];
#pragma unroll
                for (int j = 0; j < 4; ++j) { const float rstd = sq[q]; u32x2 w; w.x = cvtpk(v[q][j][0] * rstd, v[q][j][1] * rstd); w.y = cvtpk(v[q][j][2] * rstd, v[q][j][3] * rstd); o8[64 * j] = w; } } }
        }
        if (bx < 40) {
            const int item = bx;
            LAS float* um = (LAS float*)lds; LAS float* red = (LAS float*)(lds + 65536);
#pragma unroll
            for (int rr = 0; rr < 2; ++rr) {
                const int row = 2 * wid + rr; const float* xr = p_meta_tokens + row * DM; float v[16]; float s = 0.f;
#pragma unroll
                for (int j = 0; j < 16; ++j) { v[j] = xr[lane + 64 * j]; s += v[j] * v[j]; }
                s = wave_sum(s); const float rstd = 1.f / sqrtf(s * (1.f / DM) + RMS_EPS);
#pragma unroll
                for (int j = 0; j < 16; ++j) um[row * DM + lane + 64 * j] = v[j] * rstd * p_pre_mix_gain[lane + 64 * j];
            }
            __syncthreads();
            int c0, ldd, dcol; bf16* dst; bool dorope;
            if (item < 4)       { c0 = 1024 + 64 * item;        dst = p_KAm; ldd = 256;  dcol = 64 * item;        dorope = true; }
            else if (item < 8)  { c0 = 1280 + 64 * (item - 4);  dst = p_VAm; ldd = 256;  dcol = 64 * (item - 4);  dorope = false; }
            else if (item < 24) { c0 = 2560 + 64 * (item - 8);  dst = p_KBm; ldd = 1024; dcol = 64 * (item - 8);  dorope = true; }
            else                { c0 = 3584 + 64 * (item - 24); dst = p_VBm; ldd = 1024; dcol = 64 * (item - 24); dorope = false; }
#define FMAC(c_, a_, b_) asm("v_fmac_f32_e32 %0, %1, %2" : "+v"(c_) : "v"(a_), "v"(b_))
            float acc[16];
#pragma unroll
            for (int rI = 0; rI < 16; ++rI) acc[rI] = 0.f;
            const float* wp = p_w_in + (size_t)(128 * wid) * NIN + c0 + lane;
#pragma unroll 1
            for (int kc = 0; kc < 4; ++kc) {
                float wv[32];
#pragma unroll
                for (int e = 0; e < 32; ++e) wv[e] = wp[(size_t)(32 * kc + e) * NIN];
#pragma unroll
                for (int k4 = 0; k4 < 8; ++k4) {
                    asm volatile("" ::: "memory");
#pragma unroll
                    for (int rI = 0; rI < 16; ++rI) { const f32x4 uu = *(const LAS f32x4*)(um + rI * DM + 128 * wid + 32 * kc + 4 * k4); FMAC(acc[rI], uu[0], wv[4 * k4]); FMAC(acc[rI], uu[1], wv[4 * k4 + 1]); FMAC(acc[rI], uu[2], wv[4 * k4 + 2]); FMAC(acc[rI], uu[3], wv[4 * k4 + 3]); }
                }
            }
#pragma unroll
            for (int rI = 0; rI < 16; ++rI) red[(wid * 16 + rI) * 64 + lane] = acc[rI];
            __syncthreads();
            {
                const int rI = tid >> 5, i = tid & 31; float x1 = 0.f, x2 = 0.f;
#pragma unroll
                for (int w = 0; w < 8; ++w) { x1 += red[(w * 16 + rI) * 64 + i]; x2 += red[(w * 16 + rI) * 64 + i + 32]; }
                if (dorope) {
                    const float inv = powf(10000.f, -(float)i * (1.f / 32.f)); const float ang = (float)rI * inv; const float c = cosf(ang), s = sinf(ang);
                    *(unsigned*)(dst + rI * ldd + dcol + 2 * i) = cvtpk(x1 * c - x2 * s, x2 * c + x1 * s);
                } else {
                    dst[rI * ldd + dcol + i] = (bf16)(cvtpk(x1, 0.f) & 0xffffu); dst[rI * ldd + dcol + i + 32] = (bf16)(cvtpk(x2, 0.f) & 0xffffu);
                }
                for (int e = tid; e < 1536; e += 512) { const int rr = 16 + e / 32, cc = (e % 32) * 2; *(unsigned*)(dst + rr * ldd + dcol + cc) = 0u; }
            }
            __syncthreads();
        }
        {
            LAS float* scr = (LAS float*)(lds + wid * 16384);
            constexpr int I_IN = 16 * (NIN / 32), I_SQ = 16 * 32, I_FI = 16 * (2 * DFF / 32), I_FO = (DFF / 64) * 32;
            constexpr int NITEMS = I_IN + 3 * I_SQ + I_FI + I_FO;
            const bool skipw = (G > 80) && (bx < 40);
            const int wfirst = (G > 80) ? (bx - 40) * 8 + wid : gw, wstride = (G > 80) ? (G - 40) * 8 : NGW;
            if (!skipw) for (int it = wfirst; it < NITEMS; it += wstride) {
                int q = it;
                if (q < I_IN) { p0_transpose_item<1>(p_w_in, NIN, p_Win_t, DM, 0, scr, q, lane, p_pre_mix_gain); continue; } q -= I_IN;
                if (q < I_SQ) { p0_transpose_item<0>(p_w_bswa, DM, p_Wcat_t, 2048, 0, scr, q, lane); continue; } q -= I_SQ;
                if (q < I_SQ) { p0_transpose_item<0>(p_w_bdiff, DM, p_Wcat_t, 2048, 1024, scr, q, lane); continue; } q -= I_SQ;
                if (q < I_SQ) { p0_transpose_item<0>(p_w_out, DM, p_Wout_t, DM, 0, scr, q, lane); continue; } q -= I_SQ;
                if (q < I_FI) { p0_transpose_item<2>(p_w_ffn_in, 2 * DFF, p_Wffi_t, DM, 0, scr, q, lane, p_pre_ffn_gain); continue; } q -= I_FI;
                p0_transpose_item<0>(p_w_ffn_out, DM, p_Wffo_t, DFF, 0, scr, q, lane);
            }
        }
    }
    if (a.ws == nullptr) grid.sync();
    xcd_barrier(xbar);
    PROBE_DELAY(0);

#endif
#if PH_ON(1)
    PROBE_T0(1);
    {
        pg8::Gemm g{p_U, p_Win_t, NTOK, NIN, DM}; pg8::StaticOrder S; S.init(NTOK, NIN, G, bx, WGM_P1);
        pg8::EpiInProj E{ws, p_GATES, p_b_gate};
        pg8::gemm_phase<pg8::EpiInProj, pg8::StaticOrder, true, true>(lds, g, S, E);
    }
    xcd_barrier(xbar);
    PROBE_DELAY(1);

#endif
#if PH_ON(2)
    PROBE_T0(2);
    {
        int tid_o = threadIdx.x; asm volatile("" : "+v"(tid_o));
        const int tid = tid_o, lane = tid & 63, wid = __builtin_amdgcn_readfirstlane(tid >> 6);
        unsigned long long att_acc = 0, att_dummy = 0;
        float lam;
        { float p1 = p_lq1[lane] * p_lk1[lane], p2 = p_lq2[lane] * p_lk2[lane]; p1 = wave_sum(p1); p2 = wave_sum(p2); lam = expf(p1) - expf(p2) + 0.2f; }
        for (int uidx = vcu; uidx < 2048; uidx += G) {
            const int i = uidx & 15, hh = (uidx >> 4) & 7, b = uidx >> 7;
            const size_t qrow = (size_t)b * SEQL + i * 128 + 32 * (wid & 3);
            att::attn_unit<128, 128, false>(lds, tid, wid, lane, p_QO + qrow * 2048 + 1024 + hh * 128 + 64 * (wid >> 2),
                                            p_KB + (size_t)b * SEQL * 1024 + hh * 128, p_KBm + hh * 128, 1024, p_VB + (size_t)b * SEQL * 1024 + hh * 128, p_VBm + hh * 128, 1024,
                                            0, 32, 0, 0.f, lam, p_subln_gain, p_QO + qrow * 2048 + 1024 + hh * 128, att_acc);
        }
#if ATT_PROBE == 9
        const unsigned long long swa_t0 = __builtin_amdgcn_s_memrealtime();
#endif
        for (int uidx = vcu; uidx < 1024; uidx += G) {
            const int i = uidx & 15, gk = (uidx >> 4) & 3, b = uidx >> 6;
            const int t0 = (i >= 1) ? 2 * (i - 1) : 0, t1 = (2 * (i + 2) < 32) ? 2 * (i + 2) : 32;
            att::swa_unit(lds, tid, wid, lane, p_QO + ((size_t)b * SEQL + i * 128) * 2048 + gk * 256,
                          p_KA + (size_t)b * SEQL * 256 + gk * 64, p_KAm + gk * 64, p_VA + (size_t)b * SEQL * 256 + gk * 64, p_VAm + gk * 64, t0, t1 - t0, i * 128, p_attn_sink + gk * 4);
        }
#if ATT_PROBE == 9
        att_acc = __builtin_amdgcn_s_memrealtime() - swa_t0;
#endif
#if ATT_PROBE
        if (wid == 0) { const unsigned long long t1_ = __builtin_amdgcn_s_memrealtime(); while (__builtin_amdgcn_s_memrealtime() - t1_ < att_acc) __builtin_amdgcn_s_sleep(8); }
        __syncthreads();
#endif
    }
    xcd_barrier(xbar);
    PROBE_DELAY(2);

#endif
#if PH_ON(3)
    PROBE_T0(3);
    {
        pg8::Gemm g{p_QO, p_Wcat_t, NTOK, DM, 2048}; pg8::StaticOrder S; S.init(NTOK, DM, G, bx, WGM_N1K);
        pg8::EpiMerge E{p_GATES, p_MERGED};
        pg8::gemm_phase<pg8::EpiMerge, pg8::StaticOrder, true, true>(lds, g, S, E);
    }
    xcd_barrier(xbar);
    PROBE_DELAY(3);

#endif
#if PH_ON(4)
    PROBE_T0(4);
    {
        pg8::Gemm g{p_MERGED, p_Wout_t, NTOK, DM, DM}; pg8::StaticOrder S; S.init(NTOK, DM, G, bx, WGM_N1K);
        pg8::EpiYSS E{p_Y, p_ss1};
        pg8::gemm_phase<pg8::EpiYSS, pg8::StaticOrder, true, true>(lds, g, S, E);
    }
    xcd_barrier(xbar);
    PROBE_DELAY(4);

#endif
#if PH_ON(5)
    PROBE_T0(5);
    {
        int tid_o = threadIdx.x; asm volatile("" : "+v"(tid_o));
        const int tid = tid_o, lane = tid & 63, wid = __builtin_amdgcn_readfirstlane(tid >> 6), gw = bx * 8 + wid; (void)tid; (void)gw;
    for (int base = gw; base < NTOK; base += 4 * NGW) {
        f32x4 hv[4][4]; u32x2 yw[4][4]; u32x2 xw[4][4]; float r1[4], rx[4];
#pragma unroll
        for (int q = 0; q < 4; ++q) { const int mrow = (base + q * NGW < NTOK) ? base + q * NGW : NTOK - 1;
            const u32x2* xr = (const u32x2*)(p_U + (size_t)mrow * DM) + lane; const u32x2* yr = (const u32x2*)(p_Y + (size_t)mrow * DM) + lane;
            r1[q] = p_ss1[mrow]; rx[q] = ((const float*)(ws + WS_RSX))[mrow];
#pragma unroll
            for (int j = 0; j < 4; ++j) { xw[q][j] = xr[64 * j]; yw[q][j] = yr[64 * j]; } }
#pragma unroll
        for (int q = 0; q < 4; ++q) {
            const float rstd1 = 1.f / sqrtf(r1[q] * (1.f / DM) + RMS_EPS), xs = 1.f / rx[q]; float s2 = 0.f;
#pragma unroll
            for (int j = 0; j < 4; ++j) { const f32x4 g = *((const f32x4*)p_post_mix_gain + lane + 64 * j); f32x4 t; t[0] = bf_lo(xw[q][j].x) * xs; t[1] = bf_hi(xw[q][j].x) * xs; t[2] = bf_lo(xw[q][j].y) * xs; t[3] = bf_hi(xw[q][j].y) * xs;
                t[0] += bf_lo(yw[q][j].x) * rstd1 * g[0]; t[1] += bf_hi(yw[q][j].x) * rstd1 * g[1]; t[2] += bf_lo(yw[q][j].y) * rstd1 * g[2]; t[3] += bf_hi(yw[q][j].y) * rstd1 * g[3];
                hv[q][j] = t; s2 += (t[0] * t[0] + t[1] * t[1]) + (t[2] * t[2] + t[3] * t[3]); }
            r1[q] = 1.f / sqrtf(wave_sum(s2) * (1.f / DM) + RMS_EPS);
        }
#pragma unroll
        for (int q = 0; q < 4; ++q) { if (base + q * NGW < NTOK) { const int mrow = base + q * NGW; const float rstd2 = r1[q];
            u32x2* hrow = (u32x2*)(p_H1 + (size_t)mrow * DM) + lane; if (lane == 0) ((float*)(ws + WS_RS2))[mrow] = rstd2;
#pragma unroll
            for (int j = 0; j < 4; ++j) { u32x2 hw; hw.x = cvtpk(hv[q][j][0] * rstd2, hv[q][j][1] * rstd2); hw.y = cvtpk(hv[q][j][2] * rstd2, hv[q][j][3] * rstd2); hrow[64 * j] = hw; } } }
    }
    }
    xcd_barrier(xbar);
    PROBE_DELAY(5);

#endif
#if PH_ON(6)
    PROBE_T0(6);
    {
        pg8::Gemm g{p_H1, p_Wffi_t, NTOK, 2 * DFF, DM}; pg8::StaticOrder S; S.init(NTOK, 2 * DFF, G, bx, WGM_P6);
        pg8::EpiSwiGLU E{p_F};
        pg8::gemm_phase<pg8::EpiSwiGLU, pg8::StaticOrder, true, true>(lds, g, S, E);
    }
    xcd_barrier(xbar);
    PROBE_DELAY(6);

#endif
#if PH_ON(7)
    PROBE_T0(7);
    {
        pg8::Gemm g{p_F, p_Wffo_t, NTOK, DM, DFF}; pg8::StaticOrder S; S.init(NTOK, DM, G, bx, WGM_N1K);
        pg8::EpiYSS E{p_FO, p_ss3};
        pg8::gemm_phase<pg8::EpiYSS, pg8::StaticOrder, true, true>(lds, g, S, E);
    }
    xcd_barrier(xbar);
    PROBE_DELAY(7);

#endif
#if PH_ON(8)
    PROBE_T0(8);
    {
        int tid_o = threadIdx.x; asm volatile("" : "+v"(tid_o));
        const int tid = tid_o, lane = tid & 63, wid = __builtin_amdgcn_readfirstlane(tid >> 6), gw = bx * 8 + wid; (void)tid; (void)gw;
    for (int base = gw; base < NTOK; base += 4 * NGW) {
        u32x2 hw[4][4]; u32x2 fw[4][4]; float r3[4], r2[4];
#pragma unroll
        for (int q = 0; q < 4; ++q) { const int mrow = (base + q * NGW < NTOK) ? base + q * NGW : NTOK - 1;
            const u32x2* hr = (const u32x2*)(p_H1 + (size_t)mrow * DM) + lane; const u32x2* fr_ = (const u32x2*)(p_FO + (size_t)mrow * DM) + lane;
            r3[q] = p_ss3[mrow]; r2[q] = ((const float*)(ws + WS_RS2))[mrow];
#pragma unroll
            for (int j = 0; j < 4; ++j) { hw[q][j] = hr[64 * j]; fw[q][j] = fr_[64 * j]; } }
#pragma unroll
        for (int q = 0; q < 4; ++q) { if (base + q * NGW < NTOK) { const int mrow = base + q * NGW; const float rstd3 = 1.f / sqrtf(r3[q] * (1.f / DM) + RMS_EPS);
            f32x4* orow = (f32x4*)(p_out + (size_t)mrow * DM) + lane;
#pragma unroll
            for (int j = 0; j < 4; ++j) { const f32x4 g = *((const f32x4*)p_post_ffn_gain + lane + 64 * j); const float hs = 1.f / r2[q]; f32x4 o; o[0] = bf_lo(hw[q][j].x) * hs; o[1] = bf_hi(hw[q][j].x) * hs; o[2] = bf_lo(hw[q][j].y) * hs; o[3] = bf_hi(hw[q][j].y) * hs;
                o[0] += bf_lo(fw[q][j].x) * rstd3 * g[0]; o[1] += bf_hi(fw[q][j].x) * rstd3 * g[1]; o[2] += bf_lo(fw[q][j].y) * rstd3 * g[2]; o[3] += bf_hi(fw[q][j].y) * rstd3 * g[3];
                orow[64 * j] = o; } } }
    }
    }
#if PROBE_PHASE == 9
    for (int i9 = 0; i9 < 10; ++i9) grid.sync();
#endif
#if PROBE_PHASE == 8
    xcd_barrier(xbar);
    PROBE_DELAY(8);
#endif
#endif
}


extern "C" void kernel_launch(void* const* d_in, const int* in_sizes, int n_in, void* d_out, int out_size, void* d_ws, size_t ws_size, hipStream_t stream) {
    static int grid_blocks = 0;
    if (grid_blocks == 0) {
        if (n_in != 19 || out_size != NTOK * DM || ws_size < WS_END) { fprintf(stderr, "kernel_launch: unexpected shapes (n_in %d, out %d, ws %zu)\n", n_in, out_size, ws_size); grid_blocks = -1; return; }
        int dev = 0, cus = 0, per_cu = 0;
        hipGetDevice(&dev);
        hipDeviceGetAttribute(&cus, hipDeviceAttributeMultiprocessorCount, dev);
        hipFuncSetAttribute((const void*)fwd_megakernel, hipFuncAttributeMaxDynamicSharedMemorySize, LDS_BYTES);
        hipOccupancyMaxActiveBlocksPerMultiprocessor(&per_cu, (const void*)fwd_megakernel, 512, LDS_BYTES);
        if (per_cu < 1) { fprintf(stderr, "kernel_launch: occupancy query says %d blocks per CU\n", per_cu); per_cu = 1; }
        if (per_cu > 1) per_cu = 1;
        grid_blocks = cus * per_cu;
    }
    if (grid_blocks < 0) return;
    if (hipMemsetAsync((unsigned char*)d_ws + WS_BAR, 0, XCD_BAR_WORDS * 4, stream) != hipSuccess) { fprintf(stderr, "kernel_launch: memset of the barrier words failed\n"); return; }
    Args a{};
    for (int i = 0; i < 19; ++i) a.in[i] = (const float*)d_in[i];
    a.out = (float*)d_out; a.ws = (unsigned char*)d_ws;
    void* args[] = {&a};
    hipError_t e = hipLaunchCooperativeKernel((const void*)fwd_megakernel, dim3(grid_blocks), dim3(512), args, LDS_BYTES, stream);
    if (e != hipSuccess) fprintf(stderr, "cooperative launch failed: %s (grid %d)\n", hipGetErrorString(e), grid_blocks);
}
```

```cpp
#include <hip/hip_runtime.h>
#include <hip/hip_cooperative_groups.h>
#include <cstdio>
#include <cstdint>
namespace cg = cooperative_groups;

constexpr size_t MiB = 1u << 20;
constexpr size_t WS_RSX = 256 * 1024, WS_RS2 = 384 * 1024;
constexpr size_t WS_SS1 = 0, WS_SS3 = 128 * 1024, WS_ROPE = 1 * MiB, WS_KAM = 2 * MiB, WS_VAM = WS_KAM + 32 * 1024, WS_KBM = WS_KAM + 64 * 1024, WS_VBM = WS_KAM + 192 * 1024;
constexpr size_t WS_WIN = 4 * MiB, WS_WCAT = 17 * MiB, WS_WOUT = 21 * MiB, WS_WFFI = 23 * MiB, WS_WFFO = 34 * MiB;
constexpr size_t WS_U = 48 * MiB, WS_QO = 112 * MiB, WS_KA = 240 * MiB, WS_VA = 256 * MiB, WS_KB = 272 * MiB, WS_VB = 336 * MiB, WS_MERGED = 400 * MiB;
constexpr size_t WS_Y = 272 * MiB, WS_F = 112 * MiB, WS_FO = 48 * MiB  , WS_H1 = 400 * MiB  , WS_END = 464 * MiB;

namespace pg8 {
#define PG8_LAS __attribute__((address_space(3)))
typedef unsigned short bf16_t;
typedef short bf16x8 __attribute__((ext_vector_type(8)));
typedef float f32x4 __attribute__((ext_vector_type(4)));
typedef unsigned u32x4 __attribute__((ext_vector_type(4)));
constexpr int BM = 256, BK = 64, HALF = 128, HTB = HALF * BK * 2  , STAGE_BYTES = 8 * HTB, NXCD = 8, WGM = 4;

__host__ __device__ __forceinline__ int lds_byte(int r, int c) { const int st = (r >> 4) * 2 + (c >> 5), rr = r & 15, cc = c & 31, ob = rr * 64 + cc * 2; return st * 1024 + (ob ^ (((ob >> 9) & 1) << 5)); }
__host__ __device__ __forceinline__ void stage_rc(int b, int& R, int& C) { const int st = b / 1024, sb = b % 1024, swz = sb ^ (((sb >> 9) & 1) << 5); R = (st >> 1) * 16 + swz / 64; C = (st & 1) * 32 + (swz % 64) / 2; }
__host__ __device__ __forceinline__ int perm32(int rho) { const int n = rho >> 4, i = rho & 15; return 8 * (i >> 2) + 4 * n + (i & 3); }

struct Unit { int pm, pn; };
struct Gemm { const bf16_t* A; const bf16_t* Bt; int M, N, K; };

struct StaticOrder {
    int nM, nN, nwg, G, c, wgm;
    __host__ __device__ void init(int M, int N, int G_, int c_, int wgm_ = WGM) { nM = M / BM; nN = N / BM; nwg = nM * nN; G = G_; c = c_; wgm = wgm_; }
    __host__ __device__ bool next(int i, Unit& u) const {
        const long L = (long)i * G + c; if (L >= nwg) return false;
        int wgid = (int)L; { const int q = nwg / NXCD, r = nwg % NXCD, xcd = wgid % NXCD, off = wgid / NXCD; wgid = (xcd < r ? xcd * (q + 1) : r * (q + 1) + (xcd - r) * q) + off; }
        const int nig = wgm * nN, gid = wgid / nig, fm = gid * wgm, gsz = (nM - fm) < wgm ? (nM - fm) : wgm;
        u.pm = fm + ((wgid % nig) % gsz); u.pn = (wgid % nig) / gsz; return true;
    }
    __device__ __forceinline__ void a_ready(const Unit&) const {}
    __device__ __forceinline__ void done(const Unit&) const {}
};


typedef float f32x2_t __attribute__((ext_vector_type(2))); typedef __bf16 bf16x2_t __attribute__((ext_vector_type(2)));
__device__ __forceinline__ unsigned cvtpk(float lo, float hi) { f32x2_t v = {lo, hi}; bf16x2_t b = __builtin_convertvector(v, bf16x2_t); return __builtin_bit_cast(unsigned, b); }
__device__ __forceinline__ float bf_lo(unsigned w) { return __uint_as_float(w << 16); }
__device__ __forceinline__ float bf_hi(unsigned w) { return __uint_as_float(w & 0xffff0000u); }
constexpr float QK_C2 = 0.125f * 1.4426950408889634f;

struct EpiInProj {
    static constexpr bool PERM = true, AFTER_DRAIN = false, HAS_MID = false;
    unsigned char* ws; bf16_t* G; const float* bgate;
    __device__ __forceinline__ void mid(f32x4 (&)[2][2][4][2], const Unit&, int, int, int, int) const {}
    __device__ __forceinline__ void operator()(const f32x4 (&acc)[2][2][4][2], const Unit& u, int wr, int wc, int fr, int fq) const {
        const int pn = u.pn, row0 = u.pm * BM + wr * 64 + fr, cl = wc * 32 + 8 * fq;
        bf16_t* dst; int ldc, cb, mode; float sc0 = 1.f;
        const float* rope = (const float*)(ws + WS_ROPE);
        if (pn < 4)       { dst = (bf16_t*)(ws + WS_QO);        ldc = 2048; cb = pn * 256;        mode = 1; sc0 = QK_C2; }
        else if (pn == 4) { dst = (bf16_t*)(ws + WS_KA);        ldc = 256;  cb = 0;               mode = 1; }
        else if (pn == 5) { dst = (bf16_t*)(ws + WS_VA);        ldc = 256;  cb = 0;               mode = 0; }
        else if (pn < 10) { dst = (bf16_t*)(ws + WS_QO) + 1024; ldc = 2048; cb = (pn - 6) * 256;  mode = 1; sc0 = QK_C2; }
        else if (pn < 14) { dst = (bf16_t*)(ws + WS_KB);        ldc = 1024; cb = (pn - 10) * 256; mode = 1; }
        else if (pn < 18) { dst = (bf16_t*)(ws + WS_VB);        ldc = 1024; cb = (pn - 14) * 256; mode = 0; }
        else              { dst = G;                            ldc = 2048; cb = (pn - 18) * 256; mode = 2; }
        if (mode == 1) {
            const int i0 = 16 * (wc & 1) + 4 * fq;
#pragma unroll
            for (int ai = 0; ai < 2; ++ai)
#pragma unroll
                for (int m = 0; m < 4; ++m) {
                    const int row = row0 + ai * HALF + m * 16, pos = 16 + (row & 2047);
                    const f32x4 c0 = *(const f32x4*)(rope + (size_t)(pos * 32 + i0) * 2), c1 = *(const f32x4*)(rope + (size_t)(pos * 32 + i0 + 2) * 2);
                    const float sc = sc0;
#pragma unroll
                    for (int bj = 0; bj < 2; ++bj) {
                        const f32x4 v0 = acc[ai][bj][m][0], v1 = acc[ai][bj][m][1]; u32x4 w;
                        w.x = cvtpk((v0[0] * c0[0] - v0[1] * c0[1]) * sc, (v0[1] * c0[0] + v0[0] * c0[1]) * sc);
                        w.y = cvtpk((v0[2] * c0[2] - v0[3] * c0[3]) * sc, (v0[3] * c0[2] + v0[2] * c0[3]) * sc);
                        w.z = cvtpk((v1[0] * c1[0] - v1[1] * c1[1]) * sc, (v1[1] * c1[0] + v1[0] * c1[1]) * sc);
                        w.w = cvtpk((v1[2] * c1[2] - v1[3] * c1[3]) * sc, (v1[3] * c1[2] + v1[2] * c1[3]) * sc);
                        *(u32x4*)(dst + (size_t)row * ldc + cb + bj * HALF + cl) = w;
                    }
                }
        } else if (mode == 0) {
#pragma unroll
            for (int ai = 0; ai < 2; ++ai)
#pragma unroll
                for (int m = 0; m < 4; ++m) {
                    const int row = row0 + ai * HALF + m * 16;
#pragma unroll
                    for (int bj = 0; bj < 2; ++bj) {
                        const f32x4 v0 = acc[ai][bj][m][0], v1 = acc[ai][bj][m][1]; u32x4 w;
                        w.x = cvtpk(v0[0], v0[1]); w.y = cvtpk(v0[2], v0[3]); w.z = cvtpk(v1[0], v1[1]); w.w = cvtpk(v1[2], v1[3]);
                        *(u32x4*)(dst + (size_t)row * ldc + cb + bj * HALF + cl) = w;
                    }
                }
        } else {
            f32x4 bv[2][2];
#pragma unroll
            for (int bj = 0; bj < 2; ++bj)
#pragma unroll
                for (int n = 0; n < 2; ++n) bv[bj][n] = *(const f32x4*)(bgate + cb + bj * HALF + cl + 4 * n);
#pragma unroll
            for (int ai = 0; ai < 2; ++ai)
#pragma unroll
                for (int m = 0; m < 4; ++m) {
                    const int row = row0 + ai * HALF + m * 16;
#pragma unroll
                    for (int bj = 0; bj < 2; ++bj) {
                        const f32x4 v0 = acc[ai][bj][m][0] + bv[bj][0], v1 = acc[ai][bj][m][1] + bv[bj][1]; float s[8];
#pragma unroll
                        for (int e = 0; e < 4; ++e) { s[e] = __builtin_amdgcn_rcpf(1.f + __expf(-v0[e])); s[4 + e] = __builtin_amdgcn_rcpf(1.f + __expf(-v1[e])); }
                        u32x4 w; w.x = cvtpk(s[0], s[1]); w.y = cvtpk(s[2], s[3]); w.z = cvtpk(s[4], s[5]); w.w = cvtpk(s[6], s[7]);
                        *(u32x4*)(dst + (size_t)row * ldc + cb + bj * HALF + cl) = w;
                    }
                }
        }
    }
};

struct EpiMerge {
    static constexpr bool PERM = true, AFTER_DRAIN = false, HAS_MID = true;
    const bf16_t* G; bf16_t* out;
    __device__ __forceinline__ void mid(f32x4 (&acc)[2][2][4][2], const Unit& u, int wr, int wc, int fr, int fq) const {
        int row0 = u.pm * BM + wr * 64 + fr, col0 = u.pn * BM + wc * 32 + 8 * fq;
        asm volatile("" : "+v"(row0), "+v"(col0));
#pragma unroll
        for (int ai = 0; ai < 2; ++ai)
#pragma unroll
            for (int m = 0; m < 4; ++m) {
                const bf16_t* gp = G + (size_t)(row0 + ai * HALF + m * 16) * 2048 + col0;
#pragma unroll
                for (int bj = 0; bj < 2; ++bj) {
                    const u32x4 a = *(const u32x4*)(gp + bj * HALF), d = *(const u32x4*)(gp + 1024 + bj * HALF);
                    f32x4 r0, r1;
                    r0[0] = bf_lo(a.x) * __builtin_amdgcn_rcpf(fmaxf(bf_lo(d.x), 1e-20f)); r0[1] = bf_hi(a.x) * __builtin_amdgcn_rcpf(fmaxf(bf_hi(d.x), 1e-20f));
                    r0[2] = bf_lo(a.y) * __builtin_amdgcn_rcpf(fmaxf(bf_lo(d.y), 1e-20f)); r0[3] = bf_hi(a.y) * __builtin_amdgcn_rcpf(fmaxf(bf_hi(d.y), 1e-20f));
                    r1[0] = bf_lo(a.z) * __builtin_amdgcn_rcpf(fmaxf(bf_lo(d.z), 1e-20f)); r1[1] = bf_hi(a.z) * __builtin_amdgcn_rcpf(fmaxf(bf_hi(d.z), 1e-20f));
                    r1[2] = bf_lo(a.w) * __builtin_amdgcn_rcpf(fmaxf(bf_lo(d.w), 1e-20f)); r1[3] = bf_hi(a.w) * __builtin_amdgcn_rcpf(fmaxf(bf_hi(d.w), 1e-20f));
                    acc[ai][bj][m][0] *= r0; acc[ai][bj][m][1] *= r1;
                }
                asm volatile("" ::: "memory");
            }
    }
    __device__ __forceinline__ void operator()(const f32x4 (&acc)[2][2][4][2], const Unit& u, int wr, int wc, int fr, int fq) const {
        const int row0 = u.pm * BM + wr * 64 + fr, col0 = u.pn * BM + wc * 32 + 8 * fq;
#pragma unroll
        for (int ai = 0; ai < 2; ++ai)
#pragma unroll
            for (int m = 0; m < 4; ++m) {
                const int row = row0 + ai * HALF + m * 16; const bf16_t* gp = G + (size_t)row * 2048 + 1024 + col0;
#pragma unroll
                for (int bj = 0; bj < 2; ++bj) {
                    const u32x4 d = *(const u32x4*)(gp + bj * HALF); const f32x4 v0 = acc[ai][bj][m][0], v1 = acc[ai][bj][m][1]; u32x4 w;
                    w.x = cvtpk(v0[0] * fmaxf(bf_lo(d.x), 1e-20f), v0[1] * fmaxf(bf_hi(d.x), 1e-20f)); w.y = cvtpk(v0[2] * fmaxf(bf_lo(d.y), 1e-20f), v0[3] * fmaxf(bf_hi(d.y), 1e-20f));
                    w.z = cvtpk(v1[0] * fmaxf(bf_lo(d.z), 1e-20f), v1[1] * fmaxf(bf_hi(d.z), 1e-20f)); w.w = cvtpk(v1[2] * fmaxf(bf_lo(d.w), 1e-20f), v1[3] * fmaxf(bf_hi(d.w), 1e-20f));
                    *(u32x4*)(out + (size_t)row * 1024 + col0 + bj * HALF) = w;
                }
                asm volatile("" ::: "memory");
            }
    }
};

struct EpiYSS {
    static constexpr bool PERM = true, AFTER_DRAIN = false, HAS_MID = false;
    bf16_t* Y; float* ss;
    __device__ __forceinline__ void mid(f32x4 (&)[2][2][4][2], const Unit&, int, int, int, int) const {}
    __device__ __forceinline__ void operator()(const f32x4 (&acc)[2][2][4][2], const Unit& u, int wr, int wc, int fr, int fq) const {
        const int row0 = u.pm * BM + wr * 64 + fr, col0 = u.pn * BM + wc * 32 + 8 * fq;
#pragma unroll
        for (int ai = 0; ai < 2; ++ai)
#pragma unroll
            for (int m = 0; m < 4; ++m) {
                const int row = row0 + ai * HALF + m * 16; float s = 0.f;
#pragma unroll
                for (int bj = 0; bj < 2; ++bj) {
                    const f32x4 v0 = acc[ai][bj][m][0], v1 = acc[ai][bj][m][1]; u32x4 w;
                    s += (v0[0] * v0[0] + v0[1] * v0[1]) + (v0[2] * v0[2] + v0[3] * v0[3]) + (v1[0] * v1[0] + v1[1] * v1[1]) + (v1[2] * v1[2] + v1[3] * v1[3]);
                    w.x = cvtpk(v0[0], v0[1]); w.y = cvtpk(v0[2], v0[3]); w.z = cvtpk(v1[0], v1[1]); w.w = cvtpk(v1[2], v1[3]);
                    *(u32x4*)(Y + (size_t)row * 1024 + col0 + bj * HALF) = w;
                }
                s += __shfl_xor(s, 16); s += __shfl_xor(s, 32);
                if (fq == 0) atomicAdd(ss + row, s);
            }
    }
};

struct EpiSwiGLU {
    static constexpr bool PERM = true, AFTER_DRAIN = false, HAS_MID = false;
    bf16_t* F;
    __device__ __forceinline__ void mid(f32x4 (&)[2][2][4][2], const Unit&, int, int, int, int) const {}
    __device__ __forceinline__ void operator()(const f32x4 (&acc)[2][2][4][2], const Unit& u, int wr, int wc, int fr, int fq) const {
        const int row0 = u.pm * BM + wr * 64 + fr, col0 = u.pn * 128 + wc * 16 + 4 * fq;
#pragma unroll
        for (int ai = 0; ai < 2; ++ai)
#pragma unroll
            for (int m = 0; m < 4; ++m) {
                const int row = row0 + ai * HALF + m * 16;
#pragma unroll
                for (int bj = 0; bj < 2; ++bj) {
                    const f32x4 g = acc[ai][bj][m][0], up = acc[ai][bj][m][1]; float o[4];
#pragma unroll
                    for (int e = 0; e < 4; ++e) o[e] = g[e] * __builtin_amdgcn_rcpf(1.f + __expf(-g[e])) * up[e];
                    unsigned long long w = (unsigned long long)cvtpk(o[0], o[1]) | ((unsigned long long)cvtpk(o[2], o[3]) << 32);
                    *(unsigned long long*)(F + (size_t)row * 2816 + col0 + bj * 64) = w;
                }
            }
    }
};

template <class Epi, class Sched, bool ALIGN_EPI = false, bool SP2 = false>
__device__ __forceinline__ void gemm_phase(PG8_LAS unsigned char* lds, const Gemm g, const Sched& S, Epi& E) {
    int tid_ = threadIdx.x; asm volatile("" : "+v"(tid_));
    const int tid = tid_, wid = __builtin_amdgcn_readfirstlane(tid >> 6), lane = tid & 63, wr = wid >> 2, wc = wid & 3, fr = lane & 15, fq = lane >> 4;
    const int K = g.K, nt = K / BK;
    unsigned voffA[2], voffB[2];
#pragma unroll
    for (int i = 0; i < 2; ++i) { int R, C; stage_rc(tid * 16 + i * 8192, R, C); const int Rb = Epi::PERM ? ((R & ~31) + perm32(R & 31)) : R;
        voffA[i] = (unsigned)(R * K + C) * 2u; voffB[i] = (unsigned)(Rb * K + C) * 2u; }
    const size_t kstep = (size_t)(BK * 2);
    const size_t hstep = (size_t)HALF * K * 2;
    const size_t tstep = 2 * hstep;
    const unsigned ldsw = (unsigned)wid * 1024u;
    const int aoff = lds_byte(wr * 64 + fr, fq * 8), boff = lds_byte(wc * 32 + fr, fq * 8);
#define PG8_SA(b, h) (((b) * 2 + (h)) * HTB)
#define PG8_SB(b, h) ((4 + (b) * 2 + (h)) * HTB)
#define PG8_STAGE(bufoff, gbase, voff) do { _Pragma("unroll") for (int _i = 0; _i < 2; ++_i) \
        __builtin_amdgcn_global_load_lds((const unsigned*)((const char*)(gbase) + (voff)[_i]), (PG8_LAS unsigned*)(lds + (bufoff) + ldsw + _i * 8192), 16, 0, 0); } while (0)
#define PG8_LDA(dst, b, h) do { _Pragma("unroll") for (int m = 0; m < 4; ++m) _Pragma("unroll") for (int k = 0; k < 2; ++k) dst[m][k] = *(const PG8_LAS bf16x8*)(lds + PG8_SA(b, h) + aoff + m * 2048 + k * 1024); } while (0)
#define PG8_LDB(dst, b, h) do { _Pragma("unroll") for (int n = 0; n < 2; ++n) _Pragma("unroll") for (int k = 0; k < 2; ++k) dst[n][k] = *(const PG8_LAS bf16x8*)(lds + PG8_SB(b, h) + boff + n * 2048 + k * 1024); } while (0)
#define PG8_MMA(ai, bj, At, Bt) do { __builtin_amdgcn_s_setprio(1); _Pragma("unroll") for (int m = 0; m < 4; ++m) _Pragma("unroll") for (int n = 0; n < 2; ++n) _Pragma("unroll") for (int k = 0; k < 2; ++k) \
        acc[ai][bj][m][n] = __builtin_amdgcn_mfma_f32_16x16x32_bf16(Bt[n][k], At[m][k], acc[ai][bj][m][n], 0, 0, 0); __builtin_amdgcn_s_setprio(0); } while (0)
#define PG8_WAIT_V(n) asm volatile("s_waitcnt vmcnt(" #n ")" ::: "memory")
#define PG8_WAIT_L(n) asm volatile("s_waitcnt lgkmcnt(" #n ")" ::: "memory")
#define PG8_BAR __builtin_amdgcn_s_barrier()
#define PG8_SCHED __builtin_amdgcn_sched_barrier(0)
    Unit cur, nxt; int ui = 0;
    if (!S.next(0, cur)) return;
    f32x4 acc[2][2][4][2];
#pragma unroll
    for (int a = 0; a < 2; ++a)
#pragma unroll
        for (int b = 0; b < 2; ++b)
#pragma unroll
            for (int m = 0; m < 4; ++m)
#pragma unroll
                for (int n = 0; n < 2; ++n) acc[a][b][m][n] = (f32x4){0.f, 0.f, 0.f, 0.f};
    bf16x8 At[4][2], B0[2][2], B1[2][2];
    const char* cA = (const char*)g.A + (size_t)cur.pm * tstep; const char* cB = (const char*)g.Bt + (size_t)cur.pn * tstep;
    S.a_ready(cur);
    if constexpr (SP2) {
        PG8_STAGE(PG8_SB(0, 0), cB, voffB); PG8_STAGE(PG8_SB(0, 1), cB + hstep, voffB); PG8_STAGE(PG8_SA(0, 0), cA, voffA); PG8_STAGE(PG8_SA(0, 1), cA + hstep, voffA);
        if (wr == 1) PG8_BAR;
        PG8_WAIT_V(2); PG8_BAR;
        PG8_STAGE(PG8_SB(1, 0), cB + kstep, voffB); PG8_STAGE(PG8_SA(1, 0), cA + kstep, voffA); PG8_STAGE(PG8_SB(1, 1), cB + hstep + kstep, voffB);
        PG8_WAIT_V(6); PG8_BAR;
    } else {
        PG8_STAGE(PG8_SB(0, 0), cB, voffB); PG8_STAGE(PG8_SA(0, 0), cA, voffA); PG8_STAGE(PG8_SB(0, 1), cB + hstep, voffB); PG8_STAGE(PG8_SA(0, 1), cA + hstep, voffA);
        if (wr == 1) PG8_BAR;
        PG8_WAIT_V(4); PG8_BAR;
        PG8_STAGE(PG8_SB(1, 0), cB + kstep, voffB); PG8_STAGE(PG8_SA(1, 0), cA + kstep, voffA); PG8_STAGE(PG8_SB(1, 1), cB + hstep + kstep, voffB);
        PG8_WAIT_V(6); PG8_BAR;
    }
    for (;;) {
        const bool has_next = S.next(ui + 1, nxt);
        const char* nA = has_next ? (const char*)g.A + (size_t)nxt.pm * tstep : cA; const char* nB = has_next ? (const char*)g.Bt + (size_t)nxt.pn * tstep : cB;
        for (int t = 0; t < nt; t += 2) {
            if constexpr (Epi::HAS_MID) { if (t == (nt >> 1)) E.mid(acc, cur, wr, wc, fr, fq); }
            const bool last = (t == nt - 2);
            const char* a1 = cA + (size_t)(t + 1) * kstep;
            const char* a2 = last ? nA : cA + (size_t)(t + 2) * kstep; const char* b2 = last ? nB : cB + (size_t)(t + 2) * kstep;
            const char* a3 = a2 + kstep; const char* b3 = b2 + kstep;
            if (last && has_next) S.a_ready(nxt);
            if constexpr (SP2) {
            PG8_LDB(B0, 0, 0); PG8_LDB(B1, 0, 1); PG8_SCHED; PG8_LDA(At, 0, 0); PG8_STAGE(PG8_SA(1, 1), a1 + hstep, voffA);
            PG8_WAIT_V(8); PG8_WAIT_L(0); PG8_BAR; PG8_MMA(0, 0, At, B0); PG8_MMA(0, 1, At, B1); PG8_BAR; PG8_SCHED;
            PG8_LDA(At, 0, 1); PG8_STAGE(PG8_SB(0, 0), b2, voffB); PG8_STAGE(PG8_SB(0, 1), b2 + hstep, voffB); PG8_STAGE(PG8_SA(0, 0), a2, voffA);
            PG8_WAIT_V(8); PG8_WAIT_L(0); PG8_BAR; PG8_MMA(1, 0, At, B0); PG8_MMA(1, 1, At, B1); PG8_BAR; PG8_SCHED;
            PG8_LDB(B0, 1, 0); PG8_LDB(B1, 1, 1); PG8_SCHED; PG8_LDA(At, 1, 0); PG8_STAGE(PG8_SA(0, 1), a2 + hstep, voffA);
            PG8_WAIT_V(8); PG8_WAIT_L(0); PG8_BAR; PG8_MMA(0, 0, At, B0); PG8_MMA(0, 1, At, B1); PG8_BAR; PG8_SCHED;
            PG8_LDA(At, 1, 1); PG8_STAGE(PG8_SB(1, 0), b3, voffB); PG8_STAGE(PG8_SB(1, 1), b3 + hstep, voffB); PG8_STAGE(PG8_SA(1, 0), a3, voffA);
            PG8_WAIT_V(8); PG8_WAIT_L(0); PG8_BAR; PG8_MMA(1, 0, At, B0); PG8_MMA(1, 1, At, B1); PG8_BAR; PG8_SCHED;
            } else {
            PG8_LDB(B0, 0, 0); PG8_SCHED; PG8_LDA(At, 0, 0); PG8_STAGE(PG8_SA(1, 1), a1 + hstep, voffA);
            PG8_WAIT_L(8); PG8_BAR; PG8_WAIT_L(0); PG8_MMA(0, 0, At, B0); PG8_BAR; PG8_SCHED;
            PG8_LDB(B1, 0, 1); PG8_STAGE(PG8_SB(0, 0), b2, voffB);
            PG8_BAR; PG8_WAIT_L(0); PG8_MMA(0, 1, At, B1); PG8_BAR;
            PG8_LDA(At, 0, 1); PG8_STAGE(PG8_SA(0, 0), a2, voffA);
            PG8_BAR; PG8_WAIT_L(0); PG8_MMA(1, 0, At, B0); PG8_BAR; PG8_SCHED;
            PG8_STAGE(PG8_SB(0, 1), b2 + hstep, voffB);
            PG8_WAIT_V(6); PG8_BAR; PG8_MMA(1, 1, At, B1); PG8_BAR;
            PG8_LDB(B0, 1, 0); PG8_SCHED; PG8_LDA(At, 1, 0); PG8_STAGE(PG8_SA(0, 1), a2 + hstep, voffA);
            PG8_WAIT_L(8); PG8_BAR; PG8_WAIT_L(0); PG8_MMA(0, 0, At, B0); PG8_BAR; PG8_SCHED;
            PG8_LDB(B1, 1, 1); PG8_STAGE(PG8_SB(1, 0), b3, voffB);
            PG8_BAR; PG8_WAIT_L(0); PG8_MMA(0, 1, At, B1); PG8_BAR;
            PG8_LDA(At, 1, 1); PG8_STAGE(PG8_SA(1, 0), a3, voffA);
            PG8_BAR; PG8_WAIT_L(0); PG8_MMA(1, 0, At, B0); PG8_BAR; PG8_SCHED;
            PG8_STAGE(PG8_SB(1, 1), b3 + hstep, voffB);
            PG8_WAIT_V(6); PG8_BAR; PG8_MMA(1, 1, At, B1); PG8_BAR;
            }
        }
        if constexpr (ALIGN_EPI) { if (wr == 0) PG8_BAR; }
        if constexpr (!Epi::AFTER_DRAIN) { E(acc, cur, wr, wc, fr, fq); S.done(cur); }
        if (!has_next) break;
#pragma unroll
        for (int a = 0; a < 2; ++a)
#pragma unroll
            for (int b = 0; b < 2; ++b)
#pragma unroll
                for (int m = 0; m < 4; ++m)
#pragma unroll
                    for (int n = 0; n < 2; ++n) acc[a][b][m][n] = (f32x4){0.f, 0.f, 0.f, 0.f};
        cur = nxt; cA = nA; cB = nB; ++ui;
        if constexpr (ALIGN_EPI) { if (wr == 1) PG8_BAR; }
    }
    PG8_WAIT_V(0);
    if constexpr (!ALIGN_EPI) { if (wr == 0) PG8_BAR; }
    PG8_BAR;
    if constexpr (Epi::AFTER_DRAIN) { E.fused(acc, cur, wr, wc, fr, fq, lds, wid, lane); S.done(cur); }
#undef PG8_SA
#undef PG8_SB
#undef PG8_STAGE
#undef PG8_LDA
#undef PG8_LDB
#undef PG8_MMA
#undef PG8_WAIT_V
#undef PG8_WAIT_L
#undef PG8_BAR
#undef PG8_SCHED
}
}

namespace att {
#define LAS __attribute__((address_space(3)))
typedef unsigned short bf16_t;
typedef short bf16x8 __attribute__((ext_vector_type(8)));
typedef short s16x4 __attribute__((ext_vector_type(4)));
typedef short v4i16_t __attribute__((ext_vector_type(4)));
typedef float f32x16 __attribute__((ext_vector_type(16)));
typedef float f32x4 __attribute__((ext_vector_type(4)));
typedef unsigned u32x4 __attribute__((ext_vector_type(4)));
typedef unsigned u32x2 __attribute__((ext_vector_type(2)));
using pg8::cvtpk;
__device__ __forceinline__ s16x4 vtr(const LAS unsigned char* p) { return __builtin_bit_cast(s16x4, __builtin_amdgcn_ds_read_tr16_b64_v4i16((LAS v4i16_t*)p)); }
__device__ __forceinline__ int crow(int i, int h) { return (i & 3) + 8 * (i >> 2) + 4 * h; }
__device__ __forceinline__ float xhalf_max(float v) { auto rr = __builtin_amdgcn_permlane32_swap(__float_as_uint(v), __float_as_uint(v), false, false); return fmaxf(__uint_as_float(rr[0]), __uint_as_float(rr[1])); }
__device__ __forceinline__ float xhalf_sum(float v) { auto rr = __builtin_amdgcn_permlane32_swap(__float_as_uint(v), __float_as_uint(v), false, false); return __uint_as_float(rr[0]) + __uint_as_float(rr[1]); }
#define MFMA32(a, b, c) __builtin_amdgcn_mfma_f32_32x32x16_bf16((a), (b), (c), 0, 0, 0)
constexpr float NEGV = -1e30f;
constexpr int ATT_LDS_MAX = 2 * (64 * 272 + 64 * 320);

#ifndef ATT_PROBE
#define ATT_PROBE 0
#endif
#if ATT_PROBE
#define ATT_TS(k) do { if ((k) == ATT_PROBE - 1) att_t = __builtin_amdgcn_s_memrealtime(); if ((k) == ATT_PROBE) att_acc += __builtin_amdgcn_s_memrealtime() - att_t; } while (0)
#else
#define ATT_TS(k) do {} while (0)
#endif
template <int KW, int DV, bool SWA>
__device__ __forceinline__ void attn_unit(LAS unsigned char* lds, const int tid, const int wid, const int lane,
                                          bf16_t* Qw, const bf16_t* Kreal, const bf16_t* Kmeta, const int kpitch, const bf16_t* Vreal, const bf16_t* Vmeta, const int vpitch,
                                          const int t0, const int t1, const int qrel0, const float sink_l2, const float lam, const float* gain, bf16_t* Od, unsigned long long& att_acc) {
    unsigned long long att_t = 0; (void)att_t;
    constexpr int KP = KW * 2 + 16, VP = (DV == 64) ? 192 : 320, KBUF = 64 * KP, VBUF = 64 * VP;
    constexpr int NKC = KW / 64, NVC = DV / 64, KCPR = KW / 8, VCPR = DV / 8, NDB = DV / 32;
    constexpr float THR = 8.f;
    const int r = lane & 31, h = lane >> 5;
    bf16x8 qf[4];
#pragma unroll
    for (int st = 0; st < 4; ++st) qf[st] = *(const bf16x8*)(Qw + (size_t)r * 2048 + 16 * st + 8 * h);
    u32x4 kreg[1][NKC], vreg[1][NVC];
    const int krow_ = tid / KCPR, kcc_ = tid % KCPR, vrow_ = tid / VCPR, vcc_ = tid % VCPR;
#define ATT_LOAD(S, Ks, Vs) do { \
        _Pragma("unroll") for (int i_ = 0; i_ < NKC; ++i_) kreg[S][i_] = *(const u32x4*)((Ks) + (size_t)(krow_ + i_ * (512 / KCPR)) * kpitch + kcc_ * 8); \
        _Pragma("unroll") for (int i_ = 0; i_ < NVC; ++i_) vreg[S][i_] = *(const u32x4*)((Vs) + (size_t)(vrow_ + i_ * (512 / VCPR)) * vpitch + vcc_ * 8); } while (0)
#define ATT_STORE(S, buf) do { \
        _Pragma("unroll") for (int i_ = 0; i_ < NKC; ++i_) *(LAS u32x4*)(lds + (buf) * KBUF + (krow_ + i_ * (512 / KCPR)) * KP + kcc_ * 16) = kreg[S][i_]; \
        _Pragma("unroll") for (int i_ = 0; i_ < NVC; ++i_) *(LAS u32x4*)(lds + 2 * KBUF + (buf) * VBUF + (vrow_ + i_ * (512 / VCPR)) * VP + vcc_ * 16) = vreg[S][i_]; } while (0)
    const int nt = 1 + (t1 - t0);
    ATT_LOAD(0, Kmeta, Vmeta);
    ATT_STORE(0, 0);
    ATT_LOAD(0, Kreal + (size_t)t0 * 64 * kpitch, Vreal + (size_t)t0 * 64 * vpitch);
    __syncthreads();
    const int kcolw = SWA ? 0 : 64 * (wid >> 2);
    const int koff = r * KP + (kcolw + 8 * h) * 2;
    const int voff = (4 * h + ((lane & 15) >> 2)) * VP + (16 * ((lane >> 4) & 1) + 4 * (lane & 3)) * 2;
    f32x16 o[NDB];
    float mhat, l;
    f32x16 s0, s1;
    bf16x8 pf[4];
#define ATT_QK(buf, C0) do { const LAS unsigned char* kb_ = lds + (buf) * KBUF + koff; \
        __builtin_amdgcn_s_setprio(1); \
        _Pragma("unroll") for (int st = 0; st < 4; ++st) { \
            const bf16x8 a0_ = *(const LAS bf16x8*)(kb_ + st * 32), a1_ = *(const LAS bf16x8*)(kb_ + 32 * KP + st * 32); \
            if (st == 0) { s0 = MFMA32(a0_, qf[0], C0); s1 = MFMA32(a1_, qf[0], C0); } else { s0 = MFMA32(a0_, qf[st], s0); s1 = MFMA32(a1_, qf[st], s1); } } \
        __builtin_amdgcn_s_setprio(0); } while (0)
#define ATT_MAX(mx) do { float a_ = fmaxf(fmaxf(s0[0], s0[1]), s1[0]), b_ = fmaxf(fmaxf(s0[2], s0[3]), s1[1]); a_ = fmaxf(fmaxf(a_, s1[2]), s1[3]); \
        _Pragma("unroll") for (int i = 4; i < 16; i += 4) { a_ = fmaxf(fmaxf(a_, s0[i]), s0[i + 1]); b_ = fmaxf(fmaxf(b_, s0[i + 2]), s0[i + 3]); a_ = fmaxf(fmaxf(a_, s1[i]), s1[i + 1]); b_ = fmaxf(fmaxf(b_, s1[i + 2]), s1[i + 3]); } \
        mx = fmaxf(a_, b_); mx = xhalf_max(mx); } while (0)
#define ATT_EXP_PACK() do { float ra_ = 0.f, rb_ = 0.f; \
        _Pragma("unroll") for (int i = 0; i < 16; ++i) { s0[i] = __builtin_amdgcn_exp2f(s0[i]); s1[i] = __builtin_amdgcn_exp2f(s1[i]); ra_ += s0[i]; rb_ += s1[i]; } \
        l += ra_ + rb_; u32x4 w_; \
        w_.x = cvtpk(s0[0], s0[1]); w_.y = cvtpk(s0[2], s0[3]); w_.z = cvtpk(s0[4], s0[5]); w_.w = cvtpk(s0[6], s0[7]); pf[0] = __builtin_bit_cast(bf16x8, w_); \
        w_.x = cvtpk(s0[8], s0[9]); w_.y = cvtpk(s0[10], s0[11]); w_.z = cvtpk(s0[12], s0[13]); w_.w = cvtpk(s0[14], s0[15]); pf[1] = __builtin_bit_cast(bf16x8, w_); \
        w_.x = cvtpk(s1[0], s1[1]); w_.y = cvtpk(s1[2], s1[3]); w_.z = cvtpk(s1[4], s1[5]); w_.w = cvtpk(s1[6], s1[7]); pf[2] = __builtin_bit_cast(bf16x8, w_); \
        w_.x = cvtpk(s1[8], s1[9]); w_.y = cvtpk(s1[10], s1[11]); w_.z = cvtpk(s1[12], s1[13]); w_.w = cvtpk(s1[14], s1[15]); pf[3] = __builtin_bit_cast(bf16x8, w_); } while (0)
#define ATT_EXP_H(S, P0_, P1_) do { float ra_ = 0.f, rb_ = 0.f; \
        _Pragma("unroll") for (int i = 0; i < 16; i += 2) { S[i] = __builtin_amdgcn_exp2f(S[i]); S[i + 1] = __builtin_amdgcn_exp2f(S[i + 1]); ra_ += S[i]; rb_ += S[i + 1]; } \
        l += ra_ + rb_; u32x4 w_; \
        w_.x = cvtpk(S[0], S[1]); w_.y = cvtpk(S[2], S[3]); w_.z = cvtpk(S[4], S[5]); w_.w = cvtpk(S[6], S[7]); P0_ = __builtin_bit_cast(bf16x8, w_); \
        w_.x = cvtpk(S[8], S[9]); w_.y = cvtpk(S[10], S[11]); w_.z = cvtpk(S[12], S[13]); w_.w = cvtpk(S[14], S[15]); P1_ = __builtin_bit_cast(bf16x8, w_); } while (0)
    s16x4 vlo[2][NDB], vhi[2][NDB];
#define ATT_VRD(buf, ks, B) do { const LAS unsigned char* vb_ = lds + 2 * KBUF + (buf) * VBUF + voff; \
        _Pragma("unroll") for (int db = 0; db < NDB; ++db) { vlo[B][db] = vtr(vb_ + (16 * (ks)) * VP + db * 64); vhi[B][db] = vtr(vb_ + (16 * (ks) + 8) * VP + db * 64); } } while (0)
#define ATT_PV(buf, NKS) do { \
        __builtin_amdgcn_s_setprio(1); \
        _Pragma("unroll") for (int ks = 0; ks < (NKS); ++ks) { \
            if (ks + 1 < (NKS)) ATT_VRD(buf, ks + 1, (ks + 1) & 1); \
            _Pragma("unroll") for (int db = 0; db < NDB; ++db) { \
                const bf16x8 va_ = __builtin_shufflevector(vlo[ks & 1][db], vhi[ks & 1][db], 0, 1, 2, 3, 4, 5, 6, 7); \
                o[db] = MFMA32(va_, pf[ks], o[db]); } \
            __builtin_amdgcn_sched_barrier(0); } \
        __builtin_amdgcn_s_setprio(0); } while (0)
#define ATT_SMPV(buf) do { \
        ATT_EXP_H(s0, pf[0], pf[1]); \
        __builtin_amdgcn_sched_barrier(0); \
        ATT_VRD(buf, 1, 1); \
        _Pragma("unroll") for (int db = 0; db < NDB; ++db) { const bf16x8 va_ = __builtin_shufflevector(vlo[0][db], vhi[0][db], 0, 1, 2, 3, 4, 5, 6, 7); o[db] = MFMA32(va_, pf[0], o[db]); } \
        ATT_VRD(buf, 2, 0); \
        _Pragma("unroll") for (int db = 0; db < NDB; ++db) { const bf16x8 va_ = __builtin_shufflevector(vlo[1][db], vhi[1][db], 0, 1, 2, 3, 4, 5, 6, 7); o[db] = MFMA32(va_, pf[1], o[db]); } \
        ATT_EXP_H(s1, pf[2], pf[3]); \
        _Pragma("unroll") for (int g_ = 0; g_ < 2 * NDB; ++g_) { __builtin_amdgcn_sched_group_barrier(0x008, 1, 0); __builtin_amdgcn_sched_group_barrier(0x100, 2, 0); __builtin_amdgcn_sched_group_barrier(0x002, 40 / (2 * NDB), 0); } \
        __builtin_amdgcn_sched_barrier(0); \
        ATT_VRD(buf, 3, 1); \
        _Pragma("unroll") for (int db = 0; db < NDB; ++db) { const bf16x8 va_ = __builtin_shufflevector(vlo[0][db], vhi[0][db], 0, 1, 2, 3, 4, 5, 6, 7); o[db] = MFMA32(va_, pf[2], o[db]); } \
        __builtin_amdgcn_sched_barrier(0); \
        _Pragma("unroll") for (int db = 0; db < NDB; ++db) { const bf16x8 va_ = __builtin_shufflevector(vlo[1][db], vhi[1][db], 0, 1, 2, 3, 4, 5, 6, 7); o[db] = MFMA32(va_, pf[3], o[db]); } \
        __builtin_amdgcn_sched_barrier(0); } while (0)
    f32x16 zero16;
#pragma unroll
    for (int i = 0; i < 16; ++i) zero16[i] = 0.f;
    {
        ATT_QK(0, zero16);
#pragma unroll
        for (int i = 0; i < 16; ++i) { if (i >= 8) s0[i] = NEGV; s1[i] = NEGV; }
        ATT_VRD(0, 0, 0);
        float mx; ATT_MAX(mx);
        mhat = mx; l = 0.f;
#pragma unroll
        for (int i = 0; i < 16; ++i) { s0[i] -= mx; s1[i] -= mx; }
        ATT_EXP_PACK();
#pragma unroll
        for (int db = 0; db < NDB; ++db) o[db] = zero16;
        ATT_PV(0, 1);
        ATT_STORE(0, 1);
        if (2 < nt) ATT_LOAD(0, Kreal + (size_t)(t0 + 1) * 64 * kpitch, Vreal + (size_t)(t0 + 1) * 64 * vpitch);
        __syncthreads();
    }
#define ATT_TILE(it, PAR) do { \
          \
        bool skip_ = false, edge_ = false; \
        if (SWA) { const int k0_ = (t0 + (it) - 1) * 64; skip_ = (k0_ > qrel0 + 31 + 128) || (k0_ + 63 < qrel0 - 128); edge_ = !((k0_ >= qrel0 + 31 - 128) && (k0_ + 63 <= qrel0 + 128)); } \
        if (!skip_) { f32x16 negm_; _Pragma("unroll") for (int i = 0; i < 16; ++i) negm_[i] = -mhat; \
            ATT_QK(PAR, negm_); } \
        if ((it) + 1 < nt) ATT_STORE(0, (PAR) ^ 1);                       \
        if ((it) + 2 < nt) ATT_LOAD(0, Kreal + (size_t)(t0 + (it) + 1) * 64 * kpitch, Vreal + (size_t)(t0 + (it) + 1) * 64 * vpitch);     \
        if (!skip_) { \
            ATT_VRD(PAR, 0, 0);                                           \
            if (SWA && edge_) { const int d0_ = (t0 + (it) - 1) * 64 - (qrel0 + r); \
                _Pragma("unroll") for (int i = 0; i < 16; ++i) { const int d_ = d0_ + crow(i, h); if (d_ < -128 || d_ > 128) s0[i] = NEGV; if (d_ + 32 < -128 || d_ + 32 > 128) s1[i] = NEGV; } } \
            float mx_; ATT_MAX(mx_); \
            if (__builtin_expect(__any(mx_ > THR), 0)) { const float dl_ = fmaxf(mx_, 0.f); mhat += dl_; \
                _Pragma("unroll") for (int i = 0; i < 16; ++i) { s0[i] -= dl_; s1[i] -= dl_; } \
                const float f_ = __builtin_amdgcn_exp2f(-dl_); l *= f_; \
                _Pragma("unroll") for (int db = 0; db < NDB; ++db) _Pragma("unroll") for (int i = 0; i < 16; ++i) o[db][i] *= f_; } \
            ATT_SMPV(PAR); } \
        __syncthreads(); } while (0)
    for (int it = 1; it < nt; it += 2) { ATT_TILE(it, 1); ATT_TILE(it + 1, 0); }
#undef ATT_TILE
#undef ATT_QK
#undef ATT_MAX
#undef ATT_EXP_PACK
#undef ATT_PV
#undef ATT_SMPV
#undef ATT_EXP_H
#undef ATT_VRD
#undef ATT_LOAD
#undef ATT_STORE
    const float m = mhat;
    l = xhalf_sum(l);
    if constexpr (SWA) {
        l += __builtin_amdgcn_exp2f(sink_l2 - m);
        const float inv = 1.f / l;
#pragma unroll
        for (int db = 0; db < NDB; ++db)
#pragma unroll
            for (int g4 = 0; g4 < 4; ++g4) {
                u32x2 w; w.x = cvtpk(o[db][4 * g4] * inv, o[db][4 * g4 + 1] * inv); w.y = cvtpk(o[db][4 * g4 + 2] * inv, o[db][4 * g4 + 3] * inv);
                *(u32x2*)(Qw + (size_t)r * 2048 + 32 * db + 8 * g4 + 4 * h) = w;
            }
    } else {
        const float inv = 1.f / l;
        LAS float* xb = (LAS float*)lds;
        if (wid >= 4) {
            const float sc = lam * inv;
#pragma unroll
            for (int db = 0; db < NDB; ++db)
#pragma unroll
                for (int i = 0; i < 16; ++i) xb[((wid - 4) * 128 + 32 * db + crow(i, h)) * 32 + r] = o[db][i] * sc;
        }
        __syncthreads();
        if (wid < 4) {
            float ss = 0.f;
#pragma unroll
            for (int db = 0; db < NDB; ++db)
#pragma unroll
                for (int i = 0; i < 16; ++i) { const float v = o[db][i] * inv - xb[(wid * 128 + 32 * db + crow(i, h)) * 32 + r]; o[db][i] = v; ss += v * v; }
            ss = xhalf_sum(ss);
            const float rstd = 0.8f / sqrtf(ss * (1.f / 128.f) + 1e-6f);
#pragma unroll
            for (int db = 0; db < NDB; ++db)
#pragma unroll
                for (int g4 = 0; g4 < 4; ++g4) {
                    const int d = 32 * db + 8 * g4 + 4 * h; const f32x4 gg = *(const f32x4*)(gain + d);
                    u32x2 w; w.x = cvtpk(o[db][4 * g4] * rstd * gg[0], o[db][4 * g4 + 1] * rstd * gg[1]); w.y = cvtpk(o[db][4 * g4 + 2] * rstd * gg[2], o[db][4 * g4 + 3] * rstd * gg[3]);
                    *(u32x2*)(Od + (size_t)r * 2048 + d) = w;
                }
        }
        __syncthreads();
    }
}
constexpr int SW_KP = 144, SW_VP = 192, SW_KT = 64 * SW_KP, SW_VT = 64 * SW_VP, SW_VOFF = 7 * SW_KT, SW_LDS = 7 * (SW_KT + SW_VT);
__device__ __forceinline__ void swa_unit(LAS unsigned char* lds, const int tid, const int wid, const int lane, bf16_t* QOrow  ,
                                         const bf16_t* Kreal, const bf16_t* Kmeta, const bf16_t* Vreal, const bf16_t* Vmeta, const int t0, const int ntr, const int qblk0, const float* sink4) {
    constexpr float THR = 8.f;
    const int r = lane & 31, h = lane >> 5;
    {
        u32x4 kr[7], vr[7];
        const int row = tid >> 3, cc = tid & 7;
#pragma unroll
        for (int j = 0; j < 7; ++j) if (j <= ntr) {
            const bf16_t* ks = (j == 0) ? Kmeta : Kreal + (size_t)(t0 + j - 1) * 64 * 256; const bf16_t* vs = (j == 0) ? Vmeta : Vreal + (size_t)(t0 + j - 1) * 64 * 256;
            kr[j] = *(const u32x4*)(ks + (size_t)row * 256 + cc * 8); vr[j] = *(const u32x4*)(vs + (size_t)row * 256 + cc * 8); }
#pragma unroll
        for (int j = 0; j < 7; ++j) if (j <= ntr) {
            *(LAS u32x4*)(lds + j * SW_KT + row * SW_KP + cc * 16) = kr[j]; *(LAS u32x4*)(lds + SW_VOFF + j * SW_VT + row * SW_VP + cc * 16) = vr[j]; }
    }
    __syncthreads();
    const int koff = r * SW_KP + (8 * h) * 2;
    const int voff = (4 * h + ((lane & 15) >> 2)) * SW_VP + (16 * ((lane >> 4) & 1) + 4 * (lane & 3)) * 2;
    f32x16 zero16;
#pragma unroll
    for (int i = 0; i < 16; ++i) zero16[i] = 0.f;
    const int qrel0 = qblk0 + 32 * (wid & 3);
#pragma unroll 1
    for (int pass = 0; pass < 2; ++pass) {
        const int hd = 2 * pass + (wid >> 2);
        bf16_t* Qw = QOrow + (size_t)(32 * (wid & 3)) * 2048 + hd * 64;
        bf16x8 qf[4];
#pragma unroll
        for (int st = 0; st < 4; ++st) qf[st] = *(const bf16x8*)(Qw + (size_t)r * 2048 + 16 * st + 8 * h);
        const float sink_l2 = sink4[hd] * 1.4426950408889634f;
        f32x16 o[2], s0, s1; bf16x8 pf[4]; float mhat, l = 0.f;
#define SW_QK(j, C0) do { const LAS unsigned char* kb_ = lds + (j) * SW_KT + koff; \
        _Pragma("unroll") for (int st = 0; st < 4; ++st) { \
            const bf16x8 a0_ = *(const LAS bf16x8*)(kb_ + st * 32), a1_ = *(const LAS bf16x8*)(kb_ + 32 * SW_KP + st * 32); \
            if (st == 0) { s0 = MFMA32(a0_, qf[0], C0); s1 = MFMA32(a1_, qf[0], C0); } else { s0 = MFMA32(a0_, qf[st], s0); s1 = MFMA32(a1_, qf[st], s1); } } } while (0)
#define SW_MAX(mx) do { float a_ = fmaxf(fmaxf(s0[0], s0[1]), s1[0]), b_ = fmaxf(fmaxf(s0[2], s0[3]), s1[1]); a_ = fmaxf(fmaxf(a_, s1[2]), s1[3]); \
        _Pragma("unroll") for (int i = 4; i < 16; i += 4) { a_ = fmaxf(fmaxf(a_, s0[i]), s0[i + 1]); b_ = fmaxf(fmaxf(b_, s0[i + 2]), s0[i + 3]); a_ = fmaxf(fmaxf(a_, s1[i]), s1[i + 1]); b_ = fmaxf(fmaxf(b_, s1[i + 2]), s1[i + 3]); } \
        mx = xhalf_max(fmaxf(a_, b_)); } while (0)
#define SW_EXP_H(S, P0_, P1_) do { float ra_ = 0.f, rb_ = 0.f; \
        _Pragma("unroll") for (int i = 0; i < 16; i += 2) { S[i] = __builtin_amdgcn_exp2f(S[i]); S[i + 1] = __builtin_amdgcn_exp2f(S[i + 1]); ra_ += S[i]; rb_ += S[i + 1]; } \
        l += ra_ + rb_; u32x4 w_; \
        w_.x = cvtpk(S[0], S[1]); w_.y = cvtpk(S[2], S[3]); w_.z = cvtpk(S[4], S[5]); w_.w = cvtpk(S[6], S[7]); P0_ = __builtin_bit_cast(bf16x8, w_); \
        w_.x = cvtpk(S[8], S[9]); w_.y = cvtpk(S[10], S[11]); w_.z = cvtpk(S[12], S[13]); w_.w = cvtpk(S[14], S[15]); P1_ = __builtin_bit_cast(bf16x8, w_); } while (0)
#define SW_PV(j, NKS) do { const LAS unsigned char* vb_ = lds + SW_VOFF + (j) * SW_VT + voff; \
        _Pragma("unroll") for (int ks = 0; ks < (NKS); ++ks) \
            _Pragma("unroll") for (int db = 0; db < 2; ++db) { \
                const s16x4 lo_ = vtr(vb_ + (16 * ks) * SW_VP + db * 64), hi_ = vtr(vb_ + (16 * ks + 8) * SW_VP + db * 64); \
                const bf16x8 va_ = __builtin_shufflevector(lo_, hi_, 0, 1, 2, 3, 4, 5, 6, 7); \
                o[db] = MFMA32(va_, pf[ks], o[db]); } } while (0)
        {
            SW_QK(0, zero16);
#pragma unroll
            for (int i = 0; i < 16; ++i) { if (i >= 8) s0[i] = NEGV; s1[i] = NEGV; }
            float mx; SW_MAX(mx);
            mhat = mx;
#pragma unroll
            for (int i = 0; i < 16; ++i) s0[i] -= mx;
            SW_EXP_H(s0, pf[0], pf[1]);
            o[0] = zero16; o[1] = zero16;
            SW_PV(0, 1);
        }
#pragma unroll 1
        for (int j = 1; j <= ntr; ++j) {
            const int k0 = (t0 + j - 1) * 64;
            if ((k0 > qrel0 + 31 + 128) || (k0 + 63 < qrel0 - 128)) continue;
            const bool edge = !((k0 >= qrel0 + 31 - 128) && (k0 + 63 <= qrel0 + 128));
            f32x16 negm_;
#pragma unroll
            for (int i = 0; i < 16; ++i) negm_[i] = -mhat;
            SW_QK(j, negm_);
            if (edge) { const int d0_ = k0 - (qrel0 + r);
#pragma unroll
                for (int i = 0; i < 16; ++i) { const int d_ = d0_ + crow(i, h); if (d_ < -128 || d_ > 128) s0[i] = NEGV; if (d_ + 32 < -128 || d_ + 32 > 128) s1[i] = NEGV; } }
            float mx_; SW_MAX(mx_);
            if (__builtin_expect(__any(mx_ > THR), 0)) { const float dl_ = fmaxf(mx_, 0.f); mhat += dl_;
#pragma unroll
                for (int i = 0; i < 16; ++i) { s0[i] -= dl_; s1[i] -= dl_; }
                const float f_ = __builtin_amdgcn_exp2f(-dl_); l *= f_;
#pragma unroll
                for (int db = 0; db < 2; ++db)
#pragma unroll
                    for (int i = 0; i < 16; ++i) o[db][i] *= f_; }
            SW_EXP_H(s0, pf[0], pf[1]); SW_EXP_H(s1, pf[2], pf[3]);
            SW_PV(j, 4);
        }
#undef SW_QK
#undef SW_MAX
#undef SW_EXP_H
#undef SW_PV
        l = xhalf_sum(l);
        l += __builtin_amdgcn_exp2f(sink_l2 - mhat);
        const float inv = 1.f / l;
#pragma unroll
        for (int db = 0; db < 2; ++db)
#pragma unroll
            for (int g4 = 0; g4 < 4; ++g4) {
                u32x2 w; w.x = cvtpk(o[db][4 * g4] * inv, o[db][4 * g4 + 1] * inv); w.y = cvtpk(o[db][4 * g4 + 2] * inv, o[db][4 * g4 + 3] * inv);
                *(u32x2*)(Qw + (size_t)r * 2048 + 32 * db + 8 * g4 + 4 * h) = w;
            }
    }
    __syncthreads();
}
}

typedef unsigned short bf16;
typedef float f32x4 __attribute__((ext_vector_type(4)));
typedef unsigned u32x4 __attribute__((ext_vector_type(4)));
typedef unsigned u32x2 __attribute__((ext_vector_type(2)));
using pg8::cvtpk; using pg8::bf_lo; using pg8::bf_hi;
constexpr int NTOK = 32768, DM = 1024, NIN = 6656, DFF = 2816, SEQL = 2048;
constexpr float RMS_EPS = 1e-6f;
constexpr int LDS_MAIN = 151552, LDS_BYTES = LDS_MAIN + 256;
static_assert(att::ATT_LDS_MAX <= LDS_MAIN && att::SW_LDS <= LDS_MAIN && pg8::STAGE_BYTES <= LDS_MAIN, "LDS map");

__device__ __forceinline__ float wave_sum(float v) {
#pragma unroll
    for (int o = 1; o < 64; o <<= 1) v += __shfl_xor(v, o);
    return v;
}
template <int MODE> __device__ __forceinline__ int rowmap(int n) {
    if (MODE == 1) {
        const bool perm = (n < 1280) || (n >= 1536 && n < 3584);
        if (!perm) return n;
        const int d = n & 63; return (n & ~63) + ((d < 32) ? 2 * d : 2 * (d - 32) + 1);
    } else if (MODE == 2) {
        if (n < DFF) return 8 * (n >> 2) + (n & 3);
        const int j = n - DFF; return 8 * (j >> 2) + 4 + (j & 3);
    }
    return n;
}
template <int MODE> __device__ __forceinline__ void p0_transpose_item(const float* W, int N, bf16* WT, int ldk, int koff, LAS float* scr, int item, int lane, const float* kscale = nullptr) {
    const int nblk = N / 32, kb = item / nblk, nb = item % nblk, k0 = 64 * kb, n0 = 32 * nb;
#pragma unroll 8
    for (int i = 0; i < 32; ++i) { const int kk = 2 * i + (lane >> 5); scr[kk * 33 + (lane & 31)] = W[(size_t)(k0 + kk) * N + n0 + (lane & 31)]; }
    asm volatile("s_waitcnt lgkmcnt(0)" ::: "memory");
    const int c = lane & 7;
    f32x4 ks0 = {1.f, 1.f, 1.f, 1.f}, ks1 = {1.f, 1.f, 1.f, 1.f};
    if (kscale) { ks0 = *(const f32x4*)(kscale + k0 + 8 * c); ks1 = *(const f32x4*)(kscale + k0 + 8 * c + 4); }
#pragma unroll
    for (int j = 0; j < 4; ++j) { const int n = (lane >> 3) + 8 * j; const LAS float* s = scr + (8 * c) * 33 + n;
        u32x4 o; o.x = cvtpk(s[0 * 33] * ks0[0], s[1 * 33] * ks0[1]); o.y = cvtpk(s[2 * 33] * ks0[2], s[3 * 33] * ks0[3]); o.z = cvtpk(s[4 * 33] * ks1[0], s[5 * 33] * ks1[1]); o.w = cvtpk(s[6 * 33] * ks1[2], s[7 * 33] * ks1[3]);
        *(u32x4*)(WT + (size_t)rowmap<MODE>(n0 + n) * ldk + koff + k0 + 8 * c) = o; }
    asm volatile("s_waitcnt lgkmcnt(0)" ::: "memory");
}

#define XB_TMO      128
#define XB_XCNT(j)  (256  + 64 * (j))
#define XB_XSUB(j)  (1280 + 64 * (j))
#define XB_XGEN(j)  (2304 + 64 * (j))
#define XB_TOP      3328
#define XB_TOPGEN   3392
#define XCD_BAR_WORDS 3456
#define XB_SPIN_CAP (1u << 18)

__device__ __forceinline__ unsigned xb_ld(unsigned* p)              { return __hip_atomic_load(p, __ATOMIC_RELAXED, __HIP_MEMORY_SCOPE_AGENT); }
__device__ __forceinline__ unsigned xb_add(unsigned* p, unsigned v) { return __hip_atomic_fetch_add(p, v, __ATOMIC_RELAXED, __HIP_MEMORY_SCOPE_AGENT); }
__device__ __forceinline__ unsigned xb_xcc_id() { return (unsigned)__builtin_amdgcn_s_getreg((3 << 11) | 20) & 0xFu; }
#define XB_SPIN(cond, bar) do { unsigned _sp = 0; while (cond) { __builtin_amdgcn_s_sleep(1); \
    if ((++_sp & 255u) == 0u) { if (xb_ld(&(bar)[XB_TMO])) break; if (_sp > XB_SPIN_CAP) { atomicAdd(&(bar)[XB_TMO], 1u); break; } } } } while (0)

struct XcdBarrier {
    unsigned* bar; unsigned x;
    volatile LAS unsigned* st;
};

__device__ __forceinline__ XcdBarrier xcd_barrier_post(unsigned* bar, volatile LAS unsigned* st) {
    XcdBarrier b; b.bar = bar; b.x = xb_xcc_id(); b.st = st;
    if (threadIdx.x == 0) (void)xb_add(&bar[XB_XCNT(b.x)], 1u);
    return b;
}
__device__ __forceinline__ void xcd_barrier_complete(unsigned* bar, unsigned x, unsigned& nloc, unsigned& nx) {
    const unsigned G = gridDim.x * gridDim.y * gridDim.z;
    unsigned sum, cnt, mine, sp = 0u;
    for (;;) {
        sum = 0u; cnt = 0u; mine = 0u;
#pragma unroll
        for (unsigned j = 0; j < 16; ++j) { const unsigned c = xb_ld(&bar[XB_XCNT(j)]); sum += c; cnt += (c > 0u) ? 1u : 0u; mine = (j == x) ? c : mine; }
        if (sum == G) break;
        __builtin_amdgcn_s_sleep(1);
        if ((++sp & 255u) == 0u) { if (xb_ld(&bar[XB_TMO])) break; if (sp > XB_SPIN_CAP) { atomicAdd(&bar[XB_TMO], 1u); break; } }
    }
    nloc = mine > 0u ? mine : 1u; nx = cnt > 0u ? cnt : 1u;
}

__device__ __forceinline__ void xcd_barrier(const XcdBarrier& b) {
    asm volatile("s_waitcnt vmcnt(0)" ::: "memory");
    __syncthreads();
    if (threadIdx.x == 0) {
        unsigned* bar = b.bar;
        __builtin_amdgcn_s_waitcnt(0);
        unsigned nloc = b.st[0], nx = b.st[1];
        if (nloc == 0u) { xcd_barrier_complete(bar, b.x, nloc, nx); b.st[0] = nloc; b.st[1] = nx; }
        const unsigned old = xb_add(&bar[XB_XSUB(b.x)], 1u);
        const unsigned gen = old / nloc;
        if (old + 1u == (gen + 1u) * nloc) {
            __builtin_amdgcn_fence(__ATOMIC_RELEASE, "agent");
            asm volatile("s_waitcnt vmcnt(0)" ::: "memory");
            const unsigned og = xb_add(&bar[XB_TOP], 1u);
            const unsigned tg = og / nx;
            if (og + 1u == (tg + 1u) * nx) xb_add(&bar[XB_TOPGEN], 1u);
            else XB_SPIN(xb_ld(&bar[XB_TOPGEN]) == tg, bar);
            __builtin_amdgcn_fence(__ATOMIC_ACQUIRE, "agent");
            xb_add(&bar[XB_XGEN(b.x)], 1u);
            asm volatile("s_waitcnt vmcnt(0)" ::: "memory");
        } else {
            XB_SPIN(xb_ld(&bar[XB_XGEN(b.x)]) == gen, bar);
            __builtin_amdgcn_fence(__ATOMIC_ACQUIRE, "agent");
            asm volatile("s_waitcnt vmcnt(0)" ::: "memory");
        }
    }
    __syncthreads();
}

constexpr size_t WS_BAR = 512 * 1024;
#ifndef WGM_P1
#define WGM_P1 4
#endif
#ifndef WGM_P6
#define WGM_P6 4
#endif
#ifndef WGM_N1K
#define WGM_N1K 8
#endif
#ifndef PH_MASK
#define PH_MASK 0x1ff
#endif
#define PH_ON(k) ((PH_MASK >> (k)) & 1)
#ifndef PROBE_PHASE
#define PROBE_PHASE (-1)
#endif
#define PROBE_T0(k) do { if (PROBE_PHASE == (k) && threadIdx.x == 0) probe_t0 = __builtin_amdgcn_s_memrealtime(); } while (0)
#define PROBE_DELAY(k) do { if (PROBE_PHASE == (k)) { if (threadIdx.x == 0) { const unsigned long long t1_ = __builtin_amdgcn_s_memrealtime(), dt_ = t1_ - probe_t0; while (__builtin_amdgcn_s_memrealtime() - t1_ < dt_) __builtin_amdgcn_s_sleep(8); } __syncthreads(); } } while (0)
struct Args { const float* in[19]; float* out; unsigned char* ws; };

__global__ void __launch_bounds__(512, 2) fwd_megakernel(Args a) {
    extern __shared__ __attribute__((aligned(16))) unsigned char lds_raw[];
    cg::grid_group grid = cg::this_grid();
    LAS unsigned char* lds = (LAS unsigned char*)lds_raw;
    const int tid = threadIdx.x, lane = tid & 63, wid = __builtin_amdgcn_readfirstlane(tid >> 6);
    const int G = gridDim.x, bx = blockIdx.x;
    const int vcu = (G % 8 == 0) ? (bx % 8) * (G / 8) + bx / 8 : bx;
    const int gw = bx * 8 + wid, NGW = G * 8;
    unsigned char* ws = a.ws;
    unsigned long long probe_t0 = 0; (void)probe_t0;
    volatile LAS unsigned* xb_st = (volatile LAS unsigned*)(lds + LDS_MAIN);
    if (threadIdx.x < 2) xb_st[threadIdx.x] = 0u;
    __syncthreads();
    const XcdBarrier xbar = xcd_barrier_post((unsigned*)(ws + WS_BAR), xb_st);
#define p_x (a.in[0])
#define p_meta_tokens (a.in[1])
#define p_pre_mix_gain (a.in[2])
#define p_w_in (a.in[3])
#define p_b_gate (a.in[4])
#define p_attn_sink (a.in[5])
#define p_lq1 (a.in[6])
#define p_lk1 (a.in[7])
#define p_lq2 (a.in[8])
#define p_lk2 (a.in[9])
#define p_subln_gain (a.in[10])
#define p_w_bswa (a.in[11])
#define p_w_bdiff (a.in[12])
#define p_w_out (a.in[13])
#define p_post_mix_gain (a.in[14])
#define p_pre_ffn_gain (a.in[15])
#define p_w_ffn_in (a.in[16])
#define p_w_ffn_out (a.in[17])
#define p_post_ffn_gain (a.in[18])
#define p_ss1 ((float*)(ws + WS_SS1))
#define p_ss3 ((float*)(ws + WS_SS3))
#define p_rope ((float*)(ws + WS_ROPE))
#define p_KAm ((bf16*)(ws + WS_KAM))
#define p_VAm ((bf16*)(ws + WS_VAM))
#define p_KBm ((bf16*)(ws + WS_KBM))
#define p_VBm ((bf16*)(ws + WS_VBM))
#define p_Win_t ((bf16*)(ws + WS_WIN))
#define p_Wcat_t ((bf16*)(ws + WS_WCAT))
#define p_Wout_t ((bf16*)(ws + WS_WOUT))
#define p_Wffi_t ((bf16*)(ws + WS_WFFI))
#define p_Wffo_t ((bf16*)(ws + WS_WFFO))
#define p_U ((bf16*)(ws + WS_U))
#define p_QO ((bf16*)(ws + WS_QO))
#define p_KA ((bf16*)(ws + WS_KA))
#define p_VA ((bf16*)(ws + WS_VA))
#define p_KB ((bf16*)(ws + WS_KB))
#define p_VB ((bf16*)(ws + WS_VB))
#define p_MERGED ((bf16*)(ws + WS_MERGED))
#define p_Y ((bf16*)(ws + WS_Y))
#define p_F ((bf16*)(ws + WS_F))
#define p_FO ((bf16*)(ws + WS_FO))
#define p_H1 ((bf16*)(ws + WS_H1))
#define p_GATES ((bf16*)a.out)
#define p_out (a.out)

#if PH_ON(0)
    PROBE_T0(0);
    {
        int tid_o = threadIdx.x; asm volatile("" : "+v"(tid_o));
        const int tid = tid_o, lane = tid & 63, wid = __builtin_amdgcn_readfirstlane(tid >> 6), gw = bx * 8 + wid; (void)tid; (void)gw;
        for (int e = bx * 512 + tid; e < 65536; e += G * 512) p_ss1[e] = 0.f;
        for (int e = bx * 512 + tid; e < 2064 * 32; e += G * 512) {
            const int pos = e >> 5, i = e & 31; const float inv = powf(10000.f, -(float)i * (1.f / 32.f)); const float ang = (float)pos * inv;
            p_rope[2 * e] = cosf(ang); p_rope[2 * e + 1] = sinf(ang);
        }
        for (int base = gw; base < NTOK; base += 4 * NGW) {
            f32x4 v[4][4]; float sq[4];
#pragma unroll
            for (int q = 0; q < 4; ++q) { const int mrow = (base + q * NGW < NTOK) ? base + q * NGW : NTOK - 1; const f32x4* xr = (const f32x4*)(p_x + (size_t)mrow * DM) + lane;
#pragma unroll
                for (int j = 0; j < 4; ++j) v[q][j] = __builtin_nontemporal_load(&xr[64 * j]); }
#pragma unroll
            for (int q = 0; q < 4; ++q) { float s = 0.f;
#pragma unroll
                for (int j = 0; j < 4; ++j) s += (v[q][j][0] * v[q][j][0] + v[q][j][1] * v[q][j][1]) + (v[q][j][2] * v[q][j][2] + v[q][j][3] * v[q][j][3]);
                sq[q] = 1.f / sqrtf(wave_sum(s) * (1.f / DM) + RMS_EPS); }
#pragma unroll
            for (int q = 0; q < 4; ++q) { if (base + q * NGW < NTOK) { u32x2* o8 = (u32x2*)(p_U + (size_t)(base + q * NGW) * DM) + lane; if (lane == 0) ((float*)(ws + WS_RSX))[base + q * NGW] = sq[q];
#pragma unroll
                for (int j = 0; j < 4; ++j) { const float rstd = sq[q]; u32x2 w; w.x = cvtpk(v[q][j][0] * rstd, v[q][j][1] * rstd); w.y = cvtpk(v[q][j][2] * rstd, v[q][j][3] * rstd); o8[64 * j] = w; } } }
        }
        if (bx < 40) {
            const int item = bx;
            LAS float* um = (LAS float*)lds; LAS float* red = (LAS float*)(lds + 65536);
#pragma unroll
            for (int rr = 0; rr < 2; ++rr) {
                const int row = 2 * wid + rr; const float* xr = p_meta_tokens + row * DM; float v[16]; float s = 0.f;
#pragma unroll
                for (int j = 0; j < 16; ++j) { v[j] = xr[lane + 64 * j]; s += v[j] * v[j]; }
                s = wave_sum(s); const float rstd = 1.f / sqrtf(s * (1.f / DM) + RMS_EPS);
#pragma unroll
                for (int j = 0; j < 16; ++j) um[row * DM + lane + 64 * j] = v[j] * rstd * p_pre_mix_gain[lane + 64 * j];
            }
            __syncthreads();
            int c0, ldd, dcol; bf16* dst; bool dorope;
            if (item < 4)       { c0 = 1024 + 64 * item;        dst = p_KAm; ldd = 256;  dcol = 64 * item;        dorope = true; }
            else if (item < 8)  { c0 = 1280 + 64 * (item - 4);  dst = p_VAm; ldd = 256;  dcol = 64 * (item - 4);  dorope = false; }
            else if (item < 24) { c0 = 2560 + 64 * (item - 8);  dst = p_KBm; ldd = 1024; dcol = 64 * (item - 8);  dorope = true; }
            else                { c0 = 3584 + 64 * (item - 24); dst = p_VBm; ldd = 1024; dcol = 64 * (item - 24); dorope = false; }
#define FMAC(c_, a_, b_) asm("v_fmac_f32_e32 %0, %1, %2" : "+v"(c_) : "v"(a_), "v"(b_))
            float acc[16];
#pragma unroll
            for (int rI = 0; rI < 16; ++rI) acc[rI] = 0.f;
            const float* wp = p_w_in + (size_t)(128 * wid) * NIN + c0 + lane;
#pragma unroll 1
            for (int kc = 0; kc < 4; ++kc) {
                float wv[32];
#pragma unroll
                for (int e = 0; e < 32; ++e) wv[e] = wp[(size_t)(32 * kc + e) * NIN];
#pragma unroll
                for (int k4 = 0; k4 < 8; ++k4) {
                    asm volatile("" ::: "memory");
#pragma unroll
                    for (int rI = 0; rI < 16; ++rI) { const f32x4 uu = *(const LAS f32x4*)(um + rI * DM + 128 * wid + 32 * kc + 4 * k4); FMAC(acc[rI], uu[0], wv[4 * k4]); FMAC(acc[rI], uu[1], wv[4 * k4 + 1]); FMAC(acc[rI], uu[2], wv[4 * k4 + 2]); FMAC(acc[rI], uu[3], wv[4 * k4 + 3]); }
                }
            }
#pragma unroll
            for (int rI = 0; rI < 16; ++rI) red[(wid * 16 + rI) * 64 + lane] = acc[rI];
            __syncthreads();
            {
                const int rI = tid >> 5, i = tid & 31; float x1 = 0.f, x2 = 0.f;
#pragma unroll
                for (int w = 0; w < 8; ++w) { x1 += red[(w * 16 + rI) * 64 + i]; x2 += red[(w * 16 + rI) * 64 + i + 32]; }
                if (dorope) {
                    const float inv = powf(10000.f, -(float)i * (1.f / 32.f)); const float ang = (float)rI * inv; const float c = cosf(ang), s = sinf(ang);
                    *(unsigned*)(dst + rI * ldd + dcol + 2 * i) = cvtpk(x1 * c - x2 * s, x2 * c + x1 * s);
                } else {
                    dst[rI * ldd + dcol + i] = (bf16)(cvtpk(x1, 0.f) & 0xffffu); dst[rI * ldd + dcol + i + 32] = (bf16)(cvtpk(x2, 0.f) & 0xffffu);
                }
                for (int e = tid; e < 1536; e += 512) { const int rr = 16 + e / 32, cc = (e % 32) * 2; *(unsigned*)(dst + rr * ldd + dcol + cc) = 0u; }
            }
            __syncthreads();
        }
        {
            LAS float* scr = (LAS float*)(lds + wid * 16384);
            constexpr int I_IN = 16 * (NIN / 32), I_SQ = 16 * 32, I_FI = 16 * (2 * DFF / 32), I_FO = (DFF / 64) * 32;
            constexpr int NITEMS = I_IN + 3 * I_SQ + I_FI + I_FO;
            const bool skipw = (G > 80) && (bx < 40);
            const int wfirst = (G > 80) ? (bx - 40) * 8 + wid : gw, wstride = (G > 80) ? (G - 40) * 8 : NGW;
            if (!skipw) for (int it = wfirst; it < NITEMS; it += wstride) {
                int q = it;
                if (q < I_IN) { p0_transpose_item<1>(p_w_in, NIN, p_Win_t, DM, 0, scr, q, lane, p_pre_mix_gain); continue; } q -= I_IN;
                if (q < I_SQ) { p0_transpose_item<0>(p_w_bswa, DM, p_Wcat_t, 2048, 0, scr, q, lane); continue; } q -= I_SQ;
                if (q < I_SQ) { p0_transpose_item<0>(p_w_bdiff, DM, p_Wcat_t, 2048, 1024, scr, q, lane); continue; } q -= I_SQ;
                if (q < I_SQ) { p0_transpose_item<0>(p_w_out, DM, p_Wout_t, DM, 0, scr, q, lane); continue; } q -= I_SQ;
                if (q < I_FI) { p0_transpose_item<2>(p_w_ffn_in, 2 * DFF, p_Wffi_t, DM, 0, scr, q, lane, p_pre_ffn_gain); continue; } q -= I_FI;
                p0_transpose_item<0>(p_w_ffn_out, DM, p_Wffo_t, DFF, 0, scr, q, lane);
            }
        }
    }
    if (a.ws == nullptr) grid.sync();
    xcd_barrier(xbar);
    PROBE_DELAY(0);

#endif
#if PH_ON(1)
    PROBE_T0(1);
    {
        pg8::Gemm g{p_U, p_Win_t, NTOK, NIN, DM}; pg8::StaticOrder S; S.init(NTOK, NIN, G, bx, WGM_P1);
        pg8::EpiInProj E{ws, p_GATES, p_b_gate};
        pg8::gemm_phase<pg8::EpiInProj, pg8::StaticOrder, true, true>(lds, g, S, E);
    }
    xcd_barrier(xbar);
    PROBE_DELAY(1);

#endif
#if PH_ON(2)
    PROBE_T0(2);
    {
        int tid_o = threadIdx.x; asm volatile("" : "+v"(tid_o));
        const int tid = tid_o, lane = tid & 63, wid = __builtin_amdgcn_readfirstlane(tid >> 6);
        unsigned long long att_acc = 0, att_dummy = 0;
        float lam;
        { float p1 = p_lq1[lane] * p_lk1[lane], p2 = p_lq2[lane] * p_lk2[lane]; p1 = wave_sum(p1); p2 = wave_sum(p2); lam = expf(p1) - expf(p2) + 0.2f; }
        for (int uidx = vcu; uidx < 2048; uidx += G) {
            const int i = uidx & 15, hh = (uidx >> 4) & 7, b = uidx >> 7;
            const size_t qrow = (size_t)b * SEQL + i * 128 + 32 * (wid & 3);
            att::attn_unit<128, 128, false>(lds, tid, wid, lane, p_QO + qrow * 2048 + 1024 + hh * 128 + 64 * (wid >> 2),
                                            p_KB + (size_t)b * SEQL * 1024 + hh * 128, p_KBm + hh * 128, 1024, p_VB + (size_t)b * SEQL * 1024 + hh * 128, p_VBm + hh * 128, 1024,
                                            0, 32, 0, 0.f, lam, p_subln_gain, p_QO + qrow * 2048 + 1024 + hh * 128, att_acc);
        }
#if ATT_PROBE == 9
        const unsigned long long swa_t0 = __builtin_amdgcn_s_memrealtime();
#endif
        for (int uidx = vcu; uidx < 1024; uidx += G) {
            const int i = uidx & 15, gk = (uidx >> 4) & 3, b = uidx >> 6;
            const int t0 = (i >= 1) ? 2 * (i - 1) : 0, t1 = (2 * (i + 2) < 32) ? 2 * (i + 2) : 32;
            att::swa_unit(lds, tid, wid, lane, p_QO + ((size_t)b * SEQL + i * 128) * 2048 + gk * 256,
                          p_KA + (size_t)b * SEQL * 256 + gk * 64, p_KAm + gk * 64, p_VA + (size_t)b * SEQL * 256 + gk * 64, p_VAm + gk * 64, t0, t1 - t0, i * 128, p_attn_sink + gk * 4);
        }
#if ATT_PROBE == 9
        att_acc = __builtin_amdgcn_s_memrealtime() - swa_t0;
#endif
#if ATT_PROBE
        if (wid == 0) { const unsigned long long t1_ = __builtin_amdgcn_s_memrealtime(); while (__builtin_amdgcn_s_memrealtime() - t1_ < att_acc) __builtin_amdgcn_s_sleep(8); }
        __syncthreads();
#endif
    }
    xcd_barrier(xbar);
    PROBE_DELAY(2);

#endif
#if PH_ON(3)
    PROBE_T0(3);
    {
        pg8::Gemm g{p_QO, p_Wcat_t, NTOK, DM, 2048}; pg8::StaticOrder S; S.init(NTOK, DM, G, bx, WGM_N1K);
        pg8::EpiMerge E{p_GATES, p_MERGED};
        pg8::gemm_phase<pg8::EpiMerge, pg8::StaticOrder, true, true>(lds, g, S, E);
    }
    xcd_barrier(xbar);
    PROBE_DELAY(3);

#endif
#if PH_ON(4)
    PROBE_T0(4);
    {
        pg8::Gemm g{p_MERGED, p_Wout_t, NTOK, DM, DM}; pg8::StaticOrder S; S.init(NTOK, DM, G, bx, WGM_N1K);
        pg8::EpiYSS E{p_Y, p_ss1};
        pg8::gemm_phase<pg8::EpiYSS, pg8::StaticOrder, true, true>(lds, g, S, E);
    }
    xcd_barrier(xbar);
    PROBE_DELAY(4);

#endif
#if PH_ON(5)
    PROBE_T0(5);
    {
        int tid_o = threadIdx.x; asm volatile("" : "+v"(tid_o));
        const int tid = tid_o, lane = tid & 63, wid = __builtin_amdgcn_readfirstlane(tid >> 6), gw = bx * 8 + wid; (void)tid; (void)gw;
    for (int base = gw; base < NTOK; base += 4 * NGW) {
        f32x4 hv[4][4]; u32x2 yw[4][4]; u32x2 xw[4][4]; float r1[4], rx[4];
#pragma unroll
        for (int q = 0; q < 4; ++q) { const int mrow = (base + q * NGW < NTOK) ? base + q * NGW : NTOK - 1;
            const u32x2* xr = (const u32x2*)(p_U + (size_t)mrow * DM) + lane; const u32x2* yr = (const u32x2*)(p_Y + (size_t)mrow * DM) + lane;
            r1[q] = p_ss1[mrow]; rx[q] = ((const float*)(ws + WS_RSX))[mrow];
#pragma unroll
            for (int j = 0; j < 4; ++j) { xw[q][j] = xr[64 * j]; yw[q][j] = yr[64 * j]; } }
#pragma unroll
        for (int q = 0; q < 4; ++q) {
            const float rstd1 = 1.f / sqrtf(r1[q] * (1.f / DM) + RMS_EPS), xs = 1.f / rx[q]; float s2 = 0.f;
#pragma unroll
            for (int j = 0; j < 4; ++j) { const f32x4 g = *((const f32x4*)p_post_mix_gain + lane + 64 * j); f32x4 t; t[0] = bf_lo(xw[q][j].x) * xs; t[1] = bf_hi(xw[q][j].x) * xs; t[2] = bf_lo(xw[q][j].y) * xs; t[3] = bf_hi(xw[q][j].y) * xs;
                t[0] += bf_lo(yw[q][j].x) * rstd1 * g[0]; t[1] += bf_hi(yw[q][j].x) * rstd1 * g[1]; t[2] += bf_lo(yw[q][j].y) * rstd1 * g[2]; t[3] += bf_hi(yw[q][j].y) * rstd1 * g[3];
                hv[q][j] = t; s2 += (t[0] * t[0] + t[1] * t[1]) + (t[2] * t[2] + t[3] * t[3]); }
            r1[q] = 1.f / sqrtf(wave_sum(s2) * (1.f / DM) + RMS_EPS);
        }
#pragma unroll
        for (int q = 0; q < 4; ++q) { if (base + q * NGW < NTOK) { const int mrow = base + q * NGW; const float rstd2 = r1[q];
            u32x2* hrow = (u32x2*)(p_H1 + (size_t)mrow * DM) + lane; if (lane == 0) ((float*)(ws + WS_RS2))[mrow] = rstd2;
#pragma unroll
            for (int j = 0; j < 4; ++j) { u32x2 hw; hw.x = cvtpk(hv[q][j][0] * rstd2, hv[q][j][1] * rstd2); hw.y = cvtpk(hv[q][j][2] * rstd2, hv[q][j][3] * rstd2); hrow[64 * j] = hw; } } }
    }
    }
    xcd_barrier(xbar);
    PROBE_DELAY(5);

#endif
#if PH_ON(6)
    PROBE_T0(6);
    {
        pg8::Gemm g{p_H1, p_Wffi_t, NTOK, 2 * DFF, DM}; pg8::StaticOrder S; S.init(NTOK, 2 * DFF, G, bx, WGM_P6);
        pg8::EpiSwiGLU E{p_F};
        pg8::gemm_phase<pg8::EpiSwiGLU, pg8::StaticOrder, true, true>(lds, g, S, E);
    }
    xcd_barrier(xbar);
    PROBE_DELAY(6);

#endif
#if PH_ON(7)
    PROBE_T0(7);
    {
        pg8::Gemm g{p_F, p_Wffo_t, NTOK, DM, DFF}; pg8::StaticOrder S; S.init(NTOK, DM, G, bx, WGM_N1K);
        pg8::EpiYSS E{p_FO, p_ss3};
        pg8::gemm_phase<pg8::EpiYSS, pg8::StaticOrder, true, true>(lds, g, S, E);
    }
    xcd_barrier(xbar);
    PROBE_DELAY(7);

#endif
#if PH_ON(8)
    PROBE_T0(8);
    {
        int tid_o = threadIdx.x; asm volatile("" : "+v"(tid_o));
        const int tid = tid_o, lane = tid & 63, wid = __builtin_amdgcn_readfirstlane(tid >> 6), gw = bx * 8 + wid; (void)tid; (void)gw;
    for (int base = gw; base < NTOK; base += 4 * NGW) {
        u32x2 hw[4][4]; u32x2 fw[4][4]; float r3[4], r2[4];
#pragma unroll
        for (int q = 0; q < 4; ++q) { const int mrow = (base + q * NGW < NTOK) ? base + q * NGW : NTOK - 1;
            const u32x2* hr = (const u32x2*)(p_H1 + (size_t)mrow * DM) + lane; const u32x2* fr_ = (const u32x2*)(p_FO + (size_t)mrow * DM) + lane;
            r3[q] = p_ss3[mrow]; r2[q] = ((const float*)(ws + WS_RS2))[mrow];
#pragma unroll
            for (int j = 0; j < 4; ++j) { hw[q][j] = hr[64 * j]; fw[q][j] = fr_[64 * j]; } }
#pragma unroll
        for (int q = 0; q < 4; ++q) { if (base + q * NGW < NTOK) { const int mrow = base + q * NGW; const float rstd3 = 1.f / sqrtf(r3[q] * (1.f / DM) + RMS_EPS);
            f32x4* orow = (f32x4*)(p_out + (size_t)mrow * DM) + lane;
#pragma unroll
            for (int j = 0; j < 4; ++j) { const f32x4 g = *((const f32x4*)p_post_ffn_gain + lane + 64 * j); const float hs = 1.f / r2[q]; f32x4 o; o[0] = bf_lo(hw[q][j].x) * hs; o[1] = bf_hi(hw[q][j].x) * hs; o[2] = bf_lo(hw[q][j].y) * hs; o[3] = bf_hi(hw[q][j].y) * hs;
                o[0] += bf_lo(fw[q][j].x) * rstd3 * g[0]; o[1] += bf_hi(fw[q][j].x) * rstd3 * g[1]; o[2] += bf_lo(fw[q][j].y) * rstd3 * g[2]; o[3] += bf_hi(fw[q][j].y) * rstd3 * g[3];
                orow[64 * j] = o; } } }
    }
    }
#if PROBE_PHASE == 9
    for (int i9 = 0; i9 < 10; ++i9) grid.sync();
#endif
#if PROBE_PHASE == 8
    xcd_barrier(xbar);
    PROBE_DELAY(8);
#endif
#endif
}


extern "C" void kernel_launch(void* const* d_in, const int* in_sizes, int n_in, void* d_out, int out_size, void* d_ws, size_t ws_size, hipStream_t stream) {
    static int grid_blocks = 0;
    if (grid_blocks == 0) {
        if (n_in != 19 || out_size != NTOK * DM || ws_size < WS_END) { fprintf(stderr, "kernel_launch: unexpected shapes (n_in %d, out %d, ws %zu)\n", n_in, out_size, ws_size); grid_blocks = -1; return; }
        int dev = 0, cus = 0, per_cu = 0;
        hipGetDevice(&dev);
        hipDeviceGetAttribute(&cus, hipDeviceAttributeMultiprocessorCount, dev);
        hipFuncSetAttribute((const void*)fwd_megakernel, hipFuncAttributeMaxDynamicSharedMemorySize, LDS_BYTES);
        hipOccupancyMaxActiveBlocksPerMultiprocessor(&per_cu, (const void*)fwd_megakernel, 512, LDS_BYTES);
        if (per_cu < 1) { fprintf(stderr, "kernel_launch: occupancy query says %d blocks per CU\n", per_cu); per_cu = 1; }
        if (per_cu > 1) per_cu = 1;
        grid_blocks = cus * per_cu;
    }
    if (grid_blocks < 0) return;
    if (hipMemsetAsync((unsigned char*)d_ws + WS_BAR, 0, XCD_BAR_WORDS * 4, stream) != hipSuccess) { fprintf(stderr, "kernel_launch: memset of the barrier words failed\n"); return; }
    Args a{};
    for (int i = 0; i < 19; ++i) a.in[i] = (const float*)d_in[i];
    a.out = (float*)d_out; a.ws = (unsigned char*)d_ws;
    void* args[] = {&a};
    hipError_t e = hipLaunchCooperativeKernel((const void*)fwd_megakernel, dim3(grid_blocks), dim3(512), args, LDS_BYTES, stream);
    if (e != hipSuccess) fprintf(stderr, "cooperative launch failed: %s (grid %d)\n", hipGetErrorString(e), grid_blocks);
}
```

```cpp
#include <hip/hip_runtime.h>
#include <hip/hip_cooperative_groups.h>
#include <cstdio>
#include <cstdint>
namespace cg = cooperative_groups;

constexpr size_t MiB = 1u << 20;
constexpr size_t WS_RSX = 256 * 1024, WS_RS2 = 384 * 1024;
constexpr size_t WS_SS1 = 0, WS_SS3 = 128 * 1024, WS_ROPE = 1 * MiB, WS_KAM = 2 * MiB, WS_VAM = WS_KAM + 32 * 1024, WS_KBM = WS_KAM + 64 * 1024, WS_VBM = WS_KAM + 192 * 1024;
constexpr size_t WS_WIN = 4 * MiB, WS_WCAT = 17 * MiB, WS_WOUT = 21 * MiB, WS_WFFI = 23 * MiB, WS_WFFO = 34 * MiB;
constexpr size_t WS_U = 48 * MiB, WS_QO = 112 * MiB, WS_KA = 240 * MiB, WS_VA = 256 * MiB, WS_KB = 272 * MiB, WS_VB = 336 * MiB, WS_MERGED = 400 * MiB;
constexpr size_t WS_Y = 272 * MiB, WS_F = 112 * MiB, WS_FO = 48 * MiB  , WS_H1 = 400 * MiB  , WS_END = 464 * MiB;

namespace pg8 {
#define PG8_LAS __attribute__((address_space(3)))
typedef unsigned short bf16_t;
typedef short bf16x8 __attribute__((ext_vector_type(8)));
typedef float f32x4 __attribute__((ext_vector_type(4)));
typedef unsigned u32x4 __attribute__((ext_vector_type(4)));
constexpr int BM = 256, BK = 64, HALF = 128, HTB = HALF * BK * 2  , STAGE_BYTES = 8 * HTB, NXCD = 8, WGM = 4;

__host__ __device__ __forceinline__ int lds_byte(int r, int c) { const int st = (r >> 4) * 2 + (c >> 5), rr = r & 15, cc = c & 31, ob = rr * 64 + cc * 2; return st * 1024 + (ob ^ (((ob >> 9) & 1) << 5)); }
__host__ __device__ __forceinline__ void stage_rc(int b, int& R, int& C) { const int st = b / 1024, sb = b % 1024, swz = sb ^ (((sb >> 9) & 1) << 5); R = (st >> 1) * 16 + swz / 64; C = (st & 1) * 32 + (swz % 64) / 2; }
__host__ __device__ __forceinline__ int perm32(int rho) { const int n = rho >> 4, i = rho & 15; return 8 * (i >> 2) + 4 * n + (i & 3); }

struct Unit { int pm, pn; };
struct Gemm { const bf16_t* A; const bf16_t* Bt; int M, N, K; };

struct StaticOrder {
    int nM, nN, nwg, G, c, wgm;
    __host__ __device__ void init(int M, int N, int G_, int c_, int wgm_ = WGM) { nM = M / BM; nN = N / BM; nwg = nM * nN; G = G_; c = c_; wgm = wgm_; }
    __host__ __device__ bool next(int i, Unit& u) const {
        const long L = (long)i * G + c; if (L >= nwg) return false;
        int wgid = (int)L; { const int q = nwg / NXCD, r = nwg % NXCD, xcd = wgid % NXCD, off = wgid / NXCD; wgid = (xcd < r ? xcd * (q + 1) : r * (q + 1) + (xcd - r) * q) + off; }
        const int nig = wgm * nN, gid = wgid / nig, fm = gid * wgm, gsz = (nM - fm) < wgm ? (nM - fm) : wgm;
        u.pm = fm + ((wgid % nig) % gsz); u.pn = (wgid % nig) / gsz; return true;
    }
    __device__ __forceinline__ void a_ready(const Unit&) const {}
    __device__ __forceinline__ void done(const Unit&) const {}
};


typedef float f32x2_t __attribute__((ext_vector_type(2))); typedef __bf16 bf16x2_t __attribute__((ext_vector_type(2)));
__device__ __forceinline__ unsigned cvtpk(float lo, float hi) { f32x2_t v = {lo, hi}; bf16x2_t b = __builtin_convertvector(v, bf16x2_t); return __builtin_bit_cast(unsigned, b); }
__device__ __forceinline__ float bf_lo(unsigned w) { return __uint_as_float(w << 16); }
__device__ __forceinline__ float bf_hi(unsigned w) { return __uint_as_float(w & 0xffff0000u); }
constexpr float QK_C2 = 0.125f * 1.4426950408889634f;

struct EpiInProj {
    static constexpr bool PERM = true, AFTER_DRAIN = false, HAS_MID = false;
    unsigned char* ws; bf16_t* G; const float* bgate;
    __device__ __forceinline__ void mid(f32x4 (&)[2][2][4][2], const Unit&, int, int, int, int) const {}
    __device__ __forceinline__ void operator()(const f32x4 (&acc)[2][2][4][2], const Unit& u, int wr, int wc, int fr, int fq) const {
        const int pn = u.pn, row0 = u.pm * BM + wr * 64 + fr, cl = wc * 32 + 8 * fq;
        bf16_t* dst; int ldc, cb, mode; float sc0 = 1.f;
        const float* rope = (const float*)(ws + WS_ROPE);
        if (pn < 4)       { dst = (bf16_t*)(ws + WS_QO);        ldc = 2048; cb = pn * 256;        mode = 1; sc0 = QK_C2; }
        else if (pn == 4) { dst = (bf16_t*)(ws + WS_KA);        ldc = 256;  cb = 0;               mode = 1; }
        else if (pn == 5) { dst = (bf16_t*)(ws + WS_VA);        ldc = 256;  cb = 0;               mode = 0; }
        else if (pn < 10) { dst = (bf16_t*)(ws + WS_QO) + 1024; ldc = 2048; cb = (pn - 6) * 256;  mode = 1; sc0 = QK_C2; }
        else if (pn < 14) { dst = (bf16_t*)(ws + WS_KB);        ldc = 1024; cb = (pn - 10) * 256; mode = 1; }
        else if (pn < 18) { dst = (bf16_t*)(ws + WS_VB);        ldc = 1024; cb = (pn - 14) * 256; mode = 0; }
        else              { dst = G;                            ldc = 2048; cb = (pn - 18) * 256; mode = 2; }
        if (mode == 1) {
            const int i0 = 16 * (wc & 1) + 4 * fq;
#pragma unroll
            for (int ai = 0; ai < 2; ++ai)
#pragma unroll
                for (int m = 0; m < 4; ++m) {
                    const int row = row0 + ai * HALF + m * 16, pos = 16 + (row & 2047);
                    const f32x4 c0 = *(const f32x4*)(rope + (size_t)(pos * 32 + i0) * 2), c1 = *(const f32x4*)(rope + (size_t)(pos * 32 + i0 + 2) * 2);
                    const float sc = sc0;
#pragma unroll
                    for (int bj = 0; bj < 2; ++bj) {
                        const f32x4 v0 = acc[ai][bj][m][0], v1 = acc[ai][bj][m][1]; u32x4 w;
                        w.x = cvtpk((v0[0] * c0[0] - v0[1] * c0[1]) * sc, (v0[1] * c0[0] + v0[0] * c0[1]) * sc);
                        w.y = cvtpk((v0[2] * c0[2] - v0[3] * c0[3]) * sc, (v0[3] * c0[2] + v0[2] * c0[3]) * sc);
                        w.z = cvtpk((v1[0] * c1[0] - v1[1] * c1[1]) * sc, (v1[1] * c1[0] + v1[0] * c1[1]) * sc);
                        w.w = cvtpk((v1[2] * c1[2] - v1[3] * c1[3]) * sc, (v1[3] * c1[2] + v1[2] * c1[3]) * sc);
                        *(u32x4*)(dst + (size_t)row * ldc + cb + bj * HALF + cl) = w;
                    }
                }
        } else if (mode == 0) {
#pragma unroll
            for (int ai = 0; ai < 2; ++ai)
#pragma unroll
                for (int m = 0; m < 4; ++m) {
                    const int row = row0 + ai * HALF + m * 16;
#pragma unroll
                    for (int bj = 0; bj < 2; ++bj) {
                        const f32x4 v0 = acc[ai][bj][m][0], v1 = acc[ai][bj][m][1]; u32x4 w;
                        w.x = cvtpk(v0[0], v0[1]); w.y = cvtpk(v0[2], v0[3]); w.z = cvtpk(v1[0], v1[1]); w.w = cvtpk(v1[2], v1[3]);
                        *(u32x4*)(dst + (size_t)row * ldc + cb + bj * HALF + cl) = w;
                    }
                }
        } else {
            f32x4 bv[2][2];
#pragma unroll
            for (int bj = 0; bj < 2; ++bj)
#pragma unroll
                for (int n = 0; n < 2; ++n) bv[bj][n] = *(const f32x4*)(bgate + cb + bj * HALF + cl + 4 * n);
#pragma unroll
            for (int ai = 0; ai < 2; ++ai)
#pragma unroll
                for (int m = 0; m < 4; ++m) {
                    const int row = row0 + ai * HALF + m * 16;
#pragma unroll
                    for (int bj = 0; bj < 2; ++bj) {
                        const f32x4 v0 = acc[ai][bj][m][0] + bv[bj][0], v1 = acc[ai][bj][m][1] + bv[bj][1]; float s[8];
#pragma unroll
                        for (int e = 0; e < 4; ++e) { s[e] = __builtin_amdgcn_rcpf(1.f + __expf(-v0[e])); s[4 + e] = __builtin_amdgcn_rcpf(1.f + __expf(-v1[e])); }
                        u32x4 w; w.x = cvtpk(s[0], s[1]); w.y = cvtpk(s[2], s[3]); w.z = cvtpk(s[4], s[5]); w.w = cvtpk(s[6], s[7]);
                        *(u32x4*)(dst + (size_t)row * ldc + cb + bj * HALF + cl) = w;
                    }
                }
        }
    }
};

struct EpiMerge {
    static constexpr bool PERM = true, AFTER_DRAIN = false, HAS_MID = true;
    const bf16_t* G; bf16_t* out;
    __device__ __forceinline__ void mid(f32x4 (&acc)[2][2][4][2], const Unit& u, int wr, int wc, int fr, int fq) const {
        int row0 = u.pm * BM + wr * 64 + fr, col0 = u.pn * BM + wc * 32 + 8 * fq;
        asm volatile("" : "+v"(row0), "+v"(col0));
#pragma unroll
        for (int ai = 0; ai < 2; ++ai)
#pragma unroll
            for (int m = 0; m < 4; ++m) {
                const bf16_t* gp = G + (size_t)(row0 + ai * HALF + m * 16) * 2048 + col0;
#pragma unroll
                for (int bj = 0; bj < 2; ++bj) {
                    const u32x4 a = *(const u32x4*)(gp + bj * HALF), d = *(const u32x4*)(gp + 1024 + bj * HALF);
                    f32x4 r0, r1;
                    r0[0] = bf_lo(a.x) * __builtin_amdgcn_rcpf(fmaxf(bf_lo(d.x), 1e-20f)); r0[1] = bf_hi(a.x) * __builtin_amdgcn_rcpf(fmaxf(bf_hi(d.x), 1e-20f));
                    r0[2] = bf_lo(a.y) * __builtin_amdgcn_rcpf(fmaxf(bf_lo(d.y), 1e-20f)); r0[3] = bf_hi(a.y) * __builtin_amdgcn_rcpf(fmaxf(bf_hi(d.y), 1e-20f));
                    r1[0] = bf_lo(a.z) * __builtin_amdgcn_rcpf(fmaxf(bf_lo(d.z), 1e-20f)); r1[1] = bf_hi(a.z) * __builtin_amdgcn_rcpf(fmaxf(bf_hi(d.z), 1e-20f));
                    r1[2] = bf_lo(a.w) * __builtin_amdgcn_rcpf(fmaxf(bf_lo(d.w), 1e-20f)); r1[3] = bf_hi(a.w) * __builtin_amdgcn_rcpf(fmaxf(bf_hi(d.w), 1e-20f));
                    acc[ai][bj][m][0] *= r0; acc[ai][bj][m][1] *= r1;
                }
                asm volatile("" ::: "memory");
            }
    }
    __device__ __forceinline__ void operator()(const f32x4 (&acc)[2][2][4][2], const Unit& u, int wr, int wc, int fr, int fq) const {
        const int row0 = u.pm * BM + wr * 64 + fr, col0 = u.pn * BM + wc * 32 + 8 * fq;
#pragma unroll
        for (int ai = 0; ai < 2; ++ai)
#pragma unroll
            for (int m = 0; m < 4; ++m) {
                const int row = row0 + ai * HALF + m * 16; const bf16_t* gp = G + (size_t)row * 2048 + 1024 + col0;
#pragma unroll
                for (int bj = 0; bj < 2; ++bj) {
                    const u32x4 d = *(const u32x4*)(gp + bj * HALF); const f32x4 v0 = acc[ai][bj][m][0], v1 = acc[ai][bj][m][1]; u32x4 w;
                    w.x = cvtpk(v0[0] * fmaxf(bf_lo(d.x), 1e-20f), v0[1] * fmaxf(bf_hi(d.x), 1e-20f)); w.y = cvtpk(v0[2] * fmaxf(bf_lo(d.y), 1e-20f), v0[3] * fmaxf(bf_hi(d.y), 1e-20f));
                    w.z = cvtpk(v1[0] * fmaxf(bf_lo(d.z), 1e-20f), v1[1] * fmaxf(bf_hi(d.z), 1e-20f)); w.w = cvtpk(v1[2] * fmaxf(bf_lo(d.w), 1e-20f), v1[3] * fmaxf(bf_hi(d.w), 1e-20f));
                    *(u32x4*)(out + (size_t)row * 1024 + col0 + bj * HALF) = w;
                }
                asm volatile("" ::: "memory");
            }
    }
};

struct EpiYSS {
    static constexpr bool PERM = true, AFTER_DRAIN = false, HAS_MID = false;
    bf16_t* Y; float* ss;
    __device__ __forceinline__ void mid(f32x4 (&)[2][2][4][2], const Unit&, int, int, int, int) const {}
    __device__ __forceinline__ void operator()(const f32x4 (&acc)[2][2][4][2], const Unit& u, int wr, int wc, int fr, int fq) const {
        const int row0 = u.pm * BM + wr * 64 + fr, col0 = u.pn * BM + wc * 32 + 8 * fq;
#pragma unroll
        for (int ai = 0; ai < 2; ++ai)
#pragma unroll
            for (int m = 0; m < 4; ++m) {
                const int row = row0 + ai * HALF + m * 16; float s = 0.f;
#pragma unroll
                for (int bj = 0; bj < 2; ++bj) {
                    const f32x4 v0 = acc[ai][bj][m][0], v1 = acc[ai][bj][m][1]; u32x4 w;
                    s += (v0[0] * v0[0] + v0[1] * v0[1]) + (v0[2] * v0[2] + v0[3] * v0[3]) + (v1[0] * v1[0] + v1[1] * v1[1]) + (v1[2] * v1[2] + v1[3] * v1[3]);
                    w.x = cvtpk(v0[0], v0[1]); w.y = cvtpk(v0[2], v0[3]); w.z = cvtpk(v1[0], v1[1]); w.w = cvtpk(v1[2], v1[3]);
                    *(u32x4*)(Y + (size_t)row * 1024 + col0 + bj * HALF) = w;
                }
                s += __shfl_xor(s, 16); s += __shfl_xor(s, 32);
                if (fq == 0) atomicAdd(ss + row, s);
            }
    }
};

struct EpiSwiGLU {
    static constexpr bool PERM = true, AFTER_DRAIN = false, HAS_MID = false;
    bf16_t* F;
    __device__ __forceinline__ void mid(f32x4 (&)[2][2][4][2], const Unit&, int, int, int, int) const {}
    __device__ __forceinline__ void operator()(const f32x4 (&acc)[2][2][4][2], const Unit& u, int wr, int wc, int fr, int fq) const {
        const int row0 = u.pm * BM + wr * 64 + fr, col0 = u.pn * 128 + wc * 16 + 4 * fq;
#pragma unroll
        for (int ai = 0; ai < 2; ++ai)
#pragma unroll
            for (int m = 0; m < 4; ++m) {
                const int row = row0 + ai * HALF + m * 16;
#pragma unroll
                for (int bj = 0; bj < 2; ++bj) {
                    const f32x4 g = acc[ai][bj][m][0], up = acc[ai][bj][m][1]; float o[4];
#pragma unroll
                    for (int e = 0; e < 4; ++e) o[e] = g[e] * __builtin_amdgcn_rcpf(1.f + __expf(-g[e])) * up[e];
                    unsigned long long w = (unsigned long long)cvtpk(o[0], o[1]) | ((unsigned long long)cvtpk(o[2], o[3]) << 32);
                    *(unsigned long long*)(F + (size_t)row * 2816 + col0 + bj * 64) = w;
                }
            }
    }
};

template <class Epi, class Sched, bool ALIGN_EPI = false, bool SP2 = false>
__device__ __forceinline__ void gemm_phase(PG8_LAS unsigned char* lds, const Gemm g, const Sched& S, Epi& E) {
    int tid_ = threadIdx.x; asm volatile("" : "+v"(tid_));
    const int tid = tid_, wid = __builtin_amdgcn_readfirstlane(tid >> 6), lane = tid & 63, wr = wid >> 2, wc = wid & 3, fr = lane & 15, fq = lane >> 4;
    const int K = g.K, nt = K / BK;
    unsigned voffA[2], voffB[2];
#pragma unroll
    for (int i = 0; i < 2; ++i) { int R, C; stage_rc(tid * 16 + i * 8192, R, C); const int Rb = Epi::PERM ? ((R & ~31) + perm32(R & 31)) : R;
        voffA[i] = (unsigned)(R * K + C) * 2u; voffB[i] = (unsigned)(Rb * K + C) * 2u; }
    const size_t kstep = (size_t)(BK * 2);
    const size_t hstep = (size_t)HALF * K * 2;
    const size_t tstep = 2 * hstep;
    const unsigned ldsw = (unsigned)wid * 1024u;
    const int aoff = lds_byte(wr * 64 + fr, fq * 8), boff = lds_byte(wc * 32 + fr, fq * 8);
#define PG8_SA(b, h) (((b) * 2 + (h)) * HTB)
#define PG8_SB(b, h) ((4 + (b) * 2 + (h)) * HTB)
#define PG8_STAGE(bufoff, gbase, voff) do { _Pragma("unroll") for (int _i = 0; _i < 2; ++_i) \
        __builtin_amdgcn_global_load_lds((const unsigned*)((const char*)(gbase) + (voff)[_i]), (PG8_LAS unsigned*)(lds + (bufoff) + ldsw + _i * 8192), 16, 0, 0); } while (0)
#define PG8_LDA(dst, b, h) do { _Pragma("unroll") for (int m = 0; m < 4; ++m) _Pragma("unroll") for (int k = 0; k < 2; ++k) dst[m][k] = *(const PG8_LAS bf16x8*)(lds + PG8_SA(b, h) + aoff + m * 2048 + k * 1024); } while (0)
#define PG8_LDB(dst, b, h) do { _Pragma("unroll") for (int n = 0; n < 2; ++n) _Pragma("unroll") for (int k = 0; k < 2; ++k) dst[n][k] = *(const PG8_LAS bf16x8*)(lds + PG8_SB(b, h) + boff + n * 2048 + k * 1024); } while (0)
#define PG8_MMA(ai, bj, At, Bt) do { __builtin_amdgcn_s_setprio(1); _Pragma("unroll") for (int m = 0; m < 4; ++m) _Pragma("unroll") for (int n = 0; n < 2; ++n) _Pragma("unroll") for (int k = 0; k < 2; ++k) \
        acc[ai][bj][m][n] = __builtin_amdgcn_mfma_f32_16x16x32_bf16(Bt[n][k], At[m][k], acc[ai][bj][m][n], 0, 0, 0); __builtin_amdgcn_s_setprio(0); } while (0)
#define PG8_WAIT_V(n) asm volatile("s_waitcnt vmcnt(" #n ")" ::: "memory")
#define PG8_WAIT_L(n) asm volatile("s_waitcnt lgkmcnt(" #n ")" ::: "memory")
#define PG8_BAR __builtin_amdgcn_s_barrier()
#define PG8_SCHED __builtin_amdgcn_sched_barrier(0)
    Unit cur, nxt; int ui = 0;
    if (!S.next(0, cur)) return;
    f32x4 acc[2][2][4][2];
#pragma unroll
    for (int a = 0; a < 2; ++a)
#pragma unroll
        for (int b = 0; b < 2; ++b)
#pragma unroll
            for (int m = 0; m < 4; ++m)
#pragma unroll
                for (int n = 0; n < 2; ++n) acc[a][b][m][n] = (f32x4){0.f, 0.f, 0.f, 0.f};
    bf16x8 At[4][2], B0[2][2], B1[2][2];
    const char* cA = (const char*)g.A + (size_t)cur.pm * tstep; const char* cB = (const char*)g.Bt + (size_t)cur.pn * tstep;
    S.a_ready(cur);
    if constexpr (SP2) {
        PG8_STAGE(PG8_SB(0, 0), cB, voffB); PG8_STAGE(PG8_SB(0, 1), cB + hstep, voffB); PG8_STAGE(PG8_SA(0, 0), cA, voffA); PG8_STAGE(PG8_SA(0, 1), cA + hstep, voffA);
        if (wr == 1) PG8_BAR;
        PG8_WAIT_V(2); PG8_BAR;
        PG8_STAGE(PG8_SB(1, 0), cB + kstep, voffB); PG8_STAGE(PG8_SA(1, 0), cA + kstep, voffA); PG8_STAGE(PG8_SB(1, 1), cB + hstep + kstep, voffB);
        PG8_WAIT_V(6); PG8_BAR;
    } else {
        PG8_STAGE(PG8_SB(0, 0), cB, voffB); PG8_STAGE(PG8_SA(0, 0), cA, voffA); PG8_STAGE(PG8_SB(0, 1), cB + hstep, voffB); PG8_STAGE(PG8_SA(0, 1), cA + hstep, voffA);
        if (wr == 1) PG8_BAR;
        PG8_WAIT_V(4); PG8_BAR;
        PG8_STAGE(PG8_SB(1, 0), cB + kstep, voffB); PG8_STAGE(PG8_SA(1, 0), cA + kstep, voffA); PG8_STAGE(PG8_SB(1, 1), cB + hstep + kstep, voffB);
        PG8_WAIT_V(6); PG8_BAR;
    }
    for (;;) {
        const bool has_next = S.next(ui + 1, nxt);
        const char* nA = has_next ? (const char*)g.A + (size_t)nxt.pm * tstep : cA; const char* nB = has_next ? (const char*)g.Bt + (size_t)nxt.pn * tstep : cB;
        for (int t = 0; t < nt; t += 2) {
            if constexpr (Epi::HAS_MID) { if (t == (nt >> 1)) E.mid(acc, cur, wr, wc, fr, fq); }
            const bool last = (t == nt - 2);
            const char* a1 = cA + (size_t)(t + 1) * kstep;
            const char* a2 = last ? nA : cA + (size_t)(t + 2) * kstep; const char* b2 = last ? nB : cB + (size_t)(t + 2) * kstep;
            const char* a3 = a2 + kstep; const char* b3 = b2 + kstep;
            if (last && has_next) S.a_ready(nxt);
            if constexpr (SP2) {
            PG8_LDB(B0, 0, 0); PG8_LDB(B1, 0, 1); PG8_SCHED; PG8_LDA(At, 0, 0); PG8_STAGE(PG8_SA(1, 1), a1 + hstep, voffA);
            PG8_WAIT_V(8); PG8_WAIT_L(0); PG8_BAR; PG8_MMA(0, 0, At, B0); PG8_MMA(0, 1, At, B1); PG8_BAR; PG8_SCHED;
            PG8_LDA(At, 0, 1); PG8_STAGE(PG8_SB(0, 0), b2, voffB); PG8_STAGE(PG8_SB(0, 1), b2 + hstep, voffB); PG8_STAGE(PG8_SA(0, 0), a2, voffA);
            PG8_WAIT_V(8); PG8_WAIT_L(0); PG8_BAR; PG8_MMA(1, 0, At, B0); PG8_MMA(1, 1, At, B1); PG8_BAR; PG8_SCHED;
            PG8_LDB(B0, 1, 0); PG8_LDB(B1, 1, 1); PG8_SCHED; PG8_LDA(At, 1, 0); PG8_STAGE(PG8_SA(0, 1), a2 + hstep, voffA);
            PG8_WAIT_V(8); PG8_WAIT_L(0); PG8_BAR; PG8_MMA(0, 0, At, B0); PG8_MMA(0, 1, At, B1); PG8_BAR; PG8_SCHED;
            PG8_LDA(At, 1, 1); PG8_STAGE(PG8_SB(1, 0), b3, voffB); PG8_STAGE(PG8_SB(1, 1), b3 + hstep, voffB); PG8_STAGE(PG8_SA(1, 0), a3, voffA);
            PG8_WAIT_V(8); PG8_WAIT_L(0); PG8_BAR; PG8_MMA(1, 0, At, B0); PG8_MMA(1, 1, At, B1); PG8_BAR; PG8_SCHED;
            } else {
            PG8_LDB(B0, 0, 0); PG8_SCHED; PG8_LDA(At, 0, 0); PG8_STAGE(PG8_SA(1, 1), a1 + hstep, voffA);
            PG8_WAIT_L(8); PG8_BAR; PG8_WAIT_L(0); PG8_MMA(0, 0, At, B0); PG8_BAR; PG8_SCHED;
            PG8_LDB(B1, 0, 1); PG8_STAGE(PG8_SB(0, 0), b2, voffB);
            PG8_BAR; PG8_WAIT_L(0); PG8_MMA(0, 1, At, B1); PG8_BAR;
            PG8_LDA(At, 0, 1); PG8_STAGE(PG8_SA(0, 0), a2, voffA);
            PG8_BAR; PG8_WAIT_L(0); PG8_MMA(1, 0, At, B0); PG8_BAR; PG8_SCHED;
            PG8_STAGE(PG8_SB(0, 1), b2 + hstep, voffB);
            PG8_WAIT_V(6); PG8_BAR; PG8_MMA(1, 1, At, B1); PG8_BAR;
            PG8_LDB(B0, 1, 0); PG8_SCHED; PG8_LDA(At, 1, 0); PG8_STAGE(PG8_SA(0, 1), a2 + hstep, voffA);
            PG8_WAIT_L(8); PG8_BAR; PG8_WAIT_L(0); PG8_MMA(0, 0, At, B0); PG8_BAR; PG8_SCHED;
            PG8_LDB(B1, 1, 1); PG8_STAGE(PG8_SB(1, 0), b3, voffB);
            PG8_BAR; PG8_WAIT_L(0); PG8_MMA(0, 1, At, B1); PG8_BAR;
            PG8_LDA(At, 1, 1); PG8_STAGE(PG8_SA(1, 0), a3, voffA);
            PG8_BAR; PG8_WAIT_L(0); PG8_MMA(1, 0, At, B0); PG8_BAR; PG8_SCHED;
            PG8_STAGE(PG8_SB(1, 1), b3 + hstep, voffB);
            PG8_WAIT_V(6); PG8_BAR; PG8_MMA(1, 1, At, B1); PG8_BAR;
            }
        }
        if constexpr (ALIGN_EPI) { if (wr == 0) PG8_BAR; }
        if constexpr (!Epi::AFTER_DRAIN) { E(acc, cur, wr, wc, fr, fq); S.done(cur); }
        if (!has_next) break;
#pragma unroll
        for (int a = 0; a < 2; ++a)
#pragma unroll
            for (int b = 0; b < 2; ++b)
#pragma unroll
                for (int m = 0; m < 4; ++m)
#pragma unroll
                    for (int n = 0; n < 2; ++n) acc[a][b][m][n] = (f32x4){0.f, 0.f, 0.f, 0.f};
        cur = nxt; cA = nA; cB = nB; ++ui;
        if constexpr (ALIGN_EPI) { if (wr == 1) PG8_BAR; }
    }
    PG8_WAIT_V(0);
    if constexpr (!ALIGN_EPI) { if (wr == 0) PG8_BAR; }
    PG8_BAR;
    if constexpr (Epi::AFTER_DRAIN) { E.fused(acc, cur, wr, wc, fr, fq, lds, wid, lane); S.done(cur); }
#undef PG8_SA
#undef PG8_SB
#undef PG8_STAGE
#undef PG8_LDA
#undef PG8_LDB
#undef PG8_MMA
#undef PG8_WAIT_V
#undef PG8_WAIT_L
#undef PG8_BAR
#undef PG8_SCHED
}
}

namespace att {
#define LAS __attribute__((address_space(3)))
typedef unsigned short bf16_t;
typedef short bf16x8 __attribute__((ext_vector_type(8)));
typedef short s16x4 __attribute__((ext_vector_type(4)));
typedef short v4i16_t __attribute__((ext_vector_type(4)));
typedef float f32x16 __attribute__((ext_vector_type(16)));
typedef float f32x4 __attribute__((ext_vector_type(4)));
typedef unsigned u32x4 __attribute__((ext_vector_type(4)));
typedef unsigned u32x2 __attribute__((ext_vector_type(2)));
using pg8::cvtpk;
__device__ __forceinline__ s16x4 vtr(const LAS unsigned char* p) { return __builtin_bit_cast(s16x4, __builtin_amdgcn_ds_read_tr16_b64_v4i16((LAS v4i16_t*)p)); }
__device__ __forceinline__ int crow(int i, int h) { return (i & 3) + 8 * (i >> 2) + 4 * h; }
__device__ __forceinline__ float xhalf_max(float v) { auto rr = __builtin_amdgcn_permlane32_swap(__float_as_uint(v), __float_as_uint(v), false, false); return fmaxf(__uint_as_float(rr[0]), __uint_as_float(rr[1])); }
__device__ __forceinline__ float xhalf_sum(float v) { auto rr = __builtin_amdgcn_permlane32_swap(__float_as_uint(v), __float_as_uint(v), false, false); return __uint_as_float(rr[0]) + __uint_as_float(rr[1]); }
#define MFMA32(a, b, c) __builtin_amdgcn_mfma_f32_32x32x16_bf16((a), (b), (c), 0, 0, 0)
constexpr float NEGV = -1e30f;
constexpr int ATT_LDS_MAX = 2 * (64 * 272 + 64 * 320);

#ifndef ATT_PROBE
#define ATT_PROBE 0
#endif
#if ATT_PROBE
#define ATT_TS(k) do { if ((k) == ATT_PROBE - 1) att_t = __builtin_amdgcn_s_memrealtime(); if ((k) == ATT_PROBE) att_acc += __builtin_amdgcn_s_memrealtime() - att_t; } while (0)
#else
#define ATT_TS(k) do {} while (0)
#endif
template <int KW, int DV, bool SWA>
__device__ __forceinline__ void attn_unit(LAS unsigned char* lds, const int tid, const int wid, const int lane,
                                          bf16_t* Qw, const bf16_t* Kreal, const bf16_t* Kmeta, const int kpitch, const bf16_t* Vreal, const bf16_t* Vmeta, const int vpitch,
                                          const int t0, const int t1, const int qrel0, const float sink_l2, const float lam, const float* gain, bf16_t* Od, unsigned long long& att_acc) {
    unsigned long long att_t = 0; (void)att_t;
    constexpr int KP = KW * 2 + 16, VP = (DV == 64) ? 192 : 320, KBUF = 64 * KP, VBUF = 64 * VP;
    constexpr int NKC = KW / 64, NVC = DV / 64, KCPR = KW / 8, VCPR = DV / 8, NDB = DV / 32;
    constexpr float THR = 8.f;
    const int r = lane & 31, h = lane >> 5;
    bf16x8 qf[4];
#pragma unroll
    for (int st = 0; st < 4; ++st) qf[st] = *(const bf16x8*)(Qw + (size_t)r * 2048 + 16 * st + 8 * h);
    u32x4 kreg[1][NKC], vreg[1][NVC];
    const int krow_ = tid / KCPR, kcc_ = tid % KCPR, vrow_ = tid / VCPR, vcc_ = tid % VCPR;
#define ATT_LOAD(S, Ks, Vs) do { \
        _Pragma("unroll") for (int i_ = 0; i_ < NKC; ++i_) kreg[S][i_] = *(const u32x4*)((Ks) + (size_t)(krow_ + i_ * (512 / KCPR)) * kpitch + kcc_ * 8); \
        _Pragma("unroll") for (int i_ = 0; i_ < NVC; ++i_) vreg[S][i_] = *(const u32x4*)((Vs) + (size_t)(vrow_ + i_ * (512 / VCPR)) * vpitch + vcc_ * 8); } while (0)
#define ATT_STORE(S, buf) do { \
        _Pragma("unroll") for (int i_ = 0; i_ < NKC; ++i_) *(LAS u32x4*)(lds + (buf) * KBUF + (krow_ + i_ * (512 / KCPR)) * KP + kcc_ * 16) = kreg[S][i_]; \
        _Pragma("unroll") for (int i_ = 0; i_ < NVC; ++i_) *(LAS u32x4*)(lds + 2 * KBUF + (buf) * VBUF + (vrow_ + i_ * (512 / VCPR)) * VP + vcc_ * 16) = vreg[S][i_]; } while (0)
    const int nt = 1 + (t1 - t0);
    ATT_LOAD(0, Kmeta, Vmeta);
    ATT_STORE(0, 0);
    ATT_LOAD(0, Kreal + (size_t)t0 * 64 * kpitch, Vreal + (size_t)t0 * 64 * vpitch);
    __syncthreads();
    const int kcolw = SWA ? 0 : 64 * (wid >> 2);
    const int koff = r * KP + (kcolw + 8 * h) * 2;
    const int voff = (4 * h + ((lane & 15) >> 2)) * VP + (16 * ((lane >> 4) & 1) + 4 * (lane & 3)) * 2;
    f32x16 o[NDB];
    float mhat, l;
    f32x16 s0, s1;
    bf16x8 pf[4];
#define ATT_QK(buf, C0) do { const LAS unsigned char* kb_ = lds + (buf) * KBUF + koff; \
        __builtin_amdgcn_s_setprio(1); \
        _Pragma("unroll") for (int st = 0; st < 4; ++st) { \
            const bf16x8 a0_ = *(const LAS bf16x8*)(kb_ + st * 32), a1_ = *(const LAS bf16x8*)(kb_ + 32 * KP + st * 32); \
            if (st == 0) { s0 = MFMA32(a0_, qf[0], C0); s1 = MFMA32(a1_, qf[0], C0); } else { s0 = MFMA32(a0_, qf[st], s0); s1 = MFMA32(a1_, qf[st], s1); } } \
        __builtin_amdgcn_s_setprio(0); } while (0)
#define ATT_MAX(mx) do { float a_ = fmaxf(fmaxf(s0[0], s0[1]), s1[0]), b_ = fmaxf(fmaxf(s0[2], s0[3]), s1[1]); a_ = fmaxf(fmaxf(a_, s1[2]), s1[3]); \
        _Pragma("unroll") for (int i = 4; i < 16; i += 4) { a_ = fmaxf(fmaxf(a_, s0[i]), s0[i + 1]); b_ = fmaxf(fmaxf(b_, s0[i + 2]), s0[i + 3]); a_ = fmaxf(fmaxf(a_, s1[i]), s1[i + 1]); b_ = fmaxf(fmaxf(b_, s1[i + 2]), s1[i + 3]); } \
        mx = fmaxf(a_, b_); mx = xhalf_max(mx); } while (0)
#define ATT_EXP_PACK() do { float ra_ = 0.f, rb_ = 0.f; \
        _Pragma("unroll") for (int i = 0; i < 16; ++i) { s0[i] = __builtin_amdgcn_exp2f(s0[i]); s1[i] = __builtin_amdgcn_exp2f(s1[i]); ra_ += s0[i]; rb_ += s1[i]; } \
        l += ra_ + rb_; u32x4 w_; \
        w_.x = cvtpk(s0[0], s0[1]); w_.y = cvtpk(s0[2], s0[3]); w_.z = cvtpk(s0[4], s0[5]); w_.w = cvtpk(s0[6], s0[7]); pf[0] = __builtin_bit_cast(bf16x8, w_); \
        w_.x = cvtpk(s0[8], s0[9]); w_.y = cvtpk(s0[10], s0[11]); w_.z = cvtpk(s0[12], s0[13]); w_.w = cvtpk(s0[14], s0[15]); pf[1] = __builtin_bit_cast(bf16x8, w_); \
        w_.x = cvtpk(s1[0], s1[1]); w_.y = cvtpk(s1[2], s1[3]); w_.z = cvtpk(s1[4], s1[5]); w_.w = cvtpk(s1[6], s1[7]); pf[2] = __builtin_bit_cast(bf16x8, w_); \
        w_.x = cvtpk(s1[8], s1[9]); w_.y = cvtpk(s1[10], s1[11]); w_.z = cvtpk(s1[12], s1[13]); w_.w = cvtpk(s1[14], s1[15]); pf[3] = __builtin_bit_cast(bf16x8, w_); } while (0)
#define ATT_EXP_H(S, P0_, P1_) do { float ra_ = 0.f, rb_ = 0.f; \
        _Pragma("unroll") for (int i = 0; i < 16; i += 2) { S[i] = __builtin_amdgcn_exp2f(S[i]); S[i + 1] = __builtin_amdgcn_exp2f(S[i + 1]); ra_ += S[i]; rb_ += S[i + 1]; } \
        l += ra_ + rb_; u32x4 w_; \
        w_.x = cvtpk(S[0], S[1]); w_.y = cvtpk(S[2], S[3]); w_.z = cvtpk(S[4], S[5]); w_.w = cvtpk(S[6], S[7]); P0_ = __builtin_bit_cast(bf16x8, w_); \
        w_.x = cvtpk(S[8], S[9]); w_.y = cvtpk(S[10], S[11]); w_.z = cvtpk(S[12], S[13]); w_.w = cvtpk(S[14], S[15]); P1_ = __builtin_bit_cast(bf16x8, w_); } while (0)
    s16x4 vlo[2][NDB], vhi[2][NDB];
#define ATT_VRD(buf, ks, B) do { const LAS unsigned char* vb_ = lds + 2 * KBUF + (buf) * VBUF + voff; \
        _Pragma("unroll") for (int db = 0; db < NDB; ++db) { vlo[B][db] = vtr(vb_ + (16 * (ks)) * VP + db * 64); vhi[B][db] = vtr(vb_ + (16 * (ks) + 8) * VP + db * 64); } } while (0)
#define ATT_PV(buf, NKS) do { \
        __builtin_amdgcn_s_setprio(1); \
        _Pragma("unroll") for (int ks = 0; ks < (NKS); ++ks) { \
            if (ks + 1 < (NKS)) ATT_VRD(buf, ks + 1, (ks + 1) & 1); \
            _Pragma("unroll") for (int db = 0; db < NDB; ++db) { \
                const bf16x8 va_ = __builtin_shufflevector(vlo[ks & 1][db], vhi[ks & 1][db], 0, 1, 2, 3, 4, 5, 6, 7); \
                o[db] = MFMA32(va_, pf[ks], o[db]); } \
            __builtin_amdgcn_sched_barrier(0); } \
        __builtin_amdgcn_s_setprio(0); } while (0)
#define ATT_SMPV(buf) do { \
        ATT_EXP_H(s0, pf[0], pf[1]); \
        __builtin_amdgcn_sched_barrier(0); \
        ATT_VRD(buf, 1, 1); \
        _Pragma("unroll") for (int db = 0; db < NDB; ++db) { const bf16x8 va_ = __builtin_shufflevector(vlo[0][db], vhi[0][db], 0, 1, 2, 3, 4, 5, 6, 7); o[db] = MFMA32(va_, pf[0], o[db]); } \
        ATT_VRD(buf, 2, 0); \
        _Pragma("unroll") for (int db = 0; db < NDB; ++db) { const bf16x8 va_ = __builtin_shufflevector(vlo[1][db], vhi[1][db], 0, 1, 2, 3, 4, 5, 6, 7); o[db] = MFMA32(va_, pf[1], o[db]); } \
        ATT_EXP_H(s1, pf[2], pf[3]); \
        _Pragma("unroll") for (int g_ = 0; g_ < 2 * NDB; ++g_) { __builtin_amdgcn_sched_group_barrier(0x008, 1, 0); __builtin_amdgcn_sched_group_barrier(0x100, 2, 0); __builtin_amdgcn_sched_group_barrier(0x002, 40 / (2 * NDB), 0); } \
        __builtin_amdgcn_sched_barrier(0); \
        ATT_VRD(buf, 3, 1); \
        _Pragma("unroll") for (int db = 0; db < NDB; ++db) { const bf16x8 va_ = __builtin_shufflevector(vlo[0][db], vhi[0][db], 0, 1, 2, 3, 4, 5, 6, 7); o[db] = MFMA32(va_, pf[2], o[db]); } \
        __builtin_amdgcn_sched_barrier(0); \
        _Pragma("unroll") for (int db = 0; db < NDB; ++db) { const bf16x8 va_ = __builtin_shufflevector(vlo[1][db], vhi[1][db], 0, 1, 2, 3, 4, 5, 6, 7); o[db] = MFMA32(va_, pf[3], o[db]); } \
        __builtin_amdgcn_sched_barrier(0); } while (0)
    f32x16 zero16;
#pragma unroll
    for (int i = 0; i < 16; ++i) zero16[i] = 0.f;
    {
        ATT_QK(0, zero16);
#pragma unroll
        for (int i = 0; i < 16; ++i) { if (i >= 8) s0[i] = NEGV; s1[i] = NEGV; }
        ATT_VRD(0, 0, 0);
        float mx; ATT_MAX(mx);
        mhat = mx; l = 0.f;
#pragma unroll
        for (int i = 0; i < 16; ++i) { s0[i] -= mx; s1[i] -= mx; }
        ATT_EXP_PACK();
#pragma unroll
        for (int db = 0; db < NDB; ++db) o[db] = zero16;
        ATT_PV(0, 1);
        ATT_STORE(0, 1);
        if (2 < nt) ATT_LOAD(0, Kreal + (size_t)(t0 + 1) * 64 * kpitch, Vreal + (size_t)(t0 + 1) * 64 * vpitch);
        __syncthreads();
    }
#define ATT_TILE(it, PAR) do { \
          \
        bool skip_ = false, edge_ = false; \
        if (SWA) { const int k0_ = (t0 + (it) - 1) * 64; skip_ = (k0_ > qrel0 + 31 + 128) || (k0_ + 63 < qrel0 - 128); edge_ = !((k0_ >= qrel0 + 31 - 128) && (k0_ + 63 <= qrel0 + 128)); } \
        if (!skip_) { f32x16 negm_; _Pragma("unroll") for (int i = 0; i < 16; ++i) negm_[i] = -mhat; \
            ATT_QK(PAR, negm_); } \
        if ((it) + 1 < nt) ATT_STORE(0, (PAR) ^ 1);                       \
        if ((it) + 2 < nt) ATT_LOAD(0, Kreal + (size_t)(t0 + (it) + 1) * 64 * kpitch, Vreal + (size_t)(t0 + (it) + 1) * 64 * vpitch);     \
        if (!skip_) { \
            ATT_VRD(PAR, 0, 0);                                           \
            if (SWA && edge_) { const int d0_ = (t0 + (it) - 1) * 64 - (qrel0 + r); \
                _Pragma("unroll") for (int i = 0; i < 16; ++i) { const int d_ = d0_ + crow(i, h); if (d_ < -128 || d_ > 128) s0[i] = NEGV; if (d_ + 32 < -128 || d_ + 32 > 128) s1[i] = NEGV; } } \
            float mx_; ATT_MAX(mx_); \
            if (__builtin_expect(__any(mx_ > THR), 0)) { const float dl_ = fmaxf(mx_, 0.f); mhat += dl_; \
                _Pragma("unroll") for (int i = 0; i < 16; ++i) { s0[i] -= dl_; s1[i] -= dl_; } \
                const float f_ = __builtin_amdgcn_exp2f(-dl_); l *= f_; \
                _Pragma("unroll") for (int db = 0; db < NDB; ++db) _Pragma("unroll") for (int i = 0; i < 16; ++i) o[db][i] *= f_; } \
            ATT_SMPV(PAR); } \
        __syncthreads(); } while (0)
    for (int it = 1; it < nt; it += 2) { ATT_TILE(it, 1); ATT_TILE(it + 1, 0); }
#undef ATT_TILE
#undef ATT_QK
#undef ATT_MAX
#undef ATT_EXP_PACK
#undef ATT_PV
#undef ATT_SMPV
#undef ATT_EXP_H
#undef ATT_VRD
#undef ATT_LOAD
#undef ATT_STORE
    const float m = mhat;
    l = xhalf_sum(l);
    if constexpr (SWA) {
        l += __builtin_amdgcn_exp2f(sink_l2 - m);
        const float inv = 1.f / l;
#pragma unroll
        for (int db = 0; db < NDB; ++db)
#pragma unroll
            for (int g4 = 0; g4 < 4; ++g4) {
                u32x2 w; w.x = cvtpk(o[db][4 * g4] * inv, o[db][4 * g4 + 1] * inv); w.y = cvtpk(o[db][4 * g4 + 2] * inv, o[db][4 * g4 + 3] * inv);
                *(u32x2*)(Qw + (size_t)r * 2048 + 32 * db + 8 * g4 + 4 * h) = w;
            }
    } else {
        const float inv = 1.f / l;
        LAS float* xb = (LAS float*)lds;
        if (wid >= 4) {
            const float sc = lam * inv;
#pragma unroll
            for (int db = 0; db < NDB; ++db)
#pragma unroll
                for (int i = 0; i < 16; ++i) xb[((wid - 4) * 128 + 32 * db + crow(i, h)) * 32 + r] = o[db][i] * sc;
        }
        __syncthreads();
        if (wid < 4) {
            float ss = 0.f;
#pragma unroll
            for (int db = 0; db < NDB; ++db)
#pragma unroll
                for (int i = 0; i < 16; ++i) { const float v = o[db][i] * inv - xb[(wid * 128 + 32 * db + crow(i, h)) * 32 + r]; o[db][i] = v; ss += v * v; }
            ss = xhalf_sum(ss);
            const float rstd = 0.8f / sqrtf(ss * (1.f / 128.f) + 1e-6f);
#pragma unroll
            for (int db = 0; db < NDB; ++db)
#pragma unroll
                for (int g4 = 0; g4 < 4; ++g4) {
                    const int d = 32 * db + 8 * g4 + 4 * h; const f32x4 gg = *(const f32x4*)(gain + d);
                    u32x2 w; w.x = cvtpk(o[db][4 * g4] * rstd * gg[0], o[db][4 * g4 + 1] * rstd * gg[1]); w.y = cvtpk(o[db][4 * g4 + 2] * rstd * gg[2], o[db][4 * g4 + 3] * rstd * gg[3]);
                    *(u32x2*)(Od + (size_t)r * 2048 + d) = w;
                }
        }
        __syncthreads();
    }
}
constexpr int SW_KP = 144, SW_VP = 192, SW_KT = 64 * SW_KP, SW_VT = 64 * SW_VP, SW_VOFF = 7 * SW_KT, SW_LDS = 7 * (SW_KT + SW_VT);
__device__ __forceinline__ void swa_unit(LAS unsigned char* lds, const int tid, const int wid, const int lane, bf16_t* QOrow  ,
                                         const bf16_t* Kreal, const bf16_t* Kmeta, const bf16_t* Vreal, const bf16_t* Vmeta, const int t0, const int ntr, const int qblk0, const float* sink4) {
    constexpr float THR = 8.f;
    const int r = lane & 31, h = lane >> 5;
    {
        u32x4 kr[7], vr[7];
        const int row = tid >> 3, cc = tid & 7;
#pragma unroll
        for (int j = 0; j < 7; ++j) if (j <= ntr) {
            const bf16_t* ks = (j == 0) ? Kmeta : Kreal + (size_t)(t0 + j - 1) * 64 * 256; const bf16_t* vs = (j == 0) ? Vmeta : Vreal + (size_t)(t0 + j - 1) * 64 * 256;
            kr[j] = *(const u32x4*)(ks + (size_t)row * 256 + cc * 8); vr[j] = *(const u32x4*)(vs + (size_t)row * 256 + cc * 8); }
#pragma unroll
        for (int j = 0; j < 7; ++j) if (j <= ntr) {
            *(LAS u32x4*)(lds + j * SW_KT + row * SW_KP + cc * 16) = kr[j]; *(LAS u32x4*)(lds + SW_VOFF + j * SW_VT + row * SW_VP + cc * 16) = vr[j]; }
    }
    __syncthreads();
    const int koff = r * SW_KP + (8 * h) * 2;
    const int voff = (4 * h + ((lane & 15) >> 2)) * SW_VP + (16 * ((lane >> 4) & 1) + 4 * (lane & 3)) * 2;
    f32x16 zero16;
#pragma unroll
    for (int i = 0; i < 16; ++i) zero16[i] = 0.f;
    const int qrel0 = qblk0 + 32 * (wid & 3);
#pragma unroll 1
    for (int pass = 0; pass < 2; ++pass) {
        const int hd = 2 * pass + (wid >> 2);
        bf16_t* Qw = QOrow + (size_t)(32 * (wid & 3)) * 2048 + hd * 64;
        bf16x8 qf[4];
#pragma unroll
        for (int st = 0; st < 4; ++st) qf[st] = *(const bf16x8*)(Qw + (size_t)r * 2048 + 16 * st + 8 * h);
        const float sink_l2 = sink4[hd] * 1.4426950408889634f;
        f32x16 o[2], s0, s1; bf16x8 pf[4]; float mhat, l = 0.f;
#define SW_QK(j, C0) do { const LAS unsigned char* kb_ = lds + (j) * SW_KT + koff; \
        _Pragma("unroll") for (int st = 0; st < 4; ++st) { \
            const bf16x8 a0_ = *(const LAS bf16x8*)(kb_ + st * 32), a1_ = *(const LAS bf16x8*)(kb_ + 32 * SW_KP + st * 32); \
            if (st == 0) { s0 = MFMA32(a0_, qf[0], C0); s1 = MFMA32(a1_, qf[0], C0); } else { s0 = MFMA32(a0_, qf[st], s0); s1 = MFMA32(a1_, qf[st], s1); } } } while (0)
#define SW_MAX(mx) do { float a_ = fmaxf(fmaxf(s0[0], s0[1]), s1[0]), b_ = fmaxf(fmaxf(s0[2], s0[3]), s1[1]); a_ = fmaxf(fmaxf(a_, s1[2]), s1[3]); \
        _Pragma("unroll") for (int i = 4; i < 16; i += 4) { a_ = fmaxf(fmaxf(a_, s0[i]), s0[i + 1]); b_ = fmaxf(fmaxf(b_, s0[i + 2]), s0[i + 3]); a_ = fmaxf(fmaxf(a_, s1[i]), s1[i + 1]); b_ = fmaxf(fmaxf(b_, s1[i + 2]), s1[i + 3]); } \
        mx = xhalf_max(fmaxf(a_, b_)); } while (0)
#define SW_EXP_H(S, P0_, P1_) do { float ra_ = 0.f, rb_ = 0.f; \
        _Pragma("unroll") for (int i = 0; i < 16; i += 2) { S[i] = __builtin_amdgcn_exp2f(S[i]); S[i + 1] = __builtin_amdgcn_exp2f(S[i + 1]); ra_ += S[i]; rb_ += S[i + 1]; } \
        l += ra_ + rb_; u32x4 w_; \
        w_.x = cvtpk(S[0], S[1]); w_.y = cvtpk(S[2], S[3]); w_.z = cvtpk(S[4], S[5]); w_.w = cvtpk(S[6], S[7]); P0_ = __builtin_bit_cast(bf16x8, w_); \
        w_.x = cvtpk(S[8], S[9]); w_.y = cvtpk(S[10], S[11]); w_.z = cvtpk(S[12], S[13]); w_.w = cvtpk(S[14], S[15]); P1_ = __builtin_bit_cast(bf16x8, w_); } while (0)
#define SW_PV(j, NKS) do { const LAS unsigned char* vb_ = lds + SW_VOFF + (j) * SW_VT + voff; \
        _Pragma("unroll") for (int ks = 0; ks < (NKS); ++ks) \
            _Pragma("unroll") for (int db = 0; db < 2; ++db) { \
                const s16x4 lo_ = vtr(vb_ + (16 * ks) * SW_VP + db * 64), hi_ = vtr(vb_ + (16 * ks + 8) * SW_VP + db * 64); \
                const bf16x8 va_ = __builtin_shufflevector(lo_, hi_, 0, 1, 2, 3, 4, 5, 6, 7); \
                o[db] = MFMA32(va_, pf[ks], o[db]); } } while (0)
        {
            SW_QK(0, zero16);
#pragma unroll
            for (int i = 0; i < 16; ++i) { if (i >= 8) s0[i] = NEGV; s1[i] = NEGV; }
            float mx; SW_MAX(mx);
            mhat = mx;
#pragma unroll
            for (int i = 0; i < 16; ++i) s0[i] -= mx;
            SW_EXP_H(s0, pf[0], pf[1]);
            o[0] = zero16; o[1] = zero16;
            SW_PV(0, 1);
        }
#pragma unroll 1
        for (int j = 1; j <= ntr; ++j) {
            const int k0 = (t0 + j - 1) * 64;
            if ((k0 > qrel0 + 31 + 128) || (k0 + 63 < qrel0 - 128)) continue;
            const bool edge = !((k0 >= qrel0 + 31 - 128) && (k0 + 63 <= qrel0 + 128));
            f32x16 negm_;
#pragma unroll
            for (int i = 0; i < 16; ++i) negm_[i] = -mhat;
            SW_QK(j, negm_);
            if (edge) { const int d0_ = k0 - (qrel0 + r);
#pragma unroll
                for (int i = 0; i < 16; ++i) { const int d_ = d0_ + crow(i, h); if (d_ < -128 || d_ > 128) s0[i] = NEGV; if (d_ + 32 < -128 || d_ + 32 > 128) s1[i] = NEGV; } }
            float mx_; SW_MAX(mx_);
            if (__builtin_expect(__any(mx_ > THR), 0)) { const float dl_ = fmaxf(mx_, 0.f); mhat += dl_;
#pragma unroll
                for (int i = 0; i < 16; ++i) { s0[i] -= dl_; s1[i] -= dl_; }
                const float f_ = __builtin_amdgcn_exp2f(-dl_); l *= f_;
#pragma unroll
                for (int db = 0; db < 2; ++db)
#pragma unroll
                    for (int i = 0; i < 16; ++i) o[db][i] *= f_; }
            SW_EXP_H(s0, pf[0], pf[1]); SW_EXP_H(s1, pf[2], pf[3]);
            SW_PV(j, 4);
        }
#undef SW_QK
#undef SW_MAX
#undef SW_EXP_H
#undef SW_PV
        l = xhalf_sum(l);
        l += __builtin_amdgcn_exp2f(sink_l2 - mhat);
        const float inv = 1.f / l;
#pragma unroll
        for (int db = 0; db < 2; ++db)
#pragma unroll
            for (int g4 = 0; g4 < 4; ++g4) {
                u32x2 w; w.x = cvtpk(o[db][4 * g4] * inv, o[db][4 * g4 + 1] * inv); w.y = cvtpk(o[db][4 * g4 + 2] * inv, o[db][4 * g4 + 3] * inv);
                *(u32x2*)(Qw + (size_t)r * 2048 + 32 * db + 8 * g4 + 4 * h) = w;
            }
    }
    __syncthreads();
}
}

typedef unsigned short bf16;
typedef float f32x4 __attribute__((ext_vector_type(4)));
typedef unsigned u32x4 __attribute__((ext_vector_type(4)));
typedef unsigned u32x2 __attribute__((ext_vector_type(2)));
using pg8::cvtpk; using pg8::bf_lo; using pg8::bf_hi;
constexpr int NTOK = 32768, DM = 1024, NIN = 6656, DFF = 2816, SEQL = 2048;
constexpr float RMS_EPS = 1e-6f;
constexpr int LDS_MAIN = 151552, LDS_BYTES = LDS_MAIN + 256;
static_assert(att::ATT_LDS_MAX <= LDS_MAIN && att::SW_LDS <= LDS_MAIN && pg8::STAGE_BYTES <= LDS_MAIN, "LDS map");

__device__ __forceinline__ float wave_sum(float v) {
#pragma unroll
    for (int o = 1; o < 64; o <<= 1) v += __shfl_xor(v, o);
    return v;
}
template <int MODE> __device__ __forceinline__ int rowmap(int n) {
    if (MODE == 1) {
        const bool perm = (n < 1280) || (n >= 1536 && n < 3584);
        if (!perm) return n;
        const int d = n & 63; return (n & ~63) + ((d < 32) ? 2 * d : 2 * (d - 32) + 1);
    } else if (MODE == 2) {
        if (n < DFF) return 8 * (n >> 2) + (n & 3);
        const int j = n - DFF; return 8 * (j >> 2) + 4 + (j & 3);
    }
    return n;
}
template <int MODE> __device__ __forceinline__ void p0_transpose_item(const float* W, int N, bf16* WT, int ldk, int koff, LAS float* scr, int item, int lane, const float* kscale = nullptr) {
    const int nblk = N / 32, kb = item / nblk, nb = item % nblk, k0 = 64 * kb, n0 = 32 * nb;
#pragma unroll 8
    for (int i = 0; i < 32; ++i) { const int kk = 2 * i + (lane >> 5); scr[kk * 33 + (lane & 31)] = __builtin_nontemporal_load(&W[(size_t)(k0 + kk) * N + n0 + (lane & 31)]); }
    asm volatile("s_waitcnt lgkmcnt(0)" ::: "memory");
    const int c = lane & 7;
    f32x4 ks0 = {1.f, 1.f, 1.f, 1.f}, ks1 = {1.f, 1.f, 1.f, 1.f};
    if (kscale) { ks0 = *(const f32x4*)(kscale + k0 + 8 * c); ks1 = *(const f32x4*)(kscale + k0 + 8 * c + 4); }
#pragma unroll
    for (int j = 0; j < 4; ++j) { const int n = (lane >> 3) + 8 * j; const LAS float* s = scr + (8 * c) * 33 + n;
        u32x4 o; o.x = cvtpk(s[0 * 33] * ks0[0], s[1 * 33] * ks0[1]); o.y = cvtpk(s[2 * 33] * ks0[2], s[3 * 33] * ks0[3]); o.z = cvtpk(s[4 * 33] * ks1[0], s[5 * 33] * ks1[1]); o.w = cvtpk(s[6 * 33] * ks1[2], s[7 * 33] * ks1[3]);
        *(u32x4*)(WT + (size_t)rowmap<MODE>(n0 + n) * ldk + koff + k0 + 8 * c) = o; }
    asm volatile("s_waitcnt lgkmcnt(0)" ::: "memory");
}

#define XB_TMO      128
#define XB_XCNT(j)  (256  + 64 * (j))
#define XB_XSUB(j)  (1280 + 64 * (j))
#define XB_XGEN(j)  (2304 + 64 * (j))
#define XB_TOP      3328
#define XB_TOPGEN   3392
#define XCD_BAR_WORDS 3456
#define XB_SPIN_CAP (1u << 18)

__device__ __forceinline__ unsigned xb_ld(unsigned* p)              { return __hip_atomic_load(p, __ATOMIC_RELAXED, __HIP_MEMORY_SCOPE_AGENT); }
__device__ __forceinline__ unsigned xb_add(unsigned* p, unsigned v) { return __hip_atomic_fetch_add(p, v, __ATOMIC_RELAXED, __HIP_MEMORY_SCOPE_AGENT); }
__device__ __forceinline__ unsigned xb_xcc_id() { return (unsigned)__builtin_amdgcn_s_getreg((3 << 11) | 20) & 0xFu; }
#define XB_SPIN(cond, bar) do { unsigned _sp = 0; while (cond) { __builtin_amdgcn_s_sleep(1); \
    if ((++_sp & 255u) == 0u) { if (xb_ld(&(bar)[XB_TMO])) break; if (_sp > XB_SPIN_CAP) { atomicAdd(&(bar)[XB_TMO], 1u); break; } } } } while (0)

struct XcdBarrier {
    unsigned* bar; unsigned x;
    volatile LAS unsigned* st;
};

__device__ __forceinline__ XcdBarrier xcd_barrier_post(unsigned* bar, volatile LAS unsigned* st) {
    XcdBarrier b; b.bar = bar; b.x = xb_xcc_id(); b.st = st;
    if (threadIdx.x == 0) (void)xb_add(&bar[XB_XCNT(b.x)], 1u);
    return b;
}
__device__ __forceinline__ void xcd_barrier_complete(unsigned* bar, unsigned x, unsigned& nloc, unsigned& nx) {
    const unsigned G = gridDim.x * gridDim.y * gridDim.z;
    unsigned sum, cnt, mine, sp = 0u;
    for (;;) {
        sum = 0u; cnt = 0u; mine = 0u;
#pragma unroll
        for (unsigned j = 0; j < 16; ++j) { const unsigned c = xb_ld(&bar[XB_XCNT(j)]); sum += c; cnt += (c > 0u) ? 1u : 0u; mine = (j == x) ? c : mine; }
        if (sum == G) break;
        __builtin_amdgcn_s_sleep(1);
        if ((++sp & 255u) == 0u) { if (xb_ld(&bar[XB_TMO])) break; if (sp > XB_SPIN_CAP) { atomicAdd(&bar[XB_TMO], 1u); break; } }
    }
    nloc = mine > 0u ? mine : 1u; nx = cnt > 0u ? cnt : 1u;
}

__device__ __forceinline__ void xcd_barrier(const XcdBarrier& b) {
    asm volatile("s_waitcnt vmcnt(0)" ::: "memory");
    __syncthreads();
    if (threadIdx.x == 0) {
        unsigned* bar = b.bar;
        __builtin_amdgcn_s_waitcnt(0);
        unsigned nloc = b.st[0], nx = b.st[1];
        if (nloc == 0u) { xcd_barrier_complete(bar, b.x, nloc, nx); b.st[0] = nloc; b.st[1] = nx; }
        const unsigned old = xb_add(&bar[XB_XSUB(b.x)], 1u);
        const unsigned gen = old / nloc;
        if (old + 1u == (gen + 1u) * nloc) {
            __builtin_amdgcn_fence(__ATOMIC_RELEASE, "agent");
            asm volatile("s_waitcnt vmcnt(0)" ::: "memory");
            const unsigned og = xb_add(&bar[XB_TOP], 1u);
            const unsigned tg = og / nx;
            if (og + 1u == (tg + 1u) * nx) xb_add(&bar[XB_TOPGEN], 1u);
            else XB_SPIN(xb_ld(&bar[XB_TOPGEN]) == tg, bar);
            __builtin_amdgcn_fence(__ATOMIC_ACQUIRE, "agent");
            xb_add(&bar[XB_XGEN(b.x)], 1u);
            asm volatile("s_waitcnt vmcnt(0)" ::: "memory");
        } else {
            XB_SPIN(xb_ld(&bar[XB_XGEN(b.x)]) == gen, bar);
            __builtin_amdgcn_fence(__ATOMIC_ACQUIRE, "agent");
            asm volatile("s_waitcnt vmcnt(0)" ::: "memory");
        }
    }
    __syncthreads();
}

constexpr size_t WS_BAR = 512 * 1024;
#ifndef WGM_P1
#define WGM_P1 4
#endif
#ifndef WGM_P6
#define WGM_P6 4
#endif
#ifndef WGM_N1K
#define WGM_N1K 8
#endif
#ifndef PH_MASK
#define PH_MASK 0x1ff
#endif
#define PH_ON(k) ((PH_MASK >> (k)) & 1)
#ifndef PROBE_PHASE
#define PROBE_PHASE (-1)
#endif
#define PROBE_T0(k) do { if (PROBE_PHASE == (k) && threadIdx.x == 0) probe_t0 = __builtin_amdgcn_s_memrealtime(); } while (0)
#define PROBE_DELAY(k) do { if (PROBE_PHASE == (k)) { if (threadIdx.x == 0) { const unsigned long long t1_ = __builtin_amdgcn_s_memrealtime(), dt_ = t1_ - probe_t0; while (__builtin_amdgcn_s_memrealtime() - t1_ < dt_) __builtin_amdgcn_s_sleep(8); } __syncthreads(); } } while (0)
struct Args { const float* in[19]; float* out; unsigned char* ws; };

__global__ void __launch_bounds__(512, 2) fwd_megakernel(Args a) {
    extern __shared__ __attribute__((aligned(16))) unsigned char lds_raw[];
    cg::grid_group grid = cg::this_grid();
    LAS unsigned char* lds = (LAS unsigned char*)lds_raw;
    const int tid = threadIdx.x, lane = tid & 63, wid = __builtin_amdgcn_readfirstlane(tid >> 6);
    const int G = gridDim.x, bx = blockIdx.x;
    const int vcu = (G % 8 == 0) ? (bx % 8) * (G / 8) + bx / 8 : bx;
    const int gw = bx * 8 + wid, NGW = G * 8;
    unsigned char* ws = a.ws;
    unsigned long long probe_t0 = 0; (void)probe_t0;
    volatile LAS unsigned* xb_st = (volatile LAS unsigned*)(lds + LDS_MAIN);
    if (threadIdx.x < 2) xb_st[threadIdx.x] = 0u;
    __syncthreads();
    const XcdBarrier xbar = xcd_barrier_post((unsigned*)(ws + WS_BAR), xb_st);
#define p_x (a.in[0])
#define p_meta_tokens (a.in[1])
#define p_pre_mix_gain (a.in[2])
#define p_w_in (a.in[3])
#define p_b_gate (a.in[4])
#define p_attn_sink (a.in[5])
#define p_lq1 (a.in[6])
#define p_lk1 (a.in[7])
#define p_lq2 (a.in[8])
#define p_lk2 (a.in[9])
#define p_subln_gain (a.in[10])
#define p_w_bswa (a.in[11])
#define p_w_bdiff (a.in[12])
#define p_w_out (a.in[13])
#define p_post_mix_gain (a.in[14])
#define p_pre_ffn_gain (a.in[15])
#define p_w_ffn_in (a.in[16])
#define p_w_ffn_out (a.in[17])
#define p_post_ffn_gain (a.in[18])
#define p_ss1 ((float*)(ws + WS_SS1))
#define p_ss3 ((float*)(ws + WS_SS3))
#define p_rope ((float*)(ws + WS_ROPE))
#define p_KAm ((bf16*)(ws + WS_KAM))
#define p_VAm ((bf16*)(ws + WS_VAM))
#define p_KBm ((bf16*)(ws + WS_KBM))
#define p_VBm ((bf16*)(ws + WS_VBM))
#define p_Win_t ((bf16*)(ws + WS_WIN))
#define p_Wcat_t ((bf16*)(ws + WS_WCAT))
#define p_Wout_t ((bf16*)(ws + WS_WOUT))
#define p_Wffi_t ((bf16*)(ws + WS_WFFI))
#define p_Wffo_t ((bf16*)(ws + WS_WFFO))
#define p_U ((bf16*)(ws + WS_U))
#define p_QO ((bf16*)(ws + WS_QO))
#define p_KA ((bf16*)(ws + WS_KA))
#define p_VA ((bf16*)(ws + WS_VA))
#define p_KB ((bf16*)(ws + WS_KB))
#define p_VB ((bf16*)(ws + WS_VB))
#define p_MERGED ((bf16*)(ws + WS_MERGED))
#define p_Y ((bf16*)(ws + WS_Y))
#define p_F ((bf16*)(ws + WS_F))
#define p_FO ((bf16*)(ws + WS_FO))
#define p_H1 ((bf16*)(ws + WS_H1))
#define p_GATES ((bf16*)a.out)
#define p_out (a.out)

#if PH_ON(0)
    PROBE_T0(0);
    {
        int tid_o = threadIdx.x; asm volatile("" : "+v"(tid_o));
        const int tid = tid_o, lane = tid & 63, wid = __builtin_amdgcn_readfirstlane(tid >> 6), gw = bx * 8 + wid; (void)tid; (void)gw;
        for (int e = bx * 512 + tid; e < 65536; e += G * 512) p_ss1[e] = 0.f;
        for (int e = bx * 512 + tid; e < 2064 * 32; e += G * 512) {
            const int pos = e >> 5, i = e & 31; const float inv = powf(10000.f, -(float)i * (1.f / 32.f)); const float ang = (float)pos * inv;
            p_rope[2 * e] = cosf(ang); p_rope[2 * e + 1] = sinf(ang);
        }
        for (int base = gw; base < NTOK; base += 4 * NGW) {
            f32x4 v[4][4]; float sq[4];
#pragma unroll
            for (int q = 0; q < 4; ++q) { const int mrow = (base + q * NGW < NTOK) ? base + q * NGW : NTOK - 1; const f32x4* xr = (const f32x4*)(p_x + (size_t)mrow * DM) + lane;
#pragma unroll
                for (int j = 0; j < 4; ++j) v[q][j] = __builtin_nontemporal_load(&xr[64 * j]); }
#pragma unroll
            for (int q = 0; q < 4; ++q) { float s = 0.f;
#pragma unroll
                for (int j = 0; j < 4; ++j) s += (v[q][j][0] * v[q][j][0] + v[q][j][1] * v[q][j][1]) + (v[q][j][2] * v[q][j][2] + v[q][j][3] * v[q][j][3]);
                sq[q] = 1.f / sqrtf(wave_sum(s) * (1.f / DM) + RMS_EPS); }
#pragma unroll
            for (int q = 0; q < 4; ++q) { if (base + q * NGW < NTOK) { u32x2* o8 = (u32x2*)(p_U + (size_t)(base + q * NGW) * DM) + lane; if (lane == 0) ((float*)(ws + WS_RSX))[base + q * NGW] = sq[q];
#pragma unroll
                for (int j = 0; j < 4; ++j) { const float rstd = sq[q]; u32x2 w; w.x = cvtpk(v[q][j][0] * rstd, v[q][j][1] * rstd); w.y = cvtpk(v[q][j][2] * rstd, v[q][j][3] * rstd); o8[64 * j] = w; } } }
        }
        if (bx < 40) {
            const int item = bx;
            LAS float* um = (LAS float*)lds; LAS float* red = (LAS float*)(lds + 65536);
#pragma unroll
            for (int rr = 0; rr < 2; ++rr) {
                const int row = 2 * wid + rr; const float* xr = p_meta_tokens + row * DM; float v[16]; float s = 0.f;
#pragma unroll
                for (int j = 0; j < 16; ++j) { v[j] = xr[lane + 64 * j]; s += v[j] * v[j]; }
                s = wave_sum(s); const float rstd = 1.f / sqrtf(s * (1.f / DM) + RMS_EPS);
#pragma unroll
                for (int j = 0; j < 16; ++j) um[row * DM + lane + 64 * j] = v[j] * rstd * p_pre_mix_gain[lane + 64 * j];
            }
            __syncthreads();
            int c0, ldd, dcol; bf16* dst; bool dorope;
            if (item < 4)       { c0 = 1024 + 64 * item;        dst = p_KAm; ldd = 256;  dcol = 64 * item;        dorope = true; }
            else if (item < 8)  { c0 = 1280 + 64 * (item - 4);  dst = p_VAm; ldd = 256;  dcol = 64 * (item - 4);  dorope = false; }
            else if (item < 24) { c0 = 2560 + 64 * (item - 8);  dst = p_KBm; ldd = 1024; dcol = 64 * (item - 8);  dorope = true; }
            else                { c0 = 3584 + 64 * (item - 24); dst = p_VBm; ldd = 1024; dcol = 64 * (item - 24); dorope = false; }
#define FMAC(c_, a_, b_) asm("v_fmac_f32_e32 %0, %1, %2" : "+v"(c_) : "v"(a_), "v"(b_))
            float acc[16];
#pragma unroll
            for (int rI = 0; rI < 16; ++rI) acc[rI] = 0.f;
            const float* wp = p_w_in + (size_t)(128 * wid) * NIN + c0 + lane;
#pragma unroll 1
            for (int kc = 0; kc < 4; ++kc) {
                float wv[32];
#pragma unroll
                for (int e = 0; e < 32; ++e) wv[e] = wp[(size_t)(32 * kc + e) * NIN];
#pragma unroll
                for (int k4 = 0; k4 < 8; ++k4) {
                    asm volatile("" ::: "memory");
#pragma unroll
                    for (int rI = 0; rI < 16; ++rI) { const f32x4 uu = *(const LAS f32x4*)(um + rI * DM + 128 * wid + 32 * kc + 4 * k4); FMAC(acc[rI], uu[0], wv[4 * k4]); FMAC(acc[rI], uu[1], wv[4 * k4 + 1]); FMAC(acc[rI], uu[2], wv[4 * k4 + 2]); FMAC(acc[rI], uu[3], wv[4 * k4 + 3]); }
                }
            }
#pragma unroll
            for (int rI = 0; rI < 16; ++rI) red[(wid * 16 + rI) * 64 + lane] = acc[rI];
            __syncthreads();
            {
                const int rI = tid >> 5, i = tid & 31; float x1 = 0.f, x2 = 0.f;
#pragma unroll
                for (int w = 0; w < 8; ++w) { x1 += red[(w * 16 + rI) * 64 + i]; x2 += red[(w * 16 + rI) * 64 + i + 32]; }
                if (dorope) {
                    const float inv = powf(10000.f, -(float)i * (1.f / 32.f)); const float ang = (float)rI * inv; const float c = cosf(ang), s = sinf(ang);
                    *(unsigned*)(dst + rI * ldd + dcol + 2 * i) = cvtpk(x1 * c - x2 * s, x2 * c + x1 * s);
                } else {
                    dst[rI * ldd + dcol + i] = (bf16)(cvtpk(x1, 0.f) & 0xffffu); dst[rI * ldd + dcol + i + 32] = (bf16)(cvtpk(x2, 0.f) & 0xffffu);
                }
                for (int e = tid; e < 1536; e += 512) { const int rr = 16 + e / 32, cc = (e % 32) * 2; *(unsigned*)(dst + rr * ldd + dcol + cc) = 0u; }
            }
            __syncthreads();
        }
        {
            LAS float* scr = (LAS float*)(lds + wid * 16384);
            constexpr int I_IN = 16 * (NIN / 32), I_SQ = 16 * 32, I_FI = 16 * (2 * DFF / 32), I_FO = (DFF / 64) * 32;
            constexpr int NITEMS = I_IN + 3 * I_SQ + I_FI + I_FO;
            const bool skipw = (G > 80) && (bx < 40);
            const int wfirst = (G > 80) ? (bx - 40) * 8 + wid : gw, wstride = (G > 80) ? (G - 40) * 8 : NGW;
            if (!skipw) for (int it = wfirst; it < NITEMS; it += wstride) {
                int q = it;
                if (q < I_IN) { p0_transpose_item<1>(p_w_in, NIN, p_Win_t, DM, 0, scr, q, lane, p_pre_mix_gain); continue; } q -= I_IN;
                if (q < I_SQ) { p0_transpose_item<0>(p_w_bswa, DM, p_Wcat_t, 2048, 0, scr, q, lane); continue; } q -= I_SQ;
                if (q < I_SQ) { p0_transpose_item<0>(p_w_bdiff, DM, p_Wcat_t, 2048, 1024, scr, q, lane); continue; } q -= I_SQ;
                if (q < I_SQ) { p0_transpose_item<0>(p_w_out, DM, p_Wout_t, DM, 0, scr, q, lane); continue; } q -= I_SQ;
                if (q < I_FI) { p0_transpose_item<2>(p_w_ffn_in, 2 * DFF, p_Wffi_t, DM, 0, scr, q, lane, p_pre_ffn_gain); continue; } q -= I_FI;
                p0_transpose_item<0>(p_w_ffn_out, DM, p_Wffo_t, DFF, 0, scr, q, lane);
            }
        }
    }
    if (a.ws == nullptr) grid.sync();
    xcd_barrier(xbar);
    PROBE_DELAY(0);

#endif
#if PH_ON(1)
    PROBE_T0(1);
    {
        pg8::Gemm g{p_U, p_Win_t, NTOK, NIN, DM}; pg8::StaticOrder S; S.init(NTOK, NIN, G, bx, WGM_P1);
        pg8::EpiInProj E{ws, p_GATES, p_b_gate};
        pg8::gemm_phase<pg8::EpiInProj, pg8::StaticOrder, true, true>(lds, g, S, E);
    }
    xcd_barrier(xbar);
    PROBE_DELAY(1);

#endif
#if PH_ON(2)
    PROBE_T0(2);
    {
        int tid_o = threadIdx.x; asm volatile("" : "+v"(tid_o));
        const int tid = tid_o, lane = tid & 63, wid = __builtin_amdgcn_readfirstlane(tid >> 6);
        unsigned long long att_acc = 0, att_dummy = 0;
        float lam;
        { float p1 = p_lq1[lane] * p_lk1[lane], p2 = p_lq2[lane] * p_lk2[lane]; p1 = wave_sum(p1); p2 = wave_sum(p2); lam = expf(p1) - expf(p2) + 0.2f; }
        for (int uidx = vcu; uidx < 2048; uidx += G) {
            const int i = uidx & 15, hh = (uidx >> 4) & 7, b = uidx >> 7;
            const size_t qrow = (size_t)b * SEQL + i * 128 + 32 * (wid & 3);
            att::attn_unit<128, 128, false>(lds, tid, wid, lane, p_QO + qrow * 2048 + 1024 + hh * 128 + 64 * (wid >> 2),
                                            p_KB + (size_t)b * SEQL * 1024 + hh * 128, p_KBm + hh * 128, 1024, p_VB + (size_t)b * SEQL * 1024 + hh * 128, p_VBm + hh * 128, 1024,
                                            0, 32, 0, 0.f, lam, p_subln_gain, p_QO + qrow * 2048 + 1024 + hh * 128, att_acc);
        }
#if ATT_PROBE == 9
        const unsigned long long swa_t0 = __builtin_amdgcn_s_memrealtime();
#endif
        for (int uidx = vcu; uidx < 1024; uidx += G) {
            const int i = uidx & 15, gk = (uidx >> 4) & 3, b = uidx >> 6;
            const int t0 = (i >= 1) ? 2 * (i - 1) : 0, t1 = (2 * (i + 2) < 32) ? 2 * (i + 2) : 32;
            att::swa_unit(lds, tid, wid, lane, p_QO + ((size_t)b * SEQL + i * 128) * 2048 + gk * 256,
                          p_KA + (size_t)b * SEQL * 256 + gk * 64, p_KAm + gk * 64, p_VA + (size_t)b * SEQL * 256 + gk * 64, p_VAm + gk * 64, t0, t1 - t0, i * 128, p_attn_sink + gk * 4);
        }
#if ATT_PROBE == 9
        att_acc = __builtin_amdgcn_s_memrealtime() - swa_t0;
#endif
#if ATT_PROBE
        if (wid == 0) { const unsigned long long t1_ = __builtin_amdgcn_s_memrealtime(); while (__builtin_amdgcn_s_memrealtime() - t1_ < att_acc) __builtin_amdgcn_s_sleep(8); }
        __syncthreads();
#endif
    }
    xcd_barrier(xbar);
    PROBE_DELAY(2);

#endif
#if PH_ON(3)
    PROBE_T0(3);
    {
        pg8::Gemm g{p_QO, p_Wcat_t, NTOK, DM, 2048}; pg8::StaticOrder S; S.init(NTOK, DM, G, bx, WGM_N1K);
        pg8::EpiMerge E{p_GATES, p_MERGED};
        pg8::gemm_phase<pg8::EpiMerge, pg8::StaticOrder, true, true>(lds, g, S, E);
    }
    xcd_barrier(xbar);
    PROBE_DELAY(3);

#endif
#if PH_ON(4)
    PROBE_T0(4);
    {
        pg8::Gemm g{p_MERGED, p_Wout_t, NTOK, DM, DM}; pg8::StaticOrder S; S.init(NTOK, DM, G, bx, WGM_N1K);
        pg8::EpiYSS E{p_Y, p_ss1};
        pg8::gemm_phase<pg8::EpiYSS, pg8::StaticOrder, true, true>(lds, g, S, E);
    }
    xcd_barrier(xbar);
    PROBE_DELAY(4);

#endif
#if PH_ON(5)
    PROBE_T0(5);
    {
        int tid_o = threadIdx.x; asm volatile("" : "+v"(tid_o));
        const int tid = tid_o, lane = tid & 63, wid = __builtin_amdgcn_readfirstlane(tid >> 6), gw = bx * 8 + wid; (void)tid; (void)gw;
    for (int base = gw; base < NTOK; base += 4 * NGW) {
        f32x4 hv[4][4]; u32x2 yw[4][4]; u32x2 xw[4][4]; float r1[4], rx[4];
#pragma unroll
        for (int q = 0; q < 4; ++q) { const int mrow = (base + q * NGW < NTOK) ? base + q * NGW : NTOK - 1;
            const u32x2* xr = (const u32x2*)(p_U + (size_t)mrow * DM) + lane; const u32x2* yr = (const u32x2*)(p_Y + (size_t)mrow * DM) + lane;
            r1[q] = p_ss1[mrow]; rx[q] = ((const float*)(ws + WS_RSX))[mrow];
#pragma unroll
            for (int j = 0; j < 4; ++j) { xw[q][j] = xr[64 * j]; yw[q][j] = yr[64 * j]; } }
#pragma unroll
        for (int q = 0; q < 4; ++q) {
            const float rstd1 = 1.f / sqrtf(r1[q] * (1.f / DM) + RMS_EPS), xs = 1.f / rx[q]; float s2 = 0.f;
#pragma unroll
            for (int j = 0; j < 4; ++j) { const f32x4 g = *((const f32x4*)p_post_mix_gain + lane + 64 * j); f32x4 t; t[0] = bf_lo(xw[q][j].x) * xs; t[1] = bf_hi(xw[q][j].x) * xs; t[2] = bf_lo(xw[q][j].y) * xs; t[3] = bf_hi(xw[q][j].y) * xs;
                t[0] += bf_lo(yw[q][j].x) * rstd1 * g[0]; t[1] += bf_hi(yw[q][j].x) * rstd1 * g[1]; t[2] += bf_lo(yw[q][j].y) * rstd1 * g[2]; t[3] += bf_hi(yw[q][j].y) * rstd1 * g[3];
                hv[q][j] = t; s2 += (t[0] * t[0] + t[1] * t[1]) + (t[2] * t[2] + t[3] * t[3]); }
            r1[q] = 1.f / sqrtf(wave_sum(s2) * (1.f / DM) + RMS_EPS);
        }
#pragma unroll
        for (int q = 0; q < 4; ++q) { if (base + q * NGW < NTOK) { const int mrow = base + q * NGW; const float rstd2 = r1[q];
            u32x2* hrow = (u32x2*)(p_H1 + (size_t)mrow * DM) + lane; if (lane == 0) ((float*)(ws + WS_RS2))[mrow] = rstd2;
#pragma unroll
            for (int j = 0; j < 4; ++j) { u32x2 hw; hw.x = cvtpk(hv[q][j][0] * rstd2, hv[q][j][1] * rstd2); hw.y = cvtpk(hv[q][j][2] * rstd2, hv[q][j][3] * rstd2); hrow[64 * j] = hw; } } }
    }
    }
    xcd_barrier(xbar);
    PROBE_DELAY(5);

#endif
#if PH_ON(6)
    PROBE_T0(6);
    {
        pg8::Gemm g{p_H1, p_Wffi_t, NTOK, 2 * DFF, DM}; pg8::StaticOrder S; S.init(NTOK, 2 * DFF, G, bx, WGM_P6);
        pg8::EpiSwiGLU E{p_F};
        pg8::gemm_phase<pg8::EpiSwiGLU, pg8::StaticOrder, true, true>(lds, g, S, E);
    }
    xcd_barrier(xbar);
    PROBE_DELAY(6);

#endif
#if PH_ON(7)
    PROBE_T0(7);
    {
        pg8::Gemm g{p_F, p_Wffo_t, NTOK, DM, DFF}; pg8::StaticOrder S; S.init(NTOK, DM, G, bx, WGM_N1K);
        pg8::EpiYSS E{p_FO, p_ss3};
        pg8::gemm_phase<pg8::EpiYSS, pg8::StaticOrder, true, true>(lds, g, S, E);
    }
    xcd_barrier(xbar);
    PROBE_DELAY(7);

#endif
#if PH_ON(8)
    PROBE_T0(8);
    {
        int tid_o = threadIdx.x; asm volatile("" : "+v"(tid_o));
        const int tid = tid_o, lane = tid & 63, wid = __builtin_amdgcn_readfirstlane(tid >> 6), gw = bx * 8 + wid; (void)tid; (void)gw;
    for (int base = gw; base < NTOK; base += 4 * NGW) {
        u32x2 hw[4][4]; u32x2 fw[4][4]; float r3[4], r2[4];
#pragma unroll
        for (int q = 0; q < 4; ++q) { const int mrow = (base + q * NGW < NTOK) ? base + q * NGW : NTOK - 1;
            const u32x2* hr = (const u32x2*)(p_H1 + (size_t)mrow * DM) + lane; const u32x2* fr_ = (const u32x2*)(p_FO + (size_t)mrow * DM) + lane;
            r3[q] = p_ss3[mrow]; r2[q] = ((const float*)(ws + WS_RS2))[mrow];
#pragma unroll
            for (int j = 0; j < 4; ++j) { hw[q][j] = hr[64 * j]; fw[q][j] = fr_[64 * j]; } }
#pragma unroll
        for (int q = 0; q < 4; ++q) { if (base + q * NGW < NTOK) { const int mrow = base + q * NGW; const float rstd3 = 1.f / sqrtf(r3[q] * (1.f / DM) + RMS_EPS);
            f32x4* orow = (f32x4*)(p_out + (size_t)mrow * DM) + lane;
#pragma unroll
            for (int j = 0; j < 4; ++j) { const f32x4 g = *((const f32x4*)p_post_ffn_gain + lane + 64 * j); const float hs = 1.f / r2[q]; f32x4 o; o[0] = bf_lo(hw[q][j].x) * hs; o[1] = bf_hi(hw[q][j].x) * hs; o[2] = bf_lo(hw[q][j].y) * hs; o[3] = bf_hi(hw[q][j].y) * hs;
                o[0] += bf_lo(fw[q][j].x) * rstd3 * g[0]; o[1] += bf_hi(fw[q][j].x) * rstd3 * g[1]; o[2] += bf_lo(fw[q][j].y) * rstd3 * g[2]; o[3] += bf_hi(fw[q][j].y) * rstd3 * g[3];
                orow[64 * j] = o; } } }
    }
    }
#if PROBE_PHASE == 9
    for (int i9 = 0; i9 < 10; ++i9) grid.sync();
#endif
#if PROBE_PHASE == 8
    xcd_barrier(xbar);
    PROBE_DELAY(8);
#endif
#endif
}


extern "C" void kernel_launch(void* const* d_in, const int* in_sizes, int n_in, void* d_out, int out_size, void* d_ws, size_t ws_size, hipStream_t stream) {
    static int grid_blocks = 0;
    if (grid_blocks == 0) {
        if (n_in != 19 || out_size != NTOK * DM || ws_size < WS_END) { fprintf(stderr, "kernel_launch: unexpected shapes (n_in %d, out %d, ws %zu)\n", n_in, out_size, ws_size); grid_blocks = -1; return; }
        int dev = 0, cus = 0, per_cu = 0;
        hipGetDevice(&dev);
        hipDeviceGetAttribute(&cus, hipDeviceAttributeMultiprocessorCount, dev);
        hipFuncSetAttribute((const void*)fwd_megakernel, hipFuncAttributeMaxDynamicSharedMemorySize, LDS_BYTES);
        hipOccupancyMaxActiveBlocksPerMultiprocessor(&per_cu, (const void*)fwd_megakernel, 512, LDS_BYTES);
        if (per_cu < 1) { fprintf(stderr, "kernel_launch: occupancy query says %d blocks per CU\n", per_cu); per_cu = 1; }
        if (per_cu > 1) per_cu = 1;
        grid_blocks = cus * per_cu;
    }
    if (grid_blocks < 0) return;
    if (hipMemsetAsync((unsigned char*)d_ws + WS_BAR, 0, XCD_BAR_WORDS * 4, stream) != hipSuccess) { fprintf(stderr, "kernel_launch: memset of the barrier words failed\n"); return; }
    Args a{};
    for (int i = 0; i < 19; ++i) a.in[i] = (const float*)d_in[i];
    a.out = (float*)d_out; a.ws = (unsigned char*)d_ws;
    void* args[] = {&a};
    hipError_t e = hipLaunchCooperativeKernel((const void*)fwd_megakernel, dim3(grid_blocks), dim3(512), args, LDS_BYTES, stream);
    if (e != hipSuccess) fprintf(stderr, "cooperative launch failed: %s (grid %d)\n", hipGetErrorString(e), grid_blocks);
}
```

```cpp
#include <hip/hip_runtime.h>
#include <hip/hip_cooperative_groups.h>
#include <cstdio>
#include <cstdint>
namespace cg = cooperative_groups;

constexpr size_t MiB = 1u << 20;
constexpr size_t WS_RSX = 256 * 1024, WS_RS2 = 384 * 1024;
constexpr size_t WS_SS1 = 0, WS_SS3 = 128 * 1024, WS_ROPE = 1 * MiB, WS_KAM = 2 * MiB, WS_VAM = WS_KAM + 32 * 1024, WS_KBM = WS_KAM + 64 * 1024, WS_VBM = WS_KAM + 192 * 1024;
constexpr size_t WS_WIN = 4 * MiB, WS_WCAT = 17 * MiB, WS_WOUT = 21 * MiB, WS_WFFI = 23 * MiB, WS_WFFO = 34 * MiB;
constexpr size_t WS_U = 48 * MiB, WS_QO = 112 * MiB, WS_KA = 240 * MiB, WS_VA = 256 * MiB, WS_KB = 272 * MiB, WS_VB = 336 * MiB, WS_MERGED = 400 * MiB;
constexpr size_t WS_Y = 272 * MiB, WS_F = 112 * MiB, WS_FO = 48 * MiB  , WS_H1 = 400 * MiB  , WS_END = 464 * MiB;

namespace pg8 {
#define PG8_LAS __attribute__((address_space(3)))
typedef unsigned short bf16_t;
typedef short bf16x8 __attribute__((ext_vector_type(8)));
typedef float f32x4 __attribute__((ext_vector_type(4)));
typedef unsigned u32x4 __attribute__((ext_vector_type(4)));
constexpr int BM = 256, BK = 64, HALF = 128, HTB = HALF * BK * 2  , STAGE_BYTES = 8 * HTB, NXCD = 8, WGM = 4;

__host__ __device__ __forceinline__ int lds_byte(int r, int c) { const int st = (r >> 4) * 2 + (c >> 5), rr = r & 15, cc = c & 31, ob = rr * 64 + cc * 2; return st * 1024 + (ob ^ (((ob >> 9) & 1) << 5)); }
__host__ __device__ __forceinline__ void stage_rc(int b, int& R, int& C) { const int st = b / 1024, sb = b % 1024, swz = sb ^ (((sb >> 9) & 1) << 5); R = (st >> 1) * 16 + swz / 64; C = (st & 1) * 32 + (swz % 64) / 2; }
__host__ __device__ __forceinline__ int perm32(int rho) { const int n = rho >> 4, i = rho & 15; return 8 * (i >> 2) + 4 * n + (i & 3); }

struct Unit { int pm, pn; };
struct Gemm { const bf16_t* A; const bf16_t* Bt; int M, N, K; };

struct StaticOrder {
    int nM, nN, nwg, G, c, wgm;
    __host__ __device__ void init(int M, int N, int G_, int c_, int wgm_ = WGM) { nM = M / BM; nN = N / BM; nwg = nM * nN; G = G_; c = c_; wgm = wgm_; }
    __host__ __device__ bool next(int i, Unit& u) const {
        const long L = (long)i * G + c; if (L >= nwg) return false;
        int wgid = (int)L; { const int q = nwg / NXCD, r = nwg % NXCD, xcd = wgid % NXCD, off = wgid / NXCD; wgid = (xcd < r ? xcd * (q + 1) : r * (q + 1) + (xcd - r) * q) + off; }
        const int nig = wgm * nN, gid = wgid / nig, fm = gid * wgm, gsz = (nM - fm) < wgm ? (nM - fm) : wgm;
        u.pm = fm + ((wgid % nig) % gsz); u.pn = (wgid % nig) / gsz; return true;
    }
    __device__ __forceinline__ void a_ready(const Unit&) const {}
    __device__ __forceinline__ void done(const Unit&) const {}
};


typedef float f32x2_t __attribute__((ext_vector_type(2))); typedef __bf16 bf16x2_t __attribute__((ext_vector_type(2)));
__device__ __forceinline__ unsigned cvtpk(float lo, float hi) { f32x2_t v = {lo, hi}; bf16x2_t b = __builtin_convertvector(v, bf16x2_t); return __builtin_bit_cast(unsigned, b); }
__device__ __forceinline__ float bf_lo(unsigned w) { return __uint_as_float(w << 16); }
__device__ __forceinline__ float bf_hi(unsigned w) { return __uint_as_float(w & 0xffff0000u); }
constexpr float QK_C2 = 0.125f * 1.4426950408889634f;

struct EpiInProj {
    static constexpr bool PERM = true, AFTER_DRAIN = false, HAS_MID = false;
    unsigned char* ws; bf16_t* G; const float* bgate;
    __device__ __forceinline__ void mid(f32x4 (&)[2][2][4][2], const Unit&, int, int, int, int) const {}
    __device__ __forceinline__ void operator()(const f32x4 (&acc)[2][2][4][2], const Unit& u, int wr, int wc, int fr, int fq) const {
        const int pn = u.pn, row0 = u.pm * BM + wr * 64 + fr, cl = wc * 32 + 8 * fq;
        bf16_t* dst; int ldc, cb, mode; float sc0 = 1.f;
        const float* rope = (const float*)(ws + WS_ROPE);
        if (pn < 4)       { dst = (bf16_t*)(ws + WS_QO);        ldc = 2048; cb = pn * 256;        mode = 1; sc0 = QK_C2; }
        else if (pn == 4) { dst = (bf16_t*)(ws + WS_KA);        ldc = 256;  cb = 0;               mode = 1; }
        else if (pn == 5) { dst = (bf16_t*)(ws + WS_VA);        ldc = 256;  cb = 0;               mode = 0; }
        else if (pn < 10) { dst = (bf16_t*)(ws + WS_QO) + 1024; ldc = 2048; cb = (pn - 6) * 256;  mode = 1; sc0 = QK_C2; }
        else if (pn < 14) { dst = (bf16_t*)(ws + WS_KB);        ldc = 1024; cb = (pn - 10) * 256; mode = 1; }
        else if (pn < 18) { dst = (bf16_t*)(ws + WS_VB);        ldc = 1024; cb = (pn - 14) * 256; mode = 0; }
        else              { dst = G;                            ldc = 2048; cb = (pn - 18) * 256; mode = 2; }
        if (mode == 1) {
            const int i0 = 16 * (wc & 1) + 4 * fq;
#pragma unroll
            for (int ai = 0; ai < 2; ++ai)
#pragma unroll
                for (int m = 0; m < 4; ++m) {
                    const int row = row0 + ai * HALF + m * 16, pos = 16 + (row & 2047);
                    const f32x4 c0 = *(const f32x4*)(rope + (size_t)(pos * 32 + i0) * 2), c1 = *(const f32x4*)(rope + (size_t)(pos * 32 + i0 + 2) * 2);
                    const float sc = sc0;
#pragma unroll
                    for (int bj = 0; bj < 2; ++bj) {
                        const f32x4 v0 = acc[ai][bj][m][0], v1 = acc[ai][bj][m][1]; u32x4 w;
                        w.x = cvtpk((v0[0] * c0[0] - v0[1] * c0[1]) * sc, (v0[1] * c0[0] + v0[0] * c0[1]) * sc);
                        w.y = cvtpk((v0[2] * c0[2] - v0[3] * c0[3]) * sc, (v0[3] * c0[2] + v0[2] * c0[3]) * sc);
                        w.z = cvtpk((v1[0] * c1[0] - v1[1] * c1[1]) * sc, (v1[1] * c1[0] + v1[0] * c1[1]) * sc);
                        w.w = cvtpk((v1[2] * c1[2] - v1[3] * c1[3]) * sc, (v1[3] * c1[2] + v1[2] * c1[3]) * sc);
                        *(u32x4*)(dst + (size_t)row * ldc + cb + bj * HALF + cl) = w;
                    }
                }
        } else if (mode == 0) {
#pragma unroll
            for (int ai = 0; ai < 2; ++ai)
#pragma unroll
                for (int m = 0; m < 4; ++m) {
                    const int row = row0 + ai * HALF + m * 16;
#pragma unroll
                    for (int bj = 0; bj < 2; ++bj) {
                        const f32x4 v0 = acc[ai][bj][m][0], v1 = acc[ai][bj][m][1]; u32x4 w;
                        w.x = cvtpk(v0[0], v0[1]); w.y = cvtpk(v0[2], v0[3]); w.z = cvtpk(v1[0], v1[1]); w.w = cvtpk(v1[2], v1[3]);
                        *(u32x4*)(dst + (size_t)row * ldc + cb + bj * HALF + cl) = w;
                    }
                }
        } else {
            f32x4 bv[2][2];
#pragma unroll
            for (int bj = 0; bj < 2; ++bj)
#pragma unroll
                for (int n = 0; n < 2; ++n) bv[bj][n] = *(const f32x4*)(bgate + cb + bj * HALF + cl + 4 * n);
#pragma unroll
            for (int ai = 0; ai < 2; ++ai)
#pragma unroll
                for (int m = 0; m < 4; ++m) {
                    const int row = row0 + ai * HALF + m * 16;
#pragma unroll
                    for (int bj = 0; bj < 2; ++bj) {
                        const f32x4 v0 = acc[ai][bj][m][0] + bv[bj][0], v1 = acc[ai][bj][m][1] + bv[bj][1]; float s[8];
#pragma unroll
                        for (int e = 0; e < 4; ++e) { s[e] = __builtin_amdgcn_rcpf(1.f + __expf(-v0[e])); s[4 + e] = __builtin_amdgcn_rcpf(1.f + __expf(-v1[e])); }
                        u32x4 w; w.x = cvtpk(s[0], s[1]); w.y = cvtpk(s[2], s[3]); w.z = cvtpk(s[4], s[5]); w.w = cvtpk(s[6], s[7]);
                        *(u32x4*)(dst + (size_t)row * ldc + cb + bj * HALF + cl) = w;
                    }
                }
        }
    }
};

struct EpiMerge {
    static constexpr bool PERM = true, AFTER_DRAIN = false, HAS_MID = true;
    const bf16_t* G; bf16_t* out;
    __device__ __forceinline__ void mid(f32x4 (&acc)[2][2][4][2], const Unit& u, int wr, int wc, int fr, int fq) const {
        int row0 = u.pm * BM + wr * 64 + fr, col0 = u.pn * BM + wc * 32 + 8 * fq;
        asm volatile("" : "+v"(row0), "+v"(col0));
#pragma unroll
        for (int ai = 0; ai < 2; ++ai)
#pragma unroll
            for (int m = 0; m < 4; ++m) {
                const bf16_t* gp = G + (size_t)(row0 + ai * HALF + m * 16) * 2048 + col0;
#pragma unroll
                for (int bj = 0; bj < 2; ++bj) {
                    const u32x4 a = __builtin_nontemporal_load((const u32x4*)(gp + bj * HALF)), d = *(const u32x4*)(gp + 1024 + bj * HALF);
                    f32x4 r0, r1;
                    r0[0] = bf_lo(a.x) * __builtin_amdgcn_rcpf(fmaxf(bf_lo(d.x), 1e-20f)); r0[1] = bf_hi(a.x) * __builtin_amdgcn_rcpf(fmaxf(bf_hi(d.x), 1e-20f));
                    r0[2] = bf_lo(a.y) * __builtin_amdgcn_rcpf(fmaxf(bf_lo(d.y), 1e-20f)); r0[3] = bf_hi(a.y) * __builtin_amdgcn_rcpf(fmaxf(bf_hi(d.y), 1e-20f));
                    r1[0] = bf_lo(a.z) * __builtin_amdgcn_rcpf(fmaxf(bf_lo(d.z), 1e-20f)); r1[1] = bf_hi(a.z) * __builtin_amdgcn_rcpf(fmaxf(bf_hi(d.z), 1e-20f));
                    r1[2] = bf_lo(a.w) * __builtin_amdgcn_rcpf(fmaxf(bf_lo(d.w), 1e-20f)); r1[3] = bf_hi(a.w) * __builtin_amdgcn_rcpf(fmaxf(bf_hi(d.w), 1e-20f));
                    acc[ai][bj][m][0] *= r0; acc[ai][bj][m][1] *= r1;
                }
                asm volatile("" ::: "memory");
            }
    }
    __device__ __forceinline__ void operator()(const f32x4 (&acc)[2][2][4][2], const Unit& u, int wr, int wc, int fr, int fq) const {
        const int row0 = u.pm * BM + wr * 64 + fr, col0 = u.pn * BM + wc * 32 + 8 * fq;
#pragma unroll
        for (int ai = 0; ai < 2; ++ai)
#pragma unroll
            for (int m = 0; m < 4; ++m) {
                const int row = row0 + ai * HALF + m * 16; const bf16_t* gp = G + (size_t)row * 2048 + 1024 + col0;
#pragma unroll
                for (int bj = 0; bj < 2; ++bj) {
                    const u32x4 d = *(const u32x4*)(gp + bj * HALF); const f32x4 v0 = acc[ai][bj][m][0], v1 = acc[ai][bj][m][1]; u32x4 w;
                    w.x = cvtpk(v0[0] * fmaxf(bf_lo(d.x), 1e-20f), v0[1] * fmaxf(bf_hi(d.x), 1e-20f)); w.y = cvtpk(v0[2] * fmaxf(bf_lo(d.y), 1e-20f), v0[3] * fmaxf(bf_hi(d.y), 1e-20f));
                    w.z = cvtpk(v1[0] * fmaxf(bf_lo(d.z), 1e-20f), v1[1] * fmaxf(bf_hi(d.z), 1e-20f)); w.w = cvtpk(v1[2] * fmaxf(bf_lo(d.w), 1e-20f), v1[3] * fmaxf(bf_hi(d.w), 1e-20f));
                    *(u32x4*)(out + (size_t)row * 1024 + col0 + bj * HALF) = w;
                }
                asm volatile("" ::: "memory");
            }
    }
};

struct EpiYSS {
    static constexpr bool PERM = true, AFTER_DRAIN = false, HAS_MID = false;
    bf16_t* Y; float* ss;
    __device__ __forceinline__ void mid(f32x4 (&)[2][2][4][2], const Unit&, int, int, int, int) const {}
    __device__ __forceinline__ void operator()(const f32x4 (&acc)[2][2][4][2], const Unit& u, int wr, int wc, int fr, int fq) const {
        const int row0 = u.pm * BM + wr * 64 + fr, col0 = u.pn * BM + wc * 32 + 8 * fq;
#pragma unroll
        for (int ai = 0; ai < 2; ++ai)
#pragma unroll
            for (int m = 0; m < 4; ++m) {
                const int row = row0 + ai * HALF + m * 16; float s = 0.f;
#pragma unroll
                for (int bj = 0; bj < 2; ++bj) {
                    const f32x4 v0 = acc[ai][bj][m][0], v1 = acc[ai][bj][m][1]; u32x4 w;
                    s += (v0[0] * v0[0] + v0[1] * v0[1]) + (v0[2] * v0[2] + v0[3] * v0[3]) + (v1[0] * v1[0] + v1[1] * v1[1]) + (v1[2] * v1[2] + v1[3] * v1[3]);
                    w.x = cvtpk(v0[0], v0[1]); w.y = cvtpk(v0[2], v0[3]); w.z = cvtpk(v1[0], v1[1]); w.w = cvtpk(v1[2], v1[3]);
                    *(u32x4*)(Y + (size_t)row * 1024 + col0 + bj * HALF) = w;
                }
                s += __shfl_xor(s, 16); s += __shfl_xor(s, 32);
                if (fq == 0) atomicAdd(ss + row, s);
            }
    }
};

struct EpiSwiGLU {
    static constexpr bool PERM = true, AFTER_DRAIN = false, HAS_MID = false;
    bf16_t* F;
    __device__ __forceinline__ void mid(f32x4 (&)[2][2][4][2], const Unit&, int, int, int, int) const {}
    __device__ __forceinline__ void operator()(const f32x4 (&acc)[2][2][4][2], const Unit& u, int wr, int wc, int fr, int fq) const {
        const int row0 = u.pm * BM + wr * 64 + fr, col0 = u.pn * 128 + wc * 16 + 4 * fq;
#pragma unroll
        for (int ai = 0; ai < 2; ++ai)
#pragma unroll
            for (int m = 0; m < 4; ++m) {
                const int row = row0 + ai * HALF + m * 16;
#pragma unroll
                for (int bj = 0; bj < 2; ++bj) {
                    const f32x4 g = acc[ai][bj][m][0], up = acc[ai][bj][m][1]; float o[4];
#pragma unroll
                    for (int e = 0; e < 4; ++e) o[e] = g[e] * __builtin_amdgcn_rcpf(1.f + __expf(-g[e])) * up[e];
                    unsigned long long w = (unsigned long long)cvtpk(o[0], o[1]) | ((unsigned long long)cvtpk(o[2], o[3]) << 32);
                    *(unsigned long long*)(F + (size_t)row * 2816 + col0 + bj * 64) = w;
                }
            }
    }
};

template <class Epi, class Sched, bool ALIGN_EPI = false, bool SP2 = false>
__device__ __forceinline__ void gemm_phase(PG8_LAS unsigned char* lds, const Gemm g, const Sched& S, Epi& E) {
    int tid_ = threadIdx.x; asm volatile("" : "+v"(tid_));
    const int tid = tid_, wid = __builtin_amdgcn_readfirstlane(tid >> 6), lane = tid & 63, wr = wid >> 2, wc = wid & 3, fr = lane & 15, fq = lane >> 4;
    const int K = g.K, nt = K / BK;
    unsigned voffA[2], voffB[2];
#pragma unroll
    for (int i = 0; i < 2; ++i) { int R, C; stage_rc(tid * 16 + i * 8192, R, C); const int Rb = Epi::PERM ? ((R & ~31) + perm32(R & 31)) : R;
        voffA[i] = (unsigned)(R * K + C) * 2u; voffB[i] = (unsigned)(Rb * K + C) * 2u; }
    const size_t kstep = (size_t)(BK * 2);
    const size_t hstep = (size_t)HALF * K * 2;
    const size_t tstep = 2 * hstep;
    const unsigned ldsw = (unsigned)wid * 1024u;
    const int aoff = lds_byte(wr * 64 + fr, fq * 8), boff = lds_byte(wc * 32 + fr, fq * 8);
#define PG8_SA(b, h) (((b) * 2 + (h)) * HTB)
#define PG8_SB(b, h) ((4 + (b) * 2 + (h)) * HTB)
#define PG8_STAGE(bufoff, gbase, voff) do { _Pragma("unroll") for (int _i = 0; _i < 2; ++_i) \
        __builtin_amdgcn_global_load_lds((const unsigned*)((const char*)(gbase) + (voff)[_i]), (PG8_LAS unsigned*)(lds + (bufoff) + ldsw + _i * 8192), 16, 0, 0); } while (0)
#define PG8_LDA(dst, b, h) do { _Pragma("unroll") for (int m = 0; m < 4; ++m) _Pragma("unroll") for (int k = 0; k < 2; ++k) dst[m][k] = *(const PG8_LAS bf16x8*)(lds + PG8_SA(b, h) + aoff + m * 2048 + k * 1024); } while (0)
#define PG8_LDB(dst, b, h) do { _Pragma("unroll") for (int n = 0; n < 2; ++n) _Pragma("unroll") for (int k = 0; k < 2; ++k) dst[n][k] = *(const PG8_LAS bf16x8*)(lds + PG8_SB(b, h) + boff + n * 2048 + k * 1024); } while (0)
#define PG8_MMA(ai, bj, At, Bt) do { __builtin_amdgcn_s_setprio(1); _Pragma("unroll") for (int m = 0; m < 4; ++m) _Pragma("unroll") for (int n = 0; n < 2; ++n) _Pragma("unroll") for (int k = 0; k < 2; ++k) \
        acc[ai][bj][m][n] = __builtin_amdgcn_mfma_f32_16x16x32_bf16(Bt[n][k], At[m][k], acc[ai][bj][m][n], 0, 0, 0); __builtin_amdgcn_s_setprio(0); } while (0)
#define PG8_WAIT_V(n) asm volatile("s_waitcnt vmcnt(" #n ")" ::: "memory")
#define PG8_WAIT_L(n) asm volatile("s_waitcnt lgkmcnt(" #n ")" ::: "memory")
#define PG8_BAR __builtin_amdgcn_s_barrier()
#define PG8_SCHED __builtin_amdgcn_sched_barrier(0)
    Unit cur, nxt; int ui = 0;
    if (!S.next(0, cur)) return;
    f32x4 acc[2][2][4][2];
#pragma unroll
    for (int a = 0; a < 2; ++a)
#pragma unroll
        for (int b = 0; b < 2; ++b)
#pragma unroll
            for (int m = 0; m < 4; ++m)
#pragma unroll
                for (int n = 0; n < 2; ++n) acc[a][b][m][n] = (f32x4){0.f, 0.f, 0.f, 0.f};
    bf16x8 At[4][2], B0[2][2], B1[2][2];
    const char* cA = (const char*)g.A + (size_t)cur.pm * tstep; const char* cB = (const char*)g.Bt + (size_t)cur.pn * tstep;
    S.a_ready(cur);
    if constexpr (SP2) {
        PG8_STAGE(PG8_SB(0, 0), cB, voffB); PG8_STAGE(PG8_SB(0, 1), cB + hstep, voffB); PG8_STAGE(PG8_SA(0, 0), cA, voffA); PG8_STAGE(PG8_SA(0, 1), cA + hstep, voffA);
        if (wr == 1) PG8_BAR;
        PG8_WAIT_V(2); PG8_BAR;
        PG8_STAGE(PG8_SB(1, 0), cB + kstep, voffB); PG8_STAGE(PG8_SA(1, 0), cA + kstep, voffA); PG8_STAGE(PG8_SB(1, 1), cB + hstep + kstep, voffB);
        PG8_WAIT_V(6); PG8_BAR;
    } else {
        PG8_STAGE(PG8_SB(0, 0), cB, voffB); PG8_STAGE(PG8_SA(0, 0), cA, voffA); PG8_STAGE(PG8_SB(0, 1), cB + hstep, voffB); PG8_STAGE(PG8_SA(0, 1), cA + hstep, voffA);
        if (wr == 1) PG8_BAR;
        PG8_WAIT_V(4); PG8_BAR;
        PG8_STAGE(PG8_SB(1, 0), cB + kstep, voffB); PG8_STAGE(PG8_SA(1, 0), cA + kstep, voffA); PG8_STAGE(PG8_SB(1, 1), cB + hstep + kstep, voffB);
        PG8_WAIT_V(6); PG8_BAR;
    }
    for (;;) {
        const bool has_next = S.next(ui + 1, nxt);
        const char* nA = has_next ? (const char*)g.A + (size_t)nxt.pm * tstep : cA; const char* nB = has_next ? (const char*)g.Bt + (size_t)nxt.pn * tstep : cB;
        for (int t = 0; t < nt; t += 2) {
            if constexpr (Epi::HAS_MID) { if (t == (nt >> 1)) E.mid(acc, cur, wr, wc, fr, fq); }
            const bool last = (t == nt - 2);
            const char* a1 = cA + (size_t)(t + 1) * kstep;
            const char* a2 = last ? nA : cA + (size_t)(t + 2) * kstep; const char* b2 = last ? nB : cB + (size_t)(t + 2) * kstep;
            const char* a3 = a2 + kstep; const char* b3 = b2 + kstep;
            if (last && has_next) S.a_ready(nxt);
            if constexpr (SP2) {
            PG8_LDB(B0, 0, 0); PG8_LDB(B1, 0, 1); PG8_SCHED; PG8_LDA(At, 0, 0); PG8_STAGE(PG8_SA(1, 1), a1 + hstep, voffA);
            PG8_WAIT_V(8); PG8_WAIT_L(0); PG8_BAR; PG8_MMA(0, 0, At, B0); PG8_MMA(0, 1, At, B1); PG8_BAR; PG8_SCHED;
            PG8_LDA(At, 0, 1); PG8_STAGE(PG8_SB(0, 0), b2, voffB); PG8_STAGE(PG8_SB(0, 1), b2 + hstep, voffB); PG8_STAGE(PG8_SA(0, 0), a2, voffA);
            PG8_WAIT_V(8); PG8_WAIT_L(0); PG8_BAR; PG8_MMA(1, 0, At, B0); PG8_MMA(1, 1, At, B1); PG8_BAR; PG8_SCHED;
            PG8_LDB(B0, 1, 0); PG8_LDB(B1, 1, 1); PG8_SCHED; PG8_LDA(At, 1, 0); PG8_STAGE(PG8_SA(0, 1), a2 + hstep, voffA);
            PG8_WAIT_V(8); PG8_WAIT_L(0); PG8_BAR; PG8_MMA(0, 0, At, B0); PG8_MMA(0, 1, At, B1); PG8_BAR; PG8_SCHED;
            PG8_LDA(At, 1, 1); PG8_STAGE(PG8_SB(1, 0), b3, voffB); PG8_STAGE(PG8_SB(1, 1), b3 + hstep, voffB); PG8_STAGE(PG8_SA(1, 0), a3, voffA);
            PG8_WAIT_V(8); PG8_WAIT_L(0); PG8_BAR; PG8_MMA(1, 0, At, B0); PG8_MMA(1, 1, At, B1); PG8_BAR; PG8_SCHED;
            } else {
            PG8_LDB(B0, 0, 0); PG8_SCHED; PG8_LDA(At, 0, 0); PG8_STAGE(PG8_SA(1, 1), a1 + hstep, voffA);
            PG8_WAIT_L(8); PG8_BAR; PG8_WAIT_L(0); PG8_MMA(0, 0, At, B0); PG8_BAR; PG8_SCHED;
            PG8_LDB(B1, 0, 1); PG8_STAGE(PG8_SB(0, 0), b2, voffB);
            PG8_BAR; PG8_WAIT_L(0); PG8_MMA(0, 1, At, B1); PG8_BAR;
            PG8_LDA(At, 0, 1); PG8_STAGE(PG8_SA(0, 0), a2, voffA);
            PG8_BAR; PG8_WAIT_L(0); PG8_MMA(1, 0, At, B0); PG8_BAR; PG8_SCHED;
            PG8_STAGE(PG8_SB(0, 1), b2 + hstep, voffB);
            PG8_WAIT_V(6); PG8_BAR; PG8_MMA(1, 1, At, B1); PG8_BAR;
            PG8_LDB(B0, 1, 0); PG8_SCHED; PG8_LDA(At, 1, 0); PG8_STAGE(PG8_SA(0, 1), a2 + hstep, voffA);
            PG8_WAIT_L(8); PG8_BAR; PG8_WAIT_L(0); PG8_MMA(0, 0, At, B0); PG8_BAR; PG8_SCHED;
            PG8_LDB(B1, 1, 1); PG8_STAGE(PG8_SB(1, 0), b3, voffB);
            PG8_BAR; PG8_WAIT_L(0); PG8_MMA(0, 1, At, B1); PG8_BAR;
            PG8_LDA(At, 1, 1); PG8_STAGE(PG8_SA(1, 0), a3, voffA);
            PG8_BAR; PG8_WAIT_L(0); PG8_MMA(1, 0, At, B0); PG8_BAR; PG8_SCHED;
            PG8_STAGE(PG8_SB(1, 1), b3 + hstep, voffB);
            PG8_WAIT_V(6); PG8_BAR; PG8_MMA(1, 1, At, B1); PG8_BAR;
            }
        }
        if constexpr (ALIGN_EPI) { if (wr == 0) PG8_BAR; }
        if constexpr (!Epi::AFTER_DRAIN) { E(acc, cur, wr, wc, fr, fq); S.done(cur); }
        if (!has_next) break;
#pragma unroll
        for (int a = 0; a < 2; ++a)
#pragma unroll
            for (int b = 0; b < 2; ++b)
#pragma unroll
                for (int m = 0; m < 4; ++m)
#pragma unroll
                    for (int n = 0; n < 2; ++n) acc[a][b][m][n] = (f32x4){0.f, 0.f, 0.f, 0.f};
        cur = nxt; cA = nA; cB = nB; ++ui;
        if constexpr (ALIGN_EPI) { if (wr == 1) PG8_BAR; }
    }
    PG8_WAIT_V(0);
    if constexpr (!ALIGN_EPI) { if (wr == 0) PG8_BAR; }
    PG8_BAR;
    if constexpr (Epi::AFTER_DRAIN) { E.fused(acc, cur, wr, wc, fr, fq, lds, wid, lane); S.done(cur); }
#undef PG8_SA
#undef PG8_SB
#undef PG8_STAGE
#undef PG8_LDA
#undef PG8_LDB
#undef PG8_MMA
#undef PG8_WAIT_V
#undef PG8_WAIT_L
#undef PG8_BAR
#undef PG8_SCHED
}
}

namespace att {
#define LAS __attribute__((address_space(3)))
typedef unsigned short bf16_t;
typedef short bf16x8 __attribute__((ext_vector_type(8)));
typedef short s16x4 __attribute__((ext_vector_type(4)));
typedef short v4i16_t __attribute__((ext_vector_type(4)));
typedef float f32x16 __attribute__((ext_vector_type(16)));
typedef float f32x4 __attribute__((ext_vector_type(4)));
typedef unsigned u32x4 __attribute__((ext_vector_type(4)));
typedef unsigned u32x2 __attribute__((ext_vector_type(2)));
using pg8::cvtpk;
__device__ __forceinline__ s16x4 vtr(const LAS unsigned char* p) { return __builtin_bit_cast(s16x4, __builtin_amdgcn_ds_read_tr16_b64_v4i16((LAS v4i16_t*)p)); }
__device__ __forceinline__ int crow(int i, int h) { return (i & 3) + 8 * (i >> 2) + 4 * h; }
__device__ __forceinline__ float xhalf_max(float v) { auto rr = __builtin_amdgcn_permlane32_swap(__float_as_uint(v), __float_as_uint(v), false, false); return fmaxf(__uint_as_float(rr[0]), __uint_as_float(rr[1])); }
__device__ __forceinline__ float xhalf_sum(float v) { auto rr = __builtin_amdgcn_permlane32_swap(__float_as_uint(v), __float_as_uint(v), false, false); return __uint_as_float(rr[0]) + __uint_as_float(rr[1]); }
#define MFMA32(a, b, c) __builtin_amdgcn_mfma_f32_32x32x16_bf16((a), (b), (c), 0, 0, 0)
constexpr float NEGV = -1e30f;
constexpr int ATT_LDS_MAX = 2 * (64 * 272 + 64 * 320);

#ifndef ATT_PROBE
#define ATT_PROBE 0
#endif
#if ATT_PROBE
#define ATT_TS(k) do { if ((k) == ATT_PROBE - 1) att_t = __builtin_amdgcn_s_memrealtime(); if ((k) == ATT_PROBE) att_acc += __builtin_amdgcn_s_memrealtime() - att_t; } while (0)
#else
#define ATT_TS(k) do {} while (0)
#endif
template <int KW, int DV, bool SWA>
__device__ __forceinline__ void attn_unit(LAS unsigned char* lds, const int tid, const int wid, const int lane,
                                          bf16_t* Qw, const bf16_t* Kreal, const bf16_t* Kmeta, const int kpitch, const bf16_t* Vreal, const bf16_t* Vmeta, const int vpitch,
                                          const int t0, const int t1, const int qrel0, const float sink_l2, const float lam, const float* gain, bf16_t* Od, unsigned long long& att_acc) {
    unsigned long long att_t = 0; (void)att_t;
    constexpr int KP = KW * 2 + 16, VP = (DV == 64) ? 192 : 320, KBUF = 64 * KP, VBUF = 64 * VP;
    constexpr int NKC = KW / 64, NVC = DV / 64, KCPR = KW / 8, VCPR = DV / 8, NDB = DV / 32;
    constexpr float THR = 8.f;
    const int r = lane & 31, h = lane >> 5;
    bf16x8 qf[4];
#pragma unroll
    for (int st = 0; st < 4; ++st) qf[st] = *(const bf16x8*)(Qw + (size_t)r * 2048 + 16 * st + 8 * h);
    u32x4 kreg[1][NKC], vreg[1][NVC];
    const int krow_ = tid / KCPR, kcc_ = tid % KCPR, vrow_ = tid / VCPR, vcc_ = tid % VCPR;
#define ATT_LOAD(S, Ks, Vs) do { \
        _Pragma("unroll") for (int i_ = 0; i_ < NKC; ++i_) kreg[S][i_] = *(const u32x4*)((Ks) + (size_t)(krow_ + i_ * (512 / KCPR)) * kpitch + kcc_ * 8); \
        _Pragma("unroll") for (int i_ = 0; i_ < NVC; ++i_) vreg[S][i_] = *(const u32x4*)((Vs) + (size_t)(vrow_ + i_ * (512 / VCPR)) * vpitch + vcc_ * 8); } while (0)
#define ATT_STORE(S, buf) do { \
        _Pragma("unroll") for (int i_ = 0; i_ < NKC; ++i_) *(LAS u32x4*)(lds + (buf) * KBUF + (krow_ + i_ * (512 / KCPR)) * KP + kcc_ * 16) = kreg[S][i_]; \
        _Pragma("unroll") for (int i_ = 0; i_ < NVC; ++i_) *(LAS u32x4*)(lds + 2 * KBUF + (buf) * VBUF + (vrow_ + i_ * (512 / VCPR)) * VP + vcc_ * 16) = vreg[S][i_]; } while (0)
    const int nt = 1 + (t1 - t0);
    ATT_LOAD(0, Kmeta, Vmeta);
    ATT_STORE(0, 0);
    ATT_LOAD(0, Kreal + (size_t)t0 * 64 * kpitch, Vreal + (size_t)t0 * 64 * vpitch);
    __syncthreads();
    const int kcolw = SWA ? 0 : 64 * (wid >> 2);
    const int koff = r * KP + (kcolw + 8 * h) * 2;
    const int voff = (4 * h + ((lane & 15) >> 2)) * VP + (16 * ((lane >> 4) & 1) + 4 * (lane & 3)) * 2;
    f32x16 o[NDB];
    float mhat, l;
    f32x16 s0, s1;
    bf16x8 pf[4];
#define ATT_QK(buf, C0) do { const LAS unsigned char* kb_ = lds + (buf) * KBUF + koff; \
        __builtin_amdgcn_s_setprio(1); \
        _Pragma("unroll") for (int st = 0; st < 4; ++st) { \
            const bf16x8 a0_ = *(const LAS bf16x8*)(kb_ + st * 32), a1_ = *(const LAS bf16x8*)(kb_ + 32 * KP + st * 32); \
            if (st == 0) { s0 = MFMA32(a0_, qf[0], C0); s1 = MFMA32(a1_, qf[0], C0); } else { s0 = MFMA32(a0_, qf[st], s0); s1 = MFMA32(a1_, qf[st], s1); } } \
        __builtin_amdgcn_s_setprio(0); } while (0)
#define ATT_MAX(mx) do { float a_ = fmaxf(fmaxf(s0[0], s0[1]), s1[0]), b_ = fmaxf(fmaxf(s0[2], s0[3]), s1[1]); a_ = fmaxf(fmaxf(a_, s1[2]), s1[3]); \
        _Pragma("unroll") for (int i = 4; i < 16; i += 4) { a_ = fmaxf(fmaxf(a_, s0[i]), s0[i + 1]); b_ = fmaxf(fmaxf(b_, s0[i + 2]), s0[i + 3]); a_ = fmaxf(fmaxf(a_, s1[i]), s1[i + 1]); b_ = fmaxf(fmaxf(b_, s1[i + 2]), s1[i + 3]); } \
        mx = fmaxf(a_, b_); mx = xhalf_max(mx); } while (0)
#define ATT_EXP_PACK() do { float ra_ = 0.f, rb_ = 0.f; \
        _Pragma("unroll") for (int i = 0; i < 16; ++i) { s0[i] = __builtin_amdgcn_exp2f(s0[i]); s1[i] = __builtin_amdgcn_exp2f(s1[i]); ra_ += s0[i]; rb_ += s1[i]; } \
        l += ra_ + rb_; u32x4 w_; \
        w_.x = cvtpk(s0[0], s0[1]); w_.y = cvtpk(s0[2], s0[3]); w_.z = cvtpk(s0[4], s0[5]); w_.w = cvtpk(s0[6], s0[7]); pf[0] = __builtin_bit_cast(bf16x8, w_); \
        w_.x = cvtpk(s0[8], s0[9]); w_.y = cvtpk(s0[10], s0[11]); w_.z = cvtpk(s0[12], s0[13]); w_.w = cvtpk(s0[14], s0[15]); pf[1] = __builtin_bit_cast(bf16x8, w_); \
        w_.x = cvtpk(s1[0], s1[1]); w_.y = cvtpk(s1[2], s1[3]); w_.z = cvtpk(s1[4], s1[5]); w_.w = cvtpk(s1[6], s1[7]); pf[2] = __builtin_bit_cast(bf16x8, w_); \
        w_.x = cvtpk(s1[8], s1[9]); w_.y = cvtpk(s1[10], s1[11]); w_.z = cvtpk(s1[12], s1[13]); w_.w = cvtpk(s1[14], s1[15]); pf[3] = __builtin_bit_cast(bf16x8, w_); } while (0)
#define ATT_EXP_H(S, P0_, P1_) do { float ra_ = 0.f, rb_ = 0.f; \
        _Pragma("unroll") for (int i = 0; i < 16; i += 2) { S[i] = __builtin_amdgcn_exp2f(S[i]); S[i + 1] = __builtin_amdgcn_exp2f(S[i + 1]); ra_ += S[i]; rb_ += S[i + 1]; } \
        l += ra_ + rb_; u32x4 w_; \
        w_.x = cvtpk(S[0], S[1]); w_.y = cvtpk(S[2], S[3]); w_.z = cvtpk(S[4], S[5]); w_.w = cvtpk(S[6], S[7]); P0_ = __builtin_bit_cast(bf16x8, w_); \
        w_.x = cvtpk(S[8], S[9]); w_.y = cvtpk(S[10], S[11]); w_.z = cvtpk(S[12], S[13]); w_.w = cvtpk(S[14], S[15]); P1_ = __builtin_bit_cast(bf16x8, w_); } while (0)
    s16x4 vlo[2][NDB], vhi[2][NDB];
#define ATT_VRD(buf, ks, B) do { const LAS unsigned char* vb_ = lds + 2 * KBUF + (buf) * VBUF + voff; \
        _Pragma("unroll") for (int db = 0; db < NDB; ++db) { vlo[B][db] = vtr(vb_ + (16 * (ks)) * VP + db * 64); vhi[B][db] = vtr(vb_ + (16 * (ks) + 8) * VP + db * 64); } } while (0)
#define ATT_PV(buf, NKS) do { \
        __builtin_amdgcn_s_setprio(1); \
        _Pragma("unroll") for (int ks = 0; ks < (NKS); ++ks) { \
            if (ks + 1 < (NKS)) ATT_VRD(buf, ks + 1, (ks + 1) & 1); \
            _Pragma("unroll") for (int db = 0; db < NDB; ++db) { \
                const bf16x8 va_ = __builtin_shufflevector(vlo[ks & 1][db], vhi[ks & 1][db], 0, 1, 2, 3, 4, 5, 6, 7); \
                o[db] = MFMA32(va_, pf[ks], o[db]); } \
            __builtin_amdgcn_sched_barrier(0); } \
        __builtin_amdgcn_s_setprio(0); } while (0)
#define ATT_SMPV(buf) do { \
        ATT_EXP_H(s0, pf[0], pf[1]); \
        __builtin_amdgcn_sched_barrier(0); \
        ATT_VRD(buf, 1, 1); \
        _Pragma("unroll") for (int db = 0; db < NDB; ++db) { const bf16x8 va_ = __builtin_shufflevector(vlo[0][db], vhi[0][db], 0, 1, 2, 3, 4, 5, 6, 7); o[db] = MFMA32(va_, pf[0], o[db]); } \
        ATT_VRD(buf, 2, 0); \
        _Pragma("unroll") for (int db = 0; db < NDB; ++db) { const bf16x8 va_ = __builtin_shufflevector(vlo[1][db], vhi[1][db], 0, 1, 2, 3, 4, 5, 6, 7); o[db] = MFMA32(va_, pf[1], o[db]); } \
        ATT_EXP_H(s1, pf[2], pf[3]); \
        _Pragma("unroll") for (int g_ = 0; g_ < 2 * NDB; ++g_) { __builtin_amdgcn_sched_group_barrier(0x008, 1, 0); __builtin_amdgcn_sched_group_barrier(0x100, 2, 0); __builtin_amdgcn_sched_group_barrier(0x002, 40 / (2 * NDB), 0); } \
        __builtin_amdgcn_sched_barrier(0); \
        ATT_VRD(buf, 3, 1); \
        _Pragma("unroll") for (int db = 0; db < NDB; ++db) { const bf16x8 va_ = __builtin_shufflevector(vlo[0][db], vhi[0][db], 0, 1, 2, 3, 4, 5, 6, 7); o[db] = MFMA32(va_, pf[2], o[db]); } \
        __builtin_amdgcn_sched_barrier(0); \
        _Pragma("unroll") for (int db = 0; db < NDB; ++db) { const bf16x8 va_ = __builtin_shufflevector(vlo[1][db], vhi[1][db], 0, 1, 2, 3, 4, 5, 6, 7); o[db] = MFMA32(va_, pf[3], o[db]); } \
        __builtin_amdgcn_sched_barrier(0); } while (0)
    f32x16 zero16;
#pragma unroll
    for (int i = 0; i < 16; ++i) zero16[i] = 0.f;
    {
        ATT_QK(0, zero16);
#pragma unroll
        for (int i = 0; i < 16; ++i) { if (i >= 8) s0[i] = NEGV; s1[i] = NEGV; }
        ATT_VRD(0, 0, 0);
        float mx; ATT_MAX(mx);
        mhat = mx; l = 0.f;
#pragma unroll
        for (int i = 0; i < 16; ++i) { s0[i] -= mx; s1[i] -= mx; }
        ATT_EXP_PACK();
#pragma unroll
        for (int db = 0; db < NDB; ++db) o[db] = zero16;
        ATT_PV(0, 1);
        ATT_STORE(0, 1);
        if (2 < nt) ATT_LOAD(0, Kreal + (size_t)(t0 + 1) * 64 * kpitch, Vreal + (size_t)(t0 + 1) * 64 * vpitch);
        __syncthreads();
    }
#define ATT_TILE(it, PAR) do { \
          \
        bool skip_ = false, edge_ = false; \
        if (SWA) { const int k0_ = (t0 + (it) - 1) * 64; skip_ = (k0_ > qrel0 + 31 + 128) || (k0_ + 63 < qrel0 - 128); edge_ = !((k0_ >= qrel0 + 31 - 128) && (k0_ + 63 <= qrel0 + 128)); } \
        if (!skip_) { f32x16 negm_; _Pragma("unroll") for (int i = 0; i < 16; ++i) negm_[i] = -mhat; \
            ATT_QK(PAR, negm_); } \
        if ((it) + 1 < nt) ATT_STORE(0, (PAR) ^ 1);                       \
        if ((it) + 2 < nt) ATT_LOAD(0, Kreal + (size_t)(t0 + (it) + 1) * 64 * kpitch, Vreal + (size_t)(t0 + (it) + 1) * 64 * vpitch);     \
        if (!skip_) { \
            ATT_VRD(PAR, 0, 0);                                           \
            if (SWA && edge_) { const int d0_ = (t0 + (it) - 1) * 64 - (qrel0 + r); \
                _Pragma("unroll") for (int i = 0; i < 16; ++i) { const int d_ = d0_ + crow(i, h); if (d_ < -128 || d_ > 128) s0[i] = NEGV; if (d_ + 32 < -128 || d_ + 32 > 128) s1[i] = NEGV; } } \
            float mx_; ATT_MAX(mx_); \
            if (__builtin_expect(__any(mx_ > THR), 0)) { const float dl_ = fmaxf(mx_, 0.f); mhat += dl_; \
                _Pragma("unroll") for (int i = 0; i < 16; ++i) { s0[i] -= dl_; s1[i] -= dl_; } \
                const float f_ = __builtin_amdgcn_exp2f(-dl_); l *= f_; \
                _Pragma("unroll") for (int db = 0; db < NDB; ++db) _Pragma("unroll") for (int i = 0; i < 16; ++i) o[db][i] *= f_; } \
            ATT_SMPV(PAR); } \
        __syncthreads(); } while (0)
    for (int it = 1; it < nt; it += 2) { ATT_TILE(it, 1); ATT_TILE(it + 1, 0); }
#undef ATT_TILE
#undef ATT_QK
#undef ATT_MAX
#undef ATT_EXP_PACK
#undef ATT_PV
#undef ATT_SMPV
#undef ATT_EXP_H
#undef ATT_VRD
#undef ATT_LOAD
#undef ATT_STORE
    const float m = mhat;
    l = xhalf_sum(l);
    if constexpr (SWA) {
        l += __builtin_amdgcn_exp2f(sink_l2 - m);
        const float inv = 1.f / l;
#pragma unroll
        for (int db = 0; db < NDB; ++db)
#pragma unroll
            for (int g4 = 0; g4 < 4; ++g4) {
                u32x2 w; w.x = cvtpk(o[db][4 * g4] * inv, o[db][4 * g4 + 1] * inv); w.y = cvtpk(o[db][4 * g4 + 2] * inv, o[db][4 * g4 + 3] * inv);
                *(u32x2*)(Qw + (size_t)r * 2048 + 32 * db + 8 * g4 + 4 * h) = w;
            }
    } else {
        const float inv = 1.f / l;
        LAS float* xb = (LAS float*)lds;
        if (wid >= 4) {
            const float sc = lam * inv;
#pragma unroll
            for (int db = 0; db < NDB; ++db)
#pragma unroll
                for (int i = 0; i < 16; ++i) xb[((wid - 4) * 128 + 32 * db + crow(i, h)) * 32 + r] = o[db][i] * sc;
        }
        __syncthreads();
        if (wid < 4) {
            float ss = 0.f;
#pragma unroll
            for (int db = 0; db < NDB; ++db)
#pragma unroll
                for (int i = 0; i < 16; ++i) { const float v = o[db][i] * inv - xb[(wid * 128 + 32 * db + crow(i, h)) * 32 + r]; o[db][i] = v; ss += v * v; }
            ss = xhalf_sum(ss);
            const float rstd = 0.8f / sqrtf(ss * (1.f / 128.f) + 1e-6f);
#pragma unroll
            for (int db = 0; db < NDB; ++db)
#pragma unroll
                for (int g4 = 0; g4 < 4; ++g4) {
                    const int d = 32 * db + 8 * g4 + 4 * h; const f32x4 gg = *(const f32x4*)(gain + d);
                    u32x2 w; w.x = cvtpk(o[db][4 * g4] * rstd * gg[0], o[db][4 * g4 + 1] * rstd * gg[1]); w.y = cvtpk(o[db][4 * g4 + 2] * rstd * gg[2], o[db][4 * g4 + 3] * rstd * gg[3]);
                    *(u32x2*)(Od + (size_t)r * 2048 + d) = w;
                }
        }
        __syncthreads();
    }
}
constexpr int SW_KP = 144, SW_VP = 192, SW_KT = 64 * SW_KP, SW_VT = 64 * SW_VP, SW_VOFF = 7 * SW_KT, SW_LDS = 7 * (SW_KT + SW_VT);
__device__ __forceinline__ void swa_unit(LAS unsigned char* lds, const int tid, const int wid, const int lane, bf16_t* QOrow  ,
                                         const bf16_t* Kreal, const bf16_t* Kmeta, const bf16_t* Vreal, const bf16_t* Vmeta, const int t0, const int ntr, const int qblk0, const float* sink4) {
    constexpr float THR = 8.f;
    const int r = lane & 31, h = lane >> 5;
    {
        u32x4 kr[7], vr[7];
        const int row = tid >> 3, cc = tid & 7;
#pragma unroll
        for (int j = 0; j < 7; ++j) if (j <= ntr) {
            const bf16_t* ks = (j == 0) ? Kmeta : Kreal + (size_t)(t0 + j - 1) * 64 * 256; const bf16_t* vs = (j == 0) ? Vmeta : Vreal + (size_t)(t0 + j - 1) * 64 * 256;
            kr[j] = *(const u32x4*)(ks + (size_t)row * 256 + cc * 8); vr[j] = *(const u32x4*)(vs + (size_t)row * 256 + cc * 8); }
#pragma unroll
        for (int j = 0; j < 7; ++j) if (j <= ntr) {
            *(LAS u32x4*)(lds + j * SW_KT + row * SW_KP + cc * 16) = kr[j]; *(LAS u32x4*)(lds + SW_VOFF + j * SW_VT + row * SW_VP + cc * 16) = vr[j]; }
    }
    __syncthreads();
    const int koff = r * SW_KP + (8 * h) * 2;
    const int voff = (4 * h + ((lane & 15) >> 2)) * SW_VP + (16 * ((lane >> 4) & 1) + 4 * (lane & 3)) * 2;
    f32x16 zero16;
#pragma unroll
    for (int i = 0; i < 16; ++i) zero16[i] = 0.f;
    const int qrel0 = qblk0 + 32 * (wid & 3);
#pragma unroll 1
    for (int pass = 0; pass < 2; ++pass) {
        const int hd = 2 * pass + (wid >> 2);
        bf16_t* Qw = QOrow + (size_t)(32 * (wid & 3)) * 2048 + hd * 64;
        bf16x8 qf[4];
#pragma unroll
        for (int st = 0; st < 4; ++st) qf[st] = *(const bf16x8*)(Qw + (size_t)r * 2048 + 16 * st + 8 * h);
        const float sink_l2 = sink4[hd] * 1.4426950408889634f;
        f32x16 o[2], s0, s1; bf16x8 pf[4]; float mhat, l = 0.f;
#define SW_QK(j, C0) do { const LAS unsigned char* kb_ = lds + (j) * SW_KT + koff; \
        _Pragma("unroll") for (int st = 0; st < 4; ++st) { \
            const bf16x8 a0_ = *(const LAS bf16x8*)(kb_ + st * 32), a1_ = *(const LAS bf16x8*)(kb_ + 32 * SW_KP + st * 32); \
            if (st == 0) { s0 = MFMA32(a0_, qf[0], C0); s1 = MFMA32(a1_, qf[0], C0); } else { s0 = MFMA32(a0_, qf[st], s0); s1 = MFMA32(a1_, qf[st], s1); } } } while (0)
#define SW_MAX(mx) do { float a_ = fmaxf(fmaxf(s0[0], s0[1]), s1[0]), b_ = fmaxf(fmaxf(s0[2], s0[3]), s1[1]); a_ = fmaxf(fmaxf(a_, s1[2]), s1[3]); \
        _Pragma("unroll") for (int i = 4; i < 16; i += 4) { a_ = fmaxf(fmaxf(a_, s0[i]), s0[i + 1]); b_ = fmaxf(fmaxf(b_, s0[i + 2]), s0[i + 3]); a_ = fmaxf(fmaxf(a_, s1[i]), s1[i + 1]); b_ = fmaxf(fmaxf(b_, s1[i + 2]), s1[i + 3]); } \
        mx = xhalf_max(fmaxf(a_, b_)); } while (0)
#define SW_EXP_H(S, P0_, P1_) do { float ra_ = 0.f, rb_ = 0.f; \
        _Pragma("unroll") for (int i = 0; i < 16; i += 2) { S[i] = __builtin_amdgcn_exp2f(S[i]); S[i + 1] = __builtin_amdgcn_exp2f(S[i + 1]); ra_ += S[i]; rb_ += S[i + 1]; } \
        l += ra_ + rb_; u32x4 w_; \
        w_.x = cvtpk(S[0], S[1]); w_.y = cvtpk(S[2], S[3]); w_.z = cvtpk(S[4], S[5]); w_.w = cvtpk(S[6], S[7]); P0_ = __builtin_bit_cast(bf16x8, w_); \
        w_.x = cvtpk(S[8], S[9]); w_.y = cvtpk(S[10], S[11]); w_.z = cvtpk(S[12], S[13]); w_.w = cvtpk(S[14], S[15]); P1_ = __builtin_bit_cast(bf16x8, w_); } while (0)
#define SW_PV(j, NKS) do { const LAS unsigned char* vb_ = lds + SW_VOFF + (j) * SW_VT + voff; \
        _Pragma("unroll") for (int ks = 0; ks < (NKS); ++ks) \
            _Pragma("unroll") for (int db = 0; db < 2; ++db) { \
                const s16x4 lo_ = vtr(vb_ + (16 * ks) * SW_VP + db * 64), hi_ = vtr(vb_ + (16 * ks + 8) * SW_VP + db * 64); \
                const bf16x8 va_ = __builtin_shufflevector(lo_, hi_, 0, 1, 2, 3, 4, 5, 6, 7); \
                o[db] = MFMA32(va_, pf[ks], o[db]); } } while (0)
        {
            SW_QK(0, zero16);
#pragma unroll
            for (int i = 0; i < 16; ++i) { if (i >= 8) s0[i] = NEGV; s1[i] = NEGV; }
            float mx; SW_MAX(mx);
            mhat = mx;
#pragma unroll
            for (int i = 0; i < 16; ++i) s0[i] -= mx;
            SW_EXP_H(s0, pf[0], pf[1]);
            o[0] = zero16; o[1] = zero16;
            SW_PV(0, 1);
        }
#pragma unroll 1
        for (int j = 1; j <= ntr; ++j) {
            const int k0 = (t0 + j - 1) * 64;
            if ((k0 > qrel0 + 31 + 128) || (k0 + 63 < qrel0 - 128)) continue;
            const bool edge = !((k0 >= qrel0 + 31 - 128) && (k0 + 63 <= qrel0 + 128));
            f32x16 negm_;
#pragma unroll
            for (int i = 0; i < 16; ++i) negm_[i] = -mhat;
            SW_QK(j, negm_);
            if (edge) { const int d0_ = k0 - (qrel0 + r);
#pragma unroll
                for (int i = 0; i < 16; ++i) { const int d_ = d0_ + crow(i, h); if (d_ < -128 || d_ > 128) s0[i] = NEGV; if (d_ + 32 < -128 || d_ + 32 > 128) s1[i] = NEGV; } }
            float mx_; SW_MAX(mx_);
            if (__builtin_expect(__any(mx_ > THR), 0)) { const float dl_ = fmaxf(mx_, 0.f); mhat += dl_;
#pragma unroll
                for (int i = 0; i < 16; ++i) { s0[i] -= dl_; s1[i] -= dl_; }
                const float f_ = __builtin_amdgcn_exp2f(-dl_); l *= f_;
#pragma unroll
                for (int db = 0; db < 2; ++db)
#pragma unroll
                    for (int i = 0; i < 16; ++i) o[db][i] *= f_; }
            SW_EXP_H(s0, pf[0], pf[1]); SW_EXP_H(s1, pf[2], pf[3]);
            SW_PV(j, 4);
        }
#undef SW_QK
#undef SW_MAX
#undef SW_EXP_H
#undef SW_PV
        l = xhalf_sum(l);
        l += __builtin_amdgcn_exp2f(sink_l2 - mhat);
        const float inv = 1.f / l;
#pragma unroll
        for (int db = 0; db < 2; ++db)
#pragma unroll
            for (int g4 = 0; g4 < 4; ++g4) {
                u32x2 w; w.x = cvtpk(o[db][4 * g4] * inv, o[db][4 * g4 + 1] * inv); w.y = cvtpk(o[db][4 * g4 + 2] * inv, o[db][4 * g4 + 3] * inv);
                *(u32x2*)(Qw + (size_t)r * 2048 + 32 * db + 8 * g4 + 4 * h) = w;
            }
    }
    __syncthreads();
}
}

typedef unsigned short bf16;
typedef float f32x4 __attribute__((ext_vector_type(4)));
typedef unsigned u32x4 __attribute__((ext_vector_type(4)));
typedef unsigned u32x2 __attribute__((ext_vector_type(2)));
using pg8::cvtpk; using pg8::bf_lo; using pg8::bf_hi;
constexpr int NTOK = 32768, DM = 1024, NIN = 6656, DFF = 2816, SEQL = 2048;
constexpr float RMS_EPS = 1e-6f;
constexpr int LDS_MAIN = 151552, LDS_BYTES = LDS_MAIN + 256;
static_assert(att::ATT_LDS_MAX <= LDS_MAIN && att::SW_LDS <= LDS_MAIN && pg8::STAGE_BYTES <= LDS_MAIN, "LDS map");

__device__ __forceinline__ float wave_sum(float v) {
#pragma unroll
    for (int o = 1; o < 64; o <<= 1) v += __shfl_xor(v, o);
    return v;
}
template <int MODE> __device__ __forceinline__ int rowmap(int n) {
    if (MODE == 1) {
        const bool perm = (n < 1280) || (n >= 1536 && n < 3584);
        if (!perm) return n;
        const int d = n & 63; return (n & ~63) + ((d < 32) ? 2 * d : 2 * (d - 32) + 1);
    } else if (MODE == 2) {
        if (n < DFF) return 8 * (n >> 2) + (n & 3);
        const int j = n - DFF; return 8 * (j >> 2) + 4 + (j & 3);
    }
    return n;
}
template <int MODE> __device__ __forceinline__ void p0_transpose_item(const float* W, int N, bf16* WT, int ldk, int koff, LAS float* scr, int item, int lane, const float* kscale = nullptr) {
    const int nblk = N / 32, kb = item / nblk, nb = item % nblk, k0 = 64 * kb, n0 = 32 * nb;
#pragma unroll 8
    for (int i = 0; i < 32; ++i) { const int kk = 2 * i + (lane >> 5); scr[kk * 33 + (lane & 31)] = __builtin_nontemporal_load(&W[(size_t)(k0 + kk) * N + n0 + (lane & 31)]); }
    asm volatile("s_waitcnt lgkmcnt(0)" ::: "memory");
    const int c = lane & 7;
    f32x4 ks0 = {1.f, 1.f, 1.f, 1.f}, ks1 = {1.f, 1.f, 1.f, 1.f};
    if (kscale) { ks0 = *(const f32x4*)(kscale + k0 + 8 * c); ks1 = *(const f32x4*)(kscale + k0 + 8 * c + 4); }
#pragma unroll
    for (int j = 0; j < 4; ++j) { const int n = (lane >> 3) + 8 * j; const LAS float* s = scr + (8 * c) * 33 + n;
        u32x4 o; o.x = cvtpk(s[0 * 33] * ks0[0], s[1 * 33] * ks0[1]); o.y = cvtpk(s[2 * 33] * ks0[2], s[3 * 33] * ks0[3]); o.z = cvtpk(s[4 * 33] * ks1[0], s[5 * 33] * ks1[1]); o.w = cvtpk(s[6 * 33] * ks1[2], s[7 * 33] * ks1[3]);
        *(u32x4*)(WT + (size_t)rowmap<MODE>(n0 + n) * ldk + koff + k0 + 8 * c) = o; }
    asm volatile("s_waitcnt lgkmcnt(0)" ::: "memory");
}

#define XB_TMO      128
#define XB_XCNT(j)  (256  + 64 * (j))
#define XB_XSUB(j)  (1280 + 64 * (j))
#define XB_XGEN(j)  (2304 + 64 * (j))
#define XB_TOP      3328
#define XB_TOPGEN   3392
#define XCD_BAR_WORDS 3456
#define XB_SPIN_CAP (1u << 18)

__device__ __forceinline__ unsigned xb_ld(unsigned* p)              { return __hip_atomic_load(p, __ATOMIC_RELAXED, __HIP_MEMORY_SCOPE_AGENT); }
__device__ __forceinline__ unsigned xb_add(unsigned* p, unsigned v) { return __hip_atomic_fetch_add(p, v, __ATOMIC_RELAXED, __HIP_MEMORY_SCOPE_AGENT); }
__device__ __forceinline__ unsigned xb_xcc_id() { return (unsigned)__builtin_amdgcn_s_getreg((3 << 11) | 20) & 0xFu; }
#define XB_SPIN(cond, bar) do { unsigned _sp = 0; while (cond) { __builtin_amdgcn_s_sleep(1); \
    if ((++_sp & 255u) == 0u) { if (xb_ld(&(bar)[XB_TMO])) break; if (_sp > XB_SPIN_CAP) { atomicAdd(&(bar)[XB_TMO], 1u); break; } } } } while (0)

struct XcdBarrier {
    unsigned* bar; unsigned x;
    volatile LAS unsigned* st;
};

__device__ __forceinline__ XcdBarrier xcd_barrier_post(unsigned* bar, volatile LAS unsigned* st) {
    XcdBarrier b; b.bar = bar; b.x = xb_xcc_id(); b.st = st;
    if (threadIdx.x == 0) (void)xb_add(&bar[XB_XCNT(b.x)], 1u);
    return b;
}
__device__ __forceinline__ void xcd_barrier_complete(unsigned* bar, unsigned x, unsigned& nloc, unsigned& nx) {
    const unsigned G = gridDim.x * gridDim.y * gridDim.z;
    unsigned sum, cnt, mine, sp = 0u;
    for (;;) {
        sum = 0u; cnt = 0u; mine = 0u;
#pragma unroll
        for (unsigned j = 0; j < 16; ++j) { const unsigned c = xb_ld(&bar[XB_XCNT(j)]); sum += c; cnt += (c > 0u) ? 1u : 0u; mine = (j == x) ? c : mine; }
        if (sum == G) break;
        __builtin_amdgcn_s_sleep(1);
        if ((++sp & 255u) == 0u) { if (xb_ld(&bar[XB_TMO])) break; if (sp > XB_SPIN_CAP) { atomicAdd(&bar[XB_TMO], 1u); break; } }
    }
    nloc = mine > 0u ? mine : 1u; nx = cnt > 0u ? cnt : 1u;
}

__device__ __forceinline__ void xcd_barrier(const XcdBarrier& b) {
    asm volatile("s_waitcnt vmcnt(0)" ::: "memory");
    __syncthreads();
    if (threadIdx.x == 0) {
        unsigned* bar = b.bar;
        __builtin_amdgcn_s_waitcnt(0);
        unsigned nloc = b.st[0], nx = b.st[1];
        if (nloc == 0u) { xcd_barrier_complete(bar, b.x, nloc, nx); b.st[0] = nloc; b.st[1] = nx; }
        const unsigned old = xb_add(&bar[XB_XSUB(b.x)], 1u);
        const unsigned gen = old / nloc;
        if (old + 1u == (gen + 1u) * nloc) {
            __builtin_amdgcn_fence(__ATOMIC_RELEASE, "agent");
            asm volatile("s_waitcnt vmcnt(0)" ::: "memory");
            const unsigned og = xb_add(&bar[XB_TOP], 1u);
            const unsigned tg = og / nx;
            if (og + 1u == (tg + 1u) * nx) xb_add(&bar[XB_TOPGEN], 1u);
            else XB_SPIN(xb_ld(&bar[XB_TOPGEN]) == tg, bar);
            __builtin_amdgcn_fence(__ATOMIC_ACQUIRE, "agent");
            xb_add(&bar[XB_XGEN(b.x)], 1u);
            asm volatile("s_waitcnt vmcnt(0)" ::: "memory");
        } else {
            XB_SPIN(xb_ld(&bar[XB_XGEN(b.x)]) == gen, bar);
            __builtin_amdgcn_fence(__ATOMIC_ACQUIRE, "agent");
            asm volatile("s_waitcnt vmcnt(0)" ::: "memory");
        }
    }
    __syncthreads();
}

constexpr size_t WS_BAR = 512 * 1024;
#ifndef WGM_P1
#define WGM_P1 4
#endif
#ifndef WGM_P6
#define WGM_P6 4
#endif
#ifndef WGM_N1K
#define WGM_N1K 8
#endif
#ifndef PH_MASK
#define PH_MASK 0x1ff
#endif
#define PH_ON(k) ((PH_MASK >> (k)) & 1)
#ifndef PROBE_PHASE
#define PROBE_PHASE (-1)
#endif
#define PROBE_T0(k) do { if (PROBE_PHASE == (k) && threadIdx.x == 0) probe_t0 = __builtin_amdgcn_s_memrealtime(); } while (0)
#define PROBE_DELAY(k) do { if (PROBE_PHASE == (k)) { if (threadIdx.x == 0) { const unsigned long long t1_ = __builtin_amdgcn_s_memrealtime(), dt_ = t1_ - probe_t0; while (__builtin_amdgcn_s_memrealtime() - t1_ < dt_) __builtin_amdgcn_s_sleep(8); } __syncthreads(); } } while (0)
struct Args { const float* in[19]; float* out; unsigned char* ws; };

__global__ void __launch_bounds__(512, 2) fwd_megakernel(Args a) {
    extern __shared__ __attribute__((aligned(16))) unsigned char lds_raw[];
    cg::grid_group grid = cg::this_grid();
    LAS unsigned char* lds = (LAS unsigned char*)lds_raw;
    const int tid = threadIdx.x, lane = tid & 63, wid = __builtin_amdgcn_readfirstlane(tid >> 6);
    const int G = gridDim.x, bx = blockIdx.x;
    const int vcu = (G % 8 == 0) ? (bx % 8) * (G / 8) + bx / 8 : bx;
    const int gw = bx * 8 + wid, NGW = G * 8;
    unsigned char* ws = a.ws;
    unsigned long long probe_t0 = 0; (void)probe_t0;
    volatile LAS unsigned* xb_st = (volatile LAS unsigned*)(lds + LDS_MAIN);
    if (threadIdx.x < 2) xb_st[threadIdx.x] = 0u;
    __syncthreads();
    const XcdBarrier xbar = xcd_barrier_post((unsigned*)(ws + WS_BAR), xb_st);
#define p_x (a.in[0])
#define p_meta_tokens (a.in[1])
#define p_pre_mix_gain (a.in[2])
#define p_w_in (a.in[3])
#define p_b_gate (a.in[4])
#define p_attn_sink (a.in[5])
#define p_lq1 (a.in[6])
#define p_lk1 (a.in[7])
#define p_lq2 (a.in[8])
#define p_lk2 (a.in[9])
#define p_subln_gain (a.in[10])
#define p_w_bswa (a.in[11])
#define p_w_bdiff (a.in[12])
#define p_w_out (a.in[13])
#define p_post_mix_gain (a.in[14])
#define p_pre_ffn_gain (a.in[15])
#define p_w_ffn_in (a.in[16])
#define p_w_ffn_out (a.in[17])
#define p_post_ffn_gain (a.in[18])
#define p_ss1 ((float*)(ws + WS_SS1))
#define p_ss3 ((float*)(ws + WS_SS3))
#define p_rope ((float*)(ws + WS_ROPE))
#define p_KAm ((bf16*)(ws + WS_KAM))
#define p_VAm ((bf16*)(ws + WS_VAM))
#define p_KBm ((bf16*)(ws + WS_KBM))
#define p_VBm ((bf16*)(ws + WS_VBM))
#define p_Win_t ((bf16*)(ws + WS_WIN))
#define p_Wcat_t ((bf16*)(ws + WS_WCAT))
#define p_Wout_t ((bf16*)(ws + WS_WOUT))
#define p_Wffi_t ((bf16*)(ws + WS_WFFI))
#define p_Wffo_t ((bf16*)(ws + WS_WFFO))
#define p_U ((bf16*)(ws + WS_U))
#define p_QO ((bf16*)(ws + WS_QO))
#define p_KA ((bf16*)(ws + WS_KA))
#define p_VA ((bf16*)(ws + WS_VA))
#define p_KB ((bf16*)(ws + WS_KB))
#define p_VB ((bf16*)(ws + WS_VB))
#define p_MERGED ((bf16*)(ws + WS_MERGED))
#define p_Y ((bf16*)(ws + WS_Y))
#define p_F ((bf16*)(ws + WS_F))
#define p_FO ((bf16*)(ws + WS_FO))
#define p_H1 ((bf16*)(ws + WS_H1))
#define p_GATES ((bf16*)a.out)
#define p_out (a.out)

#if PH_ON(0)
    PROBE_T0(0);
    {
        int tid_o = threadIdx.x; asm volatile("" : "+v"(tid_o));
        const int tid = tid_o, lane = tid & 63, wid = __builtin_amdgcn_readfirstlane(tid >> 6), gw = bx * 8 + wid; (void)tid; (void)gw;
        for (int e = bx * 512 + tid; e < 65536; e += G * 512) p_ss1[e] = 0.f;
        for (int e = bx * 512 + tid; e < 2064 * 32; e += G * 512) {
            const int pos = e >> 5, i = e & 31; const float inv = powf(10000.f, -(float)i * (1.f / 32.f)); const float ang = (float)pos * inv;
            p_rope[2 * e] = cosf(ang); p_rope[2 * e + 1] = sinf(ang);
        }
        for (int base = gw; base < NTOK; base += 4 * NGW) {
            f32x4 v[4][4]; float sq[4];
#pragma unroll
            for (int q = 0; q < 4; ++q) { const int mrow = (base + q * NGW < NTOK) ? base + q * NGW : NTOK - 1; const f32x4* xr = (const f32x4*)(p_x + (size_t)mrow * DM) + lane;
#pragma unroll
                for (int j = 0; j < 4; ++j) v[q][j] = __builtin_nontemporal_load(&xr[64 * j]); }
#pragma unroll
            for (int q = 0; q < 4; ++q) { float s = 0.f;
#pragma unroll
                for (int j = 0; j < 4; ++j) s += (v[q][j][0] * v[q][j][0] + v[q][j][1] * v[q][j][1]) + (v[q][j][2] * v[q][j][2] + v[q][j][3] * v[q][j][3]);
                sq[q] = 1.f / sqrtf(wave_sum(s) * (1.f / DM) + RMS_EPS); }
#pragma unroll
            for (int q = 0; q < 4; ++q) { if (base + q * NGW < NTOK) { u32x2* o8 = (u32x2*)(p_U + (size_t)(base + q * NGW) * DM) + lane; if (lane == 0) ((float*)(ws + WS_RSX))[base + q * NGW] = sq[q];
#pragma unroll
                for (int j = 0; j < 4; ++j) { const float rstd = sq[q]; u32x2 w; w.x = cvtpk(v[q][j][0] * rstd, v[q][j][1] * rstd); w.y = cvtpk(v[q][j][2] * rstd, v[q][j][3] * rstd); o8[64 * j] = w; } } }
        }
        if (bx < 40) {
            const int item = bx;
            LAS float* um = (LAS float*)lds; LAS float* red = (LAS float*)(lds + 65536);
#pragma unroll
            for (int rr = 0; rr < 2; ++rr) {
                const int row = 2 * wid + rr; const float* xr = p_meta_tokens + row * DM; float v[16]; float s = 0.f;
#pragma unroll
                for (int j = 0; j < 16; ++j) { v[j] = xr[lane + 64 * j]; s += v[j] * v[j]; }
                s = wave_sum(s); const float rstd = 1.f / sqrtf(s * (1.f / DM) + RMS_EPS);
#pragma unroll
                for (int j = 0; j < 16; ++j) um[row * DM + lane + 64 * j] = v[j] * rstd * p_pre_mix_gain[lane + 64 * j];
            }
            __syncthreads();
            int c0, ldd, dcol; bf16* dst; bool dorope;
            if (item < 4)       { c0 = 1024 + 64 * item;        dst = p_KAm; ldd = 256;  dcol = 64 * item;        dorope = true; }
            else if (item < 8)  { c0 = 1280 + 64 * (item - 4);  dst = p_VAm; ldd = 256;  dcol = 64 * (item - 4);  dorope = false; }
            else if (item < 24) { c0 = 2560 + 64 * (item - 8);  dst = p_KBm; ldd = 1024; dcol = 64 * (item - 8);  dorope = true; }
            else                { c0 = 3584 + 64 * (item - 24); dst = p_VBm; ldd = 1024; dcol = 64 * (item - 24); dorope = false; }
#define FMAC(c_, a_, b_) asm("v_fmac_f32_e32 %0, %1, %2" : "+v"(c_) : "v"(a_), "v"(b_))
            float acc[16];
#pragma unroll
            for (int rI = 0; rI < 16; ++rI) acc[rI] = 0.f;
            const float* wp = p_w_in + (size_t)(128 * wid) * NIN + c0 + lane;
#pragma unroll 1
            for (int kc = 0; kc < 4; ++kc) {
                float wv[32];
#pragma unroll
                for (int e = 0; e < 32; ++e) wv[e] = wp[(size_t)(32 * kc + e) * NIN];
#pragma unroll
                for (int k4 = 0; k4 < 8; ++k4) {
                    asm volatile("" ::: "memory");
#pragma unroll
                    for (int rI = 0; rI < 16; ++rI) { const f32x4 uu = *(const LAS f32x4*)(um + rI * DM + 128 * wid + 32 * kc + 4 * k4); FMAC(acc[rI], uu[0], wv[4 * k4]); FMAC(acc[rI], uu[1], wv[4 * k4 + 1]); FMAC(acc[rI], uu[2], wv[4 * k4 + 2]); FMAC(acc[rI], uu[3], wv[4 * k4 + 3]); }
                }
            }
#pragma unroll
            for (int rI = 0; rI < 16; ++rI) red[(wid * 16 + rI) * 64 + lane] = acc[rI];
            __syncthreads();
            {
                const int rI = tid >> 5, i = tid & 31; float x1 = 0.f, x2 = 0.f;
#pragma unroll
                for (int w = 0; w < 8; ++w) { x1 += red[(w * 16 + rI) * 64 + i]; x2 += red[(w * 16 + rI) * 64 + i + 32]; }
                if (dorope) {
                    const float inv = powf(10000.f, -(float)i * (1.f / 32.f)); const float ang = (float)rI * inv; const float c = cosf(ang), s = sinf(ang);
                    *(unsigned*)(dst + rI * ldd + dcol + 2 * i) = cvtpk(x1 * c - x2 * s, x2 * c + x1 * s);
                } else {
                    dst[rI * ldd + dcol + i] = (bf16)(cvtpk(x1, 0.f) & 0xffffu); dst[rI * ldd + dcol + i + 32] = (bf16)(cvtpk(x2, 0.f) & 0xffffu);
                }
                for (int e = tid; e < 1536; e += 512) { const int rr = 16 + e / 32, cc = (e % 32) * 2; *(unsigned*)(dst + rr * ldd + dcol + cc) = 0u; }
            }
            __syncthreads();
        }
        {
            LAS float* scr = (LAS float*)(lds + wid * 16384);
            constexpr int I_IN = 16 * (NIN / 32), I_SQ = 16 * 32, I_FI = 16 * (2 * DFF / 32), I_FO = (DFF / 64) * 32;
            constexpr int NITEMS = I_IN + 3 * I_SQ + I_FI + I_FO;
            const bool skipw = (G > 80) && (bx < 40);
            const int wfirst = (G > 80) ? (bx - 40) * 8 + wid : gw, wstride = (G > 80) ? (G - 40) * 8 : NGW;
            if (!skipw) for (int it = wfirst; it < NITEMS; it += wstride) {
                int q = it;
                if (q < I_IN) { p0_transpose_item<1>(p_w_in, NIN, p_Win_t, DM, 0, scr, q, lane, p_pre_mix_gain); continue; } q -= I_IN;
                if (q < I_SQ) { p0_transpose_item<0>(p_w_bswa, DM, p_Wcat_t, 2048, 0, scr, q, lane); continue; } q -= I_SQ;
                if (q < I_SQ) { p0_transpose_item<0>(p_w_bdiff, DM, p_Wcat_t, 2048, 1024, scr, q, lane); continue; } q -= I_SQ;
                if (q < I_SQ) { p0_transpose_item<0>(p_w_out, DM, p_Wout_t, DM, 0, scr, q, lane); continue; } q -= I_SQ;
                if (q < I_FI) { p0_transpose_item<2>(p_w_ffn_in, 2 * DFF, p_Wffi_t, DM, 0, scr, q, lane, p_pre_ffn_gain); continue; } q -= I_FI;
                p0_transpose_item<0>(p_w_ffn_out, DM, p_Wffo_t, DFF, 0, scr, q, lane);
            }
        }
    }
    if (a.ws == nullptr) grid.sync();
    xcd_barrier(xbar);
    PROBE_DELAY(0);

#endif
#if PH_ON(1)
    PROBE_T0(1);
    {
        pg8::Gemm g{p_U, p_Win_t, NTOK, NIN, DM}; pg8::StaticOrder S; S.init(NTOK, NIN, G, bx, WGM_P1);
        pg8::EpiInProj E{ws, p_GATES, p_b_gate};
        pg8::gemm_phase<pg8::EpiInProj, pg8::StaticOrder, true, true>(lds, g, S, E);
    }
    xcd_barrier(xbar);
    PROBE_DELAY(1);

#endif
#if PH_ON(2)
    PROBE_T0(2);
    {
        int tid_o = threadIdx.x; asm volatile("" : "+v"(tid_o));
        const int tid = tid_o, lane = tid & 63, wid = __builtin_amdgcn_readfirstlane(tid >> 6);
        unsigned long long att_acc = 0, att_dummy = 0;
        float lam;
        { float p1 = p_lq1[lane] * p_lk1[lane], p2 = p_lq2[lane] * p_lk2[lane]; p1 = wave_sum(p1); p2 = wave_sum(p2); lam = expf(p1) - expf(p2) + 0.2f; }
        for (int uidx = vcu; uidx < 2048; uidx += G) {
            const int i = uidx & 15, hh = (uidx >> 4) & 7, b = uidx >> 7;
            const size_t qrow = (size_t)b * SEQL + i * 128 + 32 * (wid & 3);
            att::attn_unit<128, 128, false>(lds, tid, wid, lane, p_QO + qrow * 2048 + 1024 + hh * 128 + 64 * (wid >> 2),
                                            p_KB + (size_t)b * SEQL * 1024 + hh * 128, p_KBm + hh * 128, 1024, p_VB + (size_t)b * SEQL * 1024 + hh * 128, p_VBm + hh * 128, 1024,
                                            0, 32, 0, 0.f, lam, p_subln_gain, p_QO + qrow * 2048 + 1024 + hh * 128, att_acc);
        }
#if ATT_PROBE == 9
        const unsigned long long swa_t0 = __builtin_amdgcn_s_memrealtime();
#endif
        for (int uidx = vcu; uidx < 1024; uidx += G) {
            const int i = uidx & 15, gk = (uidx >> 4) & 3, b = uidx >> 6;
            const int t0 = (i >= 1) ? 2 * (i - 1) : 0, t1 = (2 * (i + 2) < 32) ? 2 * (i + 2) : 32;
            att::swa_unit(lds, tid, wid, lane, p_QO + ((size_t)b * SEQL + i * 128) * 2048 + gk * 256,
                          p_KA + (size_t)b * SEQL * 256 + gk * 64, p_KAm + gk * 64, p_VA + (size_t)b * SEQL * 256 + gk * 64, p_VAm + gk * 64, t0, t1 - t0, i * 128, p_attn_sink + gk * 4);
        }
#if ATT_PROBE == 9
        att_acc = __builtin_amdgcn_s_memrealtime() - swa_t0;
#endif
#if ATT_PROBE
        if (wid == 0) { const unsigned long long t1_ = __builtin_amdgcn_s_memrealtime(); while (__builtin_amdgcn_s_memrealtime() - t1_ < att_acc) __builtin_amdgcn_s_sleep(8); }
        __syncthreads();
#endif
    }
    xcd_barrier(xbar);
    PROBE_DELAY(2);

#endif
#if PH_ON(3)
    PROBE_T0(3);
    {
        pg8::Gemm g{p_QO, p_Wcat_t, NTOK, DM, 2048}; pg8::StaticOrder S; S.init(NTOK, DM, G, bx, WGM_N1K);
        pg8::EpiMerge E{p_GATES, p_MERGED};
        pg8::gemm_phase<pg8::EpiMerge, pg8::StaticOrder, true, true>(lds, g, S, E);
    }
    xcd_barrier(xbar);
    PROBE_DELAY(3);

#endif
#if PH_ON(4)
    PROBE_T0(4);
    {
        pg8::Gemm g{p_MERGED, p_Wout_t, NTOK, DM, DM}; pg8::StaticOrder S; S.init(NTOK, DM, G, bx, WGM_N1K);
        pg8::EpiYSS E{p_Y, p_ss1};
        pg8::gemm_phase<pg8::EpiYSS, pg8::StaticOrder, true, true>(lds, g, S, E);
    }
    xcd_barrier(xbar);
    PROBE_DELAY(4);

#endif
#if PH_ON(5)
    PROBE_T0(5);
    {
        int tid_o = threadIdx.x; asm volatile("" : "+v"(tid_o));
        const int tid = tid_o, lane = tid & 63, wid = __builtin_amdgcn_readfirstlane(tid >> 6), gw = bx * 8 + wid; (void)tid; (void)gw;
    for (int base = gw; base < NTOK; base += 4 * NGW) {
        f32x4 hv[4][4]; u32x2 yw[4][4]; u32x2 xw[4][4]; float r1[4], rx[4];
#pragma unroll
        for (int q = 0; q < 4; ++q) { const int mrow = (base + q * NGW < NTOK) ? base + q * NGW : NTOK - 1;
            const u32x2* xr = (const u32x2*)(p_U + (size_t)mrow * DM) + lane; const u32x2* yr = (const u32x2*)(p_Y + (size_t)mrow * DM) + lane;
            r1[q] = p_ss1[mrow]; rx[q] = ((const float*)(ws + WS_RSX))[mrow];
#pragma unroll
            for (int j = 0; j < 4; ++j) { xw[q][j] = xr[64 * j]; yw[q][j] = yr[64 * j]; } }
#pragma unroll
        for (int q = 0; q < 4; ++q) {
            const float rstd1 = 1.f / sqrtf(r1[q] * (1.f / DM) + RMS_EPS), xs = 1.f / rx[q]; float s2 = 0.f;
#pragma unroll
            for (int j = 0; j < 4; ++j) { const f32x4 g = *((const f32x4*)p_post_mix_gain + lane + 64 * j); f32x4 t; t[0] = bf_lo(xw[q][j].x) * xs; t[1] = bf_hi(xw[q][j].x) * xs; t[2] = bf_lo(xw[q][j].y) * xs; t[3] = bf_hi(xw[q][j].y) * xs;
                t[0] += bf_lo(yw[q][j].x) * rstd1 * g[0]; t[1] += bf_hi(yw[q][j].x) * rstd1 * g[1]; t[2] += bf_lo(yw[q][j].y) * rstd1 * g[2]; t[3] += bf_hi(yw[q][j].y) * rstd1 * g[3];
                hv[q][j] = t; s2 += (t[0] * t[0] + t[1] * t[1]) + (t[2] * t[2] + t[3] * t[3]); }
            r1[q] = 1.f / sqrtf(wave_sum(s2) * (1.f / DM) + RMS_EPS);
        }
#pragma unroll
        for (int q = 0; q < 4; ++q) { if (base + q * NGW < NTOK) { const int mrow = base + q * NGW; const float rstd2 = r1[q];
            u32x2* hrow = (u32x2*)(p_H1 + (size_t)mrow * DM) + lane; if (lane == 0) ((float*)(ws + WS_RS2))[mrow] = rstd2;
#pragma unroll
            for (int j = 0; j < 4; ++j) { u32x2 hw; hw.x = cvtpk(hv[q][j][0] * rstd2, hv[q][j][1] * rstd2); hw.y = cvtpk(hv[q][j][2] * rstd2, hv[q][j][3] * rstd2); hrow[64 * j] = hw; } } }
    }
    }
    xcd_barrier(xbar);
    PROBE_DELAY(5);

#endif
#if PH_ON(6)
    PROBE_T0(6);
    {
        pg8::Gemm g{p_H1, p_Wffi_t, NTOK, 2 * DFF, DM}; pg8::StaticOrder S; S.init(NTOK, 2 * DFF, G, bx, WGM_P6);
        pg8::EpiSwiGLU E{p_F};
        pg8::gemm_phase<pg8::EpiSwiGLU, pg8::StaticOrder, true, true>(lds, g, S, E);
    }
    xcd_barrier(xbar);
    PROBE_DELAY(6);

#endif
#if PH_ON(7)
    PROBE_T0(7);
    {
        pg8::Gemm g{p_F, p_Wffo_t, NTOK, DM, DFF}; pg8::StaticOrder S; S.init(NTOK, DM, G, bx, WGM_N1K);
        pg8::EpiYSS E{p_FO, p_ss3};
        pg8::gemm_phase<pg8::EpiYSS, pg8::StaticOrder, true, true>(lds, g, S, E);
    }
    xcd_barrier(xbar);
    PROBE_DELAY(7);

#endif
#if PH_ON(8)
    PROBE_T0(8);
    {
        int tid_o = threadIdx.x; asm volatile("" : "+v"(tid_o));
        const int tid = tid_o, lane = tid & 63, wid = __builtin_amdgcn_readfirstlane(tid >> 6), gw = bx * 8 + wid; (void)tid; (void)gw;
    for (int base = gw; base < NTOK; base += 4 * NGW) {
        u32x2 hw[4][4]; u32x2 fw[4][4]; float r3[4], r2[4];
#pragma unroll
        for (int q = 0; q < 4; ++q) { const int mrow = (base + q * NGW < NTOK) ? base + q * NGW : NTOK - 1;
            const u32x2* hr = (const u32x2*)(p_H1 + (size_t)mrow * DM) + lane; const u32x2* fr_ = (const u32x2*)(p_FO + (size_t)mrow * DM) + lane;
            r3[q] = p_ss3[mrow]; r2[q] = ((const float*)(ws + WS_RS2))[mrow];
#pragma unroll
            for (int j = 0; j < 4; ++j) { hw[q][j] = hr[64 * j]; fw[q][j] = fr_[64 * j]; } }
#pragma unroll
        for (int q = 0; q < 4; ++q) { if (base + q * NGW < NTOK) { const int mrow = base + q * NGW; const float rstd3 = 1.f / sqrtf(r3[q] * (1.f / DM) + RMS_EPS);
            f32x4* orow = (f32x4*)(p_out + (size_t)mrow * DM) + lane;
#pragma unroll
            for (int j = 0; j < 4; ++j) { const f32x4 g = *((const f32x4*)p_post_ffn_gain + lane + 64 * j); const float hs = 1.f / r2[q]; f32x4 o; o[0] = bf_lo(hw[q][j].x) * hs; o[1] = bf_hi(hw[q][j].x) * hs; o[2] = bf_lo(hw[q][j].y) * hs; o[3] = bf_hi(hw[q][j].y) * hs;
                o[0] += bf_lo(fw[q][j].x) * rstd3 * g[0]; o[1] += bf_hi(fw[q][j].x) * rstd3 * g[1]; o[2] += bf_lo(fw[q][j].y) * rstd3 * g[2]; o[3] += bf_hi(fw[q][j].y) * rstd3 * g[3];
                orow[64 * j] = o; } } }
    }
    }
#if PROBE_PHASE == 9
    for (int i9 = 0; i9 < 10; ++i9) grid.sync();
#endif
#if PROBE_PHASE == 8
    xcd_barrier(xbar);
    PROBE_DELAY(8);
#endif
#endif
}


extern "C" void kernel_launch(void* const* d_in, const int* in_sizes, int n_in, void* d_out, int out_size, void* d_ws, size_t ws_size, hipStream_t stream) {
    static int grid_blocks = 0;
    if (grid_blocks == 0) {
        if (n_in != 19 || out_size != NTOK * DM || ws_size < WS_END) { fprintf(stderr, "kernel_launch: unexpected shapes (n_in %d, out %d, ws %zu)\n", n_in, out_size, ws_size); grid_blocks = -1; return; }
        int dev = 0, cus = 0, per_cu = 0;
        hipGetDevice(&dev);
        hipDeviceGetAttribute(&cus, hipDeviceAttributeMultiprocessorCount, dev);
        hipFuncSetAttribute((const void*)fwd_megakernel, hipFuncAttributeMaxDynamicSharedMemorySize, LDS_BYTES);
        hipOccupancyMaxActiveBlocksPerMultiprocessor(&per_cu, (const void*)fwd_megakernel, 512, LDS_BYTES);
        if (per_cu < 1) { fprintf(stderr, "kernel_launch: occupancy query says %d blocks per CU\n", per_cu); per_cu = 1; }
        if (per_cu > 1) per_cu = 1;
        grid_blocks = cus * per_cu;
    }
    if (grid_blocks < 0) return;
    if (hipMemsetAsync((unsigned char*)d_ws + WS_BAR, 0, XCD_BAR_WORDS * 4, stream) != hipSuccess) { fprintf(stderr, "kernel_launch: memset of the barrier words failed\n"); return; }
    Args a{};
    for (int i = 0; i < 19; ++i) a.in[i] = (const float*)d_in[i];
    a.out = (float*)d_out; a.ws = (unsigned char*)d_ws;
    void* args[] = {&a};
    hipError_t e = hipLaunchCooperativeKernel((const void*)fwd_megakernel, dim3(grid_blocks), dim3(512), args, LDS_BYTES, stream);
    if (e != hipSuccess) fprintf(stderr, "cooperative launch failed: %s (grid %d)\n", hipGetErrorString(e), grid_blocks);
}
```
